# Optimizing an MI355X kernel written in HIP

```python
import math
import jax, jax.numpy as jnp
from jax import lax
import numpy as np

D_MODEL = 1024
BATCH = 32
SEQ = 2048
DEPTH = 2

PLE_DIM = 256
MIX_WIDTH = D_MODEL
N_GROUPS_MIX = 4
GROUP_WIDTH = MIX_WIDTH // N_GROUPS_MIX
BLOCK = 128

MLA_HEADS = 4
MLA_Q_RANK = 256
MLA_KV_RANK = 128
MLA_NOPE = 64
MLA_ROPE = 32
MLA_V = GROUP_WIDTH // MLA_HEADS
ROPE_THETA = 10000.0

HY_WIDTH = GROUP_WIDTH
HY_ORDER = 2
HY_EMB = 33
HY_BANDS = (HY_EMB - 1) // 2
HY_FILTER_HIDDEN = 64
HY_FAST_DECAY = 0.3
HY_SLOW_DECAY = 1.5
HY_TARGET = 1e-2

SWA_HEADS = 4
SWA_KV_HEADS = 2
SWA_HEAD_DIM = GROUP_WIDTH // SWA_HEADS
SWA_WINDOW = 128

SSD_D_INNER = GROUP_WIDTH
SSD_HEAD_DIM = 64
SSD_HEADS = SSD_D_INNER // SSD_HEAD_DIM
SSD_GROUPS = 2
SSD_STATE = 128
SSD_CHUNK = BLOCK

D_FF = 2816
SHORT_CONV = 3

LN_EPS = 1e-5
RMS_EPS = 1e-6
NEG_INF = -1e30
ALPHA = (2.0 * DEPTH) ** 0.25
BETA = (8.0 * DEPTH) ** -0.25

IN_SPLITS = [MLA_Q_RANK, MLA_KV_RANK, MLA_ROPE,
             (HY_ORDER + 1) * HY_WIDTH,
             SWA_HEADS * SWA_HEAD_DIM, SWA_KV_HEADS * SWA_HEAD_DIM, SWA_KV_HEADS * SWA_HEAD_DIM,
             SSD_D_INNER, SSD_D_INNER + 2 * SSD_GROUPS * SSD_STATE, 2 * SSD_HEADS]
IN_WIDTH = sum(IN_SPLITS)
IN_OFFSETS = [int(v) for v in np.cumsum(IN_SPLITS)[:-1]]

kernel_name = "hybrid_parallel_group_encoder"


def layer_norm(x, g, b):
    xf = x.astype(jnp.float32)
    mu = jnp.mean(xf, -1, keepdims=True)
    var = jnp.mean(jnp.square(xf - mu), -1, keepdims=True)
    return ((xf - mu) * lax.rsqrt(var + LN_EPS) * g + b).astype(x.dtype)


def rms_norm(x, g):
    xf = x.astype(jnp.float32)
    return (xf * lax.rsqrt(jnp.mean(xf * xf, -1, keepdims=True) + RMS_EPS) * g).astype(x.dtype)


def group_rms_norm(y, g, n_groups):
    bsz, s, w = y.shape
    yf = y.astype(jnp.float32).reshape(bsz, s, n_groups, w // n_groups)
    yf = yf * lax.rsqrt(jnp.mean(yf * yf, -1, keepdims=True) + RMS_EPS)
    return (yf.reshape(bsz, s, w) * g).astype(y.dtype)


def dwconv_centred(x, w, b):
    k = w.shape[0]
    s = x.shape[1]
    half = (k - 1) // 2
    xp = jnp.pad(x, ((0, 0), (half, half), (0, 0)))
    out = xp[:, 0:s] * w[0]
    for j in range(1, k):
        out = out + xp[:, j:j + s] * w[j]
    return out + b


def rotary_tables(seq_len):
    inv_freq = ROPE_THETA ** (-jnp.arange(0, MLA_ROPE, 2, dtype=jnp.float32) / MLA_ROPE)
    ang = jnp.arange(seq_len, dtype=jnp.float32)[:, None] * inv_freq[None, :]
    return jnp.cos(ang), jnp.sin(ang)


def apply_rope(x, cos, sin):
    extra = x.ndim - 3
    c = cos.reshape(cos.shape[:1] + (1,) * extra + cos.shape[1:])
    sn = sin.reshape(sin.shape[:1] + (1,) * extra + sin.shape[1:])
    x1, x2 = jnp.split(x.astype(jnp.float32), 2, axis=-1)
    return jnp.concatenate([x1 * c - x2 * sn, x2 * c + x1 * sn], -1).astype(x.dtype)


def alibi_slopes(n):
    start = 2.0 ** (-8.0 / n)
    return start ** jnp.arange(1, n + 1, dtype=jnp.float32)


def mla_mixer(cq, ckv, kr, gq, gkv, w_uq, w_ukv, cos, sin):
    bsz, s, _ = cq.shape
    q = (rms_norm(cq, gq) @ w_uq).reshape(bsz, s, MLA_HEADS, MLA_NOPE + MLA_ROPE)
    q_nope = q[..., :MLA_NOPE]
    q_rope = apply_rope(q[..., MLA_NOPE:], cos, sin)
    kv = (rms_norm(ckv, gkv) @ w_ukv).reshape(bsz, s, MLA_HEADS, MLA_NOPE + MLA_V)
    k_nope = kv[..., :MLA_NOPE]
    v = kv[..., MLA_NOPE:]
    k_rope = apply_rope(kr, cos, sin)
    scale = (MLA_NOPE + MLA_ROPE) ** -0.5
    nb = s // BLOCK
    qn_b = q_nope.reshape(bsz, nb, BLOCK, MLA_HEADS, MLA_NOPE).transpose(1, 0, 2, 3, 4)
    qr_b = q_rope.reshape(bsz, nb, BLOCK, MLA_HEADS, MLA_ROPE).transpose(1, 0, 2, 3, 4)

    def attend(blk):
        qn, qr = blk
        sc = (jnp.einsum('bqhd,bkhd->bhqk', qn, k_nope, preferred_element_type=jnp.float32)
              + jnp.einsum('bqhr,bkr->bhqk', qr, k_rope, preferred_element_type=jnp.float32)) * scale
        pr = jax.nn.softmax(sc, axis=-1).astype(v.dtype)
        return jnp.einsum('bhqk,bkhd->bqhd', pr, v)

    o = lax.map(attend, (qn_b, qr_b))
    return o.transpose(1, 0, 2, 3, 4).reshape(bsz, s, MLA_HEADS * MLA_V)


def hyena_filters(seq_len, w1, b1, freq, w2, b2, w3):
    f32 = jnp.float32
    t = jnp.linspace(0.0, 1.0, seq_len, dtype=f32)[:, None]
    ang = 2.0 * math.pi * jnp.arange(seq_len, dtype=f32)[:, None] / seq_len
    bands = jnp.linspace(1e-4, HY_BANDS - 1, HY_BANDS, dtype=f32)[None, :]
    feat = jnp.concatenate([t, jnp.cos(bands * ang), -jnp.sin(bands * ang)], -1)
    fr = freq.astype(f32)
    h = jnp.sin(fr * (feat @ w1.astype(f32) + b1.astype(f32)))
    h = jnp.sin(fr * (h @ w2.astype(f32) + b2.astype(f32)))
    h = (h @ w3.astype(f32)).reshape(seq_len, HY_ORDER, 2, HY_WIDTH)
    max_decay = math.log(HY_TARGET) / HY_FAST_DECAY
    min_decay = math.log(HY_TARGET) / HY_SLOW_DECAY
    deltas = jnp.linspace(min_decay, max_decay, HY_WIDTH, dtype=f32)
    decay = jnp.exp(-t * jnp.abs(deltas)[None, :])
    return h * decay[:, None, None, :]


def bidir_fft_conv(z, h_fwd, h_bwd):
    s = z.shape[1]
    k = jnp.concatenate([h_fwd, jnp.zeros((1, h_fwd.shape[1]), h_fwd.dtype), h_bwd[:0:-1]], 0)
    kf = jnp.fft.rfft(k, axis=0)
    zf = jnp.fft.rfft(z, n=2 * s, axis=1)
    return jnp.fft.irfft(zf * kf[None], n=2 * s, axis=1)[:, :s]


def hyena_mixer(u, conv_w, conv_b, w1, b1, freq, w2, b2, w3, filt_bias):
    s = u.shape[1]
    uc = dwconv_centred(u, conv_w, conv_b).astype(jnp.float32)
    v, x1, x2 = jnp.split(uc, 3, axis=-1)
    h = hyena_filters(s, w1, b1, freq, w2, b2, w3)
    z = v
    for n, gate in enumerate((x1, x2)):
        z = gate * (bidir_fft_conv(z, h[:, n, 0], h[:, n, 1]) + filt_bias[n].astype(jnp.float32) * z)
    return z.astype(u.dtype)


def swa_mixer(q, k, v, sink):
    bsz, s, _ = q.shape
    nb = s // BLOCK
    grp = SWA_HEADS // SWA_KV_HEADS
    hd = SWA_HEAD_DIM
    q = q.reshape(bsz, nb, BLOCK, SWA_KV_HEADS, grp, hd)
    pad = ((0, 0), (BLOCK, BLOCK), (0, 0), (0, 0))
    kp = jnp.pad(k.reshape(bsz, s, SWA_KV_HEADS, hd), pad).reshape(bsz, nb + 2, BLOCK, SWA_KV_HEADS, hd)
    vp = jnp.pad(v.reshape(bsz, s, SWA_KV_HEADS, hd), pad).reshape(bsz, nb + 2, BLOCK, SWA_KV_HEADS, hd)
    kw = jnp.concatenate([kp[:, :nb], kp[:, 1:nb + 1], kp[:, 2:]], axis=2)
    vw = jnp.concatenate([vp[:, :nb], vp[:, 1:nb + 1], vp[:, 2:]], axis=2)
    sc = jnp.einsum('bnqkgd,bnjkd->bnkgqj', q, kw, preferred_element_type=jnp.float32) * (hd ** -0.5)
    blk = jnp.arange(nb)[:, None] * BLOCK
    qpos = blk + jnp.arange(BLOCK)[None, :]
    kpos = blk - BLOCK + jnp.arange(3 * BLOCK)[None, :]
    dist = jnp.abs(qpos[:, :, None] - kpos[:, None, :])
    valid = (dist <= SWA_WINDOW) & ((kpos >= 0) & (kpos < s))[:, None, :]
    slopes = alibi_slopes(SWA_HEADS).reshape(SWA_KV_HEADS, grp)
    bias = -slopes[None, :, :, None, None] * dist.astype(jnp.float32)[:, None, None]
    sc = jnp.where(valid[:, None, None], sc + bias, NEG_INF)
    sk = sink.astype(jnp.float32).reshape(SWA_KV_HEADS, grp)[:, :, None]
    m = jnp.maximum(jnp.max(sc, -1), sk)
    e = jnp.exp(sc - m[..., None])
    denom = jnp.sum(e, -1) + jnp.exp(sk - m)
    pr = (e / denom[..., None]).astype(v.dtype)
    o = jnp.einsum('bnkgqj,bnjkd->bnqkgd', pr, vw)
    return o.reshape(bsz, s, SWA_HEADS * hd)


def ssd_chunked(x, a, bm, cm):
    b, s, h, p = x.shape
    c = s // SSD_CHUNK
    qn = SSD_CHUNK
    g = SSD_GROUPS
    r = h // g
    n = SSD_STATE
    X = x.reshape(b, c, qn, g, r, p)
    A = a.reshape(b, c, qn, g, r).transpose(0, 3, 4, 1, 2)
    Bc = bm.reshape(b, c, qn, g, n)
    Cc = cm.reshape(b, c, qn, g, n)
    a_cs = jnp.cumsum(A, axis=-1)
    seg = a_cs[..., :, None] - a_cs[..., None, :]
    tril = jnp.tril(jnp.ones((qn, qn), dtype=bool))
    lmat = jnp.exp(jnp.where(tril, seg, -jnp.inf))
    cb = jnp.einsum('bctgn,bcsgn->bgcts', Cc, Bc)
    y_diag = jnp.einsum('bgcts,bgrcts,bcsgrp->bctgrp', cb, lmat, X)
    decay_states = jnp.exp(a_cs[..., -1:] - a_cs)
    states = jnp.einsum('bcsgn,bgrcs,bcsgrp->cbgrpn', Bc, decay_states, X)
    chunk_decay = jnp.exp(a_cs[..., -1]).transpose(3, 0, 1, 2)

    def step(carry, inp):
        st, dec = inp
        return carry * dec[..., None, None] + st, carry

    _, prev = lax.scan(step, jnp.zeros(states.shape[1:], jnp.float32), (states, chunk_decay))
    y_off = jnp.einsum('bctgn,cbgrpn,bgrct->bctgrp', Cc, prev, jnp.exp(a_cs))
    return (y_diag + y_off).reshape(b, s, h, p)


def ssd_mixer(xbc, dt_raw, conv_w, conv_b, dt_bias, a_log, d_skip):
    bsz, s, _ = xbc.shape
    f32 = jnp.float32
    xbc = jax.nn.silu(dwconv_centred(xbc, conv_w, conv_b).astype(f32))
    xs, bm, cm = jnp.split(xbc, [SSD_D_INNER, SSD_D_INNER + SSD_GROUPS * SSD_STATE], axis=-1)
    xs = xs.reshape(bsz, s, SSD_HEADS, SSD_HEAD_DIM)
    bm = bm.reshape(bsz, s, SSD_GROUPS, SSD_STATE)
    cm = cm.reshape(bsz, s, SSD_GROUPS, SSD_STATE)
    dt = jax.nn.softplus(dt_raw.astype(f32).reshape(bsz, s, 2, SSD_HEADS) + dt_bias.astype(f32))
    a = -jnp.exp(a_log.astype(f32))
    y_f = ssd_chunked(xs * dt[:, :, 0, :, None], dt[:, :, 0] * a[0], bm, cm)
    flip = lambda t: jnp.flip(t, axis=1)
    y_b = flip(ssd_chunked(flip(xs * dt[:, :, 1, :, None]), flip(dt[:, :, 1] * a[1]), flip(bm), flip(cm)))
    dsum = (d_skip[0] + d_skip[1]).astype(f32)[:, None]
    y = y_f + y_b + dsum * xs
    return y.reshape(bsz, s, SSD_D_INNER)


def setup_inputs(seed: int = 0) -> dict:
    key = jax.random.key(seed)
    ks = iter(jax.random.split(key, 64))
    f32 = jnp.float32
    L = DEPTH
    D = D_MODEL

    def nrm(shape, scale):
        return jax.random.normal(next(ks), shape, f32) * scale

    def gain(shape):
        return 1.0 + nrm(shape, 0.02)

    x = nrm((BATCH, SEQ, D), 1.0)
    p = nrm((DEPTH, BATCH, SEQ, PLE_DIM), 1.0)
    emb_ln_g = gain((D,))
    emb_ln_b = nrm((D,), 0.02)
    col_scale = np.ones(IN_WIDTH, np.float32)
    sv0 = IN_OFFSETS[5]
    col_scale[sv0:sv0 + SWA_KV_HEADS * SWA_HEAD_DIM] = BETA
    w_in = nrm((L, D, IN_WIDTH), D ** -0.5) * jnp.asarray(col_scale)
    mla_q_norm = gain((L, MLA_Q_RANK))
    mla_kv_norm = gain((L, MLA_KV_RANK))
    mla_w_uq = nrm((L, MLA_Q_RANK, MLA_HEADS * (MLA_NOPE + MLA_ROPE)), MLA_Q_RANK ** -0.5)
    ukv_scale = jnp.concatenate([jnp.ones((MLA_NOPE,), f32), jnp.full((MLA_V,), BETA, f32)])
    mla_w_ukv = (nrm((L, MLA_KV_RANK, MLA_HEADS, MLA_NOPE + MLA_V), MLA_KV_RANK ** -0.5)
                 * ukv_scale).reshape(L, MLA_KV_RANK, MLA_HEADS * (MLA_NOPE + MLA_V))
    hy_conv_w = nrm((L, SHORT_CONV, (HY_ORDER + 1) * HY_WIDTH), SHORT_CONV ** -0.5)
    hy_conv_b = nrm((L, (HY_ORDER + 1) * HY_WIDTH), 0.02)
    hy_f_w1 = nrm((L, HY_EMB, HY_FILTER_HIDDEN), HY_EMB ** -0.5)
    hy_f_b1 = nrm((L, HY_FILTER_HIDDEN), 0.1)
    hy_f_freq = 1.0 + nrm((L, HY_FILTER_HIDDEN), 0.1)
    hy_f_w2 = nrm((L, HY_FILTER_HIDDEN, HY_FILTER_HIDDEN), HY_FILTER_HIDDEN ** -0.5)
    hy_f_b2 = nrm((L, HY_FILTER_HIDDEN), 0.1)
    hy_f_w3 = nrm((L, HY_FILTER_HIDDEN, HY_ORDER * 2 * HY_WIDTH), 0.1 * HY_FILTER_HIDDEN ** -0.5)
    hy_bias = nrm((L, HY_ORDER, HY_WIDTH), 0.5)
    swa_sink = nrm((L, SWA_HEADS), 0.5)
    ssd_conv_w = nrm((L, SHORT_CONV, SSD_D_INNER + 2 * SSD_GROUPS * SSD_STATE), SHORT_CONV ** -0.5)
    ssd_conv_b = nrm((L, SSD_D_INNER + 2 * SSD_GROUPS * SSD_STATE), 0.02)
    dt0 = jnp.exp(jax.random.uniform(next(ks), (L, 2, SSD_HEADS), f32, math.log(1e-3), math.log(1e-1)))
    ssd_dt_bias = dt0 + jnp.log(-jnp.expm1(-dt0))
    ssd_a_log = jnp.log(jax.random.uniform(next(ks), (L, 2, SSD_HEADS), f32, 1.0, 16.0))
    ssd_d = 1.0 + nrm((L, 2, SSD_HEADS), 0.1)
    mix_norm_g = gain((L, MIX_WIDTH))
    w_out = nrm((L, MIX_WIDTH, D), BETA * MIX_WIDTH ** -0.5)
    ln1_g = gain((L, D))
    ln1_b = nrm((L, D), 0.02)
    ffn_w_gate = nrm((L, D, D_FF), BETA * D ** -0.5)
    ffn_w_up = nrm((L, D, D_FF), BETA * D ** -0.5)
    ffn_conv_w = nrm((L, SHORT_CONV, D_FF), SHORT_CONV ** -0.5)
    ffn_conv_b = nrm((L, D_FF), 0.02)
    ffn_w_down = nrm((L, D_FF, D), BETA * D_FF ** -0.5)
    ln2_g = gain((L, D))
    ln2_b = nrm((L, D), 0.02)
    ple_w_proj = nrm((L, PLE_DIM, D), BETA * PLE_DIM ** -0.5)
    ple_w_gate = nrm((L, D, D), D ** -0.5)
    ple_b_gate = nrm((L, D), 0.02)
    ln3_g = gain((L, D))
    ln3_b = nrm((L, D), 0.02)
    return {"x": x, "p": p, "emb_ln_g": emb_ln_g, "emb_ln_b": emb_ln_b, "w_in": w_in,
            "mla_q_norm": mla_q_norm, "mla_kv_norm": mla_kv_norm, "mla_w_uq": mla_w_uq, "mla_w_ukv": mla_w_ukv,
            "hy_conv_w": hy_conv_w, "hy_conv_b": hy_conv_b, "hy_f_w1": hy_f_w1, "hy_f_b1": hy_f_b1,
            "hy_f_freq": hy_f_freq, "hy_f_w2": hy_f_w2, "hy_f_b2": hy_f_b2, "hy_f_w3": hy_f_w3, "hy_bias": hy_bias,
            "swa_sink": swa_sink, "ssd_conv_w": ssd_conv_w, "ssd_conv_b": ssd_conv_b, "ssd_dt_bias": ssd_dt_bias,
            "ssd_a_log": ssd_a_log, "ssd_d": ssd_d, "mix_norm_g": mix_norm_g, "w_out": w_out,
            "ln1_g": ln1_g, "ln1_b": ln1_b, "ffn_w_gate": ffn_w_gate, "ffn_w_up": ffn_w_up,
            "ffn_conv_w": ffn_conv_w, "ffn_conv_b": ffn_conv_b, "ffn_w_down": ffn_w_down,
            "ln2_g": ln2_g, "ln2_b": ln2_b, "ple_w_proj": ple_w_proj, "ple_w_gate": ple_w_gate,
            "ple_b_gate": ple_b_gate, "ln3_g": ln3_g, "ln3_b": ln3_b}


def reference(x, p, emb_ln_g, emb_ln_b, w_in, mla_q_norm, mla_kv_norm, mla_w_uq, mla_w_ukv,
              hy_conv_w, hy_conv_b, hy_f_w1, hy_f_b1, hy_f_freq, hy_f_w2, hy_f_b2, hy_f_w3, hy_bias,
              swa_sink, ssd_conv_w, ssd_conv_b, ssd_dt_bias, ssd_a_log, ssd_d, mix_norm_g, w_out,
              ln1_g, ln1_b, ffn_w_gate, ffn_w_up, ffn_conv_w, ffn_conv_b, ffn_w_down,
              ln2_g, ln2_b, ple_w_proj, ple_w_gate, ple_b_gate, ln3_g, ln3_b):
    s = x.shape[1]
    cos, sin = rotary_tables(s)
    h = layer_norm(x, emb_ln_g, emb_ln_b)
    for i in range(DEPTH):
        u = h @ w_in[i]
        (cq, ckv, kr, hy_u, sq, sk, sv, ssd_z, ssd_xbc, ssd_dt) = jnp.split(u, IN_OFFSETS, axis=-1)
        y_a = mla_mixer(cq, ckv, kr, mla_q_norm[i], mla_kv_norm[i], mla_w_uq[i], mla_w_ukv[i], cos, sin)
        y_b = hyena_mixer(hy_u, hy_conv_w[i], hy_conv_b[i], hy_f_w1[i], hy_f_b1[i], hy_f_freq[i],
                          hy_f_w2[i], hy_f_b2[i], hy_f_w3[i], hy_bias[i])
        y_c = swa_mixer(sq, sk, sv, swa_sink[i])
        y_d = ssd_mixer(ssd_xbc, ssd_dt, ssd_conv_w[i], ssd_conv_b[i], ssd_dt_bias[i], ssd_a_log[i],
                        ssd_d[i]).astype(h.dtype) * jax.nn.silu(ssd_z)
        y = jnp.concatenate([y_a, y_b.astype(h.dtype), y_c, y_d], axis=-1)
        y = group_rms_norm(y, mix_norm_g[i], N_GROUPS_MIX)
        h = layer_norm(ALPHA * h + y @ w_out[i], ln1_g[i], ln1_b[i])
        gate = dwconv_centred(h @ ffn_w_gate[i], ffn_conv_w[i], ffn_conv_b[i])
        f = (jax.nn.silu(gate) * (h @ ffn_w_up[i])) @ ffn_w_down[i]
        h = layer_norm(ALPHA * h + f, ln2_g[i], ln2_b[i])
        e = (p[i] @ ple_w_proj[i]) * jax.nn.sigmoid(h @ ple_w_gate[i] + ple_b_gate[i])
        h = layer_norm(ALPHA * h + e, ln3_g[i], ln3_b[i])
    return h
```

```cpp
#include <hip/hip_runtime.h>
#include <hip/hip_bf16.h>
#include <hip/hip_cooperative_groups.h>
#include <cstdio>
namespace cg = cooperative_groups;

#ifndef PROBE_DUP
#define PROBE_DUP 0
#define PROBE_MIX 0
#define PROBE_GEMM 0
#endif
#ifndef COOP
#define COOP 1
#endif

typedef unsigned short bfr;
using bf16x8 = __attribute__((ext_vector_type(8))) short;
using s16x4  = __attribute__((ext_vector_type(4))) short;
using f32x4  = __attribute__((ext_vector_type(4))) float;
using f32x16 = __attribute__((ext_vector_type(16))) float;
#define DI __device__ __forceinline__

constexpr int NB = 32, S = 2048, D = 1024, NT = NB * S, NL = 2;
constexpr int INW = 2728, INP = 2816, DFF = 2816, PLE = 256;
constexpr int OQ = 0, OKV = 256, OKR = 384, OHY = 416, OSQ = 1184, OSK = 1440, OSV = 1568, OZ = 1696, OXBC = 1952, ODT = 2720;
constexpr float ALPHA = 1.4142135623730951f;
constexpr float LOG2E = 1.4426950408889634f;

constexpr size_t EW_IN = 2816ull * 1024, EW_UQ = 512ull * 256, EW_UKV = 512ull * 256, EW_OUT = 1024ull * 1024,
                 EW_G = 2816ull * 1024, EW_U = 2816ull * 1024, EW_D = 1024ull * 2816, EW_PP = 1024ull * 256, EW_PG = 1024ull * 1024;
constexpr size_t WO_IN = 0, WO_UQ = WO_IN + EW_IN, WO_UKV = WO_UQ + EW_UQ, WO_OUT = WO_UKV + EW_UKV, WO_G = WO_OUT + EW_OUT,
                 WO_U = WO_G + EW_G, WO_D = WO_U + EW_U, WO_PP = WO_D + EW_D, WO_PG = WO_PP + EW_PP, EW_LAYER = WO_PG + EW_PG;
constexpr size_t WS_W = 0;
constexpr size_t WS_KBUF = WS_W + NL * EW_LAYER * 2;
constexpr size_t WS_KF = WS_KBUF + 2ull * 2 * 256 * 4096 * 4;
constexpr size_t WS_ROPE = WS_KF + 2ull * 2 * 256 * 4096 * 8;
constexpr size_t WS_TW = WS_ROPE + 2048ull * 16 * 8;
constexpr size_t WS_HALO = WS_TW + 2048ull * 8;
constexpr size_t WS_HB = WS_HALO + 512ull * 2 * 2816 * 2;
constexpr size_t WS_U = WS_HB + (size_t)NT * 1024 * 2;
constexpr size_t WS_Y = WS_U + (size_t)NT * 2816 * 2;
constexpr size_t WS_Q = WS_Y + (size_t)NT * 512 * 2;
constexpr size_t WS_K = WS_Q + (size_t)NT * 384 * 2;
constexpr size_t WS_VT = WS_K + (size_t)NT * 384 * 2;
constexpr size_t WS_YN = WS_Q;
constexpr size_t WS_HYT = WS_VT + (size_t)NT * 256 * 2;
constexpr size_t WS_PB = WS_HYT;
constexpr size_t WS_PRE = WS_HYT + (size_t)NT * 256 * 2;
constexpr size_t WS_YSSD = WS_HYT + (size_t)NT * 768 * 2;
constexpr size_t WS_YH = WS_YSSD + 2ull * NT * 256 * 2;
constexpr size_t WS_BAR = WS_YH + (size_t)NT * 256 * 2;
constexpr size_t WS_END = WS_BAR + 256;

constexpr int LDS_BYTES = 147456;
constexpr int NTHREADS = 512;

struct Params {
  const float* in[40];
  float* out;
  char* ws;
};

typedef const float* const __attribute__((address_space(4)))* in_tab_t;
struct PX {
  in_tab_t in;
  float* out;
  char* ws;
};
__shared__ int s_wave_tab[64];
DI int hw_slot() { return (int)(__builtin_amdgcn_s_getreg((5 << 11) | (0 << 6) | 4) & 63u); }
DI void tid_init() {
  const int t = threadIdx.x;
  if ((t & 63) == 0) s_wave_tab[hw_slot()] = t >> 6;
  __syncthreads();
}
DI int tidx() {
  int w = s_wave_tab[hw_slot()];
  asm volatile("" : "+v"(w));
  w = __builtin_amdgcn_readfirstlane(w);
  int t = (w << 6) | (int)__builtin_amdgcn_mbcnt_hi(~0u, __builtin_amdgcn_mbcnt_lo(~0u, 0u));
  asm volatile("" : "+v"(t));
  return t;
}
DI const char* uni_ptr(const char* p) {
  const unsigned long long v = (unsigned long long)p;
  const unsigned lo = __builtin_amdgcn_readfirstlane((unsigned)v), hi = __builtin_amdgcn_readfirstlane((unsigned)(v >> 32));
  return (const char*)(((unsigned long long)hi << 32) | lo);
}
template <int M> DI float swz_xor(float v) { return __int_as_float(__builtin_amdgcn_ds_swizzle(__float_as_int(v), (M << 10) | 0x1f)); }
typedef __bf16 bf16x2_t __attribute__((ext_vector_type(2)));
DI bfr f2bf(float x) { return __builtin_bit_cast(bfr, (__bf16)x); }
DI float bf2f(bfr v) { return __uint_as_float(((unsigned)v) << 16); }
DI unsigned pack2(float a, float b) { bf16x2_t v = {(__bf16)a, (__bf16)b}; return __builtin_bit_cast(unsigned, v); }
DI float silu(float x) { return x / (1.f + __expf(-x)); }
DI float sigmoidf(float x) { return 1.f / (1.f + __expf(-x)); }

constexpr int BM = 256, BK = 64, HALF = 128, HT = HALF * BK;
DI int lds_byte(int r, int c) {
  int st = (r >> 4) * 2 + (c >> 5), rr = r & 15, cc = c & 31, ob = rr * 64 + cc * 2;
  return st * 1024 + (ob ^ (((ob >> 9) & 1) << 5));
}
DI void stage_rc(int b, int& R, int& C) {
  int st = b / 1024, sb = b % 1024, swz = sb ^ (((sb >> 9) & 1) << 5);
  R = (st >> 1) * 16 + swz / 64; C = (st & 1) * 32 + (swz % 64) / 2;
}

typedef f32x4 acc_t[2][2][4][2];
constexpr int TST = 260;

template <int LDA, int LDB, class Epi, int SKIP = 0>
DI void gemm_unit(const bfr* __restrict__ A, const bfr* __restrict__ Bt, int K, int brow, int bcol, char* shmc, const Epi& epi) {
  bfr* shm = (bfr*)shmc;
#define SA(b, h) (shm + ((b) * 2 + (h)) * HT)
#define SB(b, h) (shm + (4 + (b) * 2 + (h)) * HT)
#define GL_LDS(gp, lp) __builtin_amdgcn_global_load_lds((const unsigned*)(gp), (__attribute__((address_space(3))) unsigned*)(lp), 16, 0, 0)
#define STAGE(P, BASE, LD, br, kt) do { const char* _sb = (const char*)(BASE) + ((long)(br) * (LD) + (kt) * BK) * 2; \
    const char* _sb2 = uni_ptr(_sb + 64 * (LD) * 2); \
    GL_LDS(_sb + voff_##LD, (char*)(P) + woff); \
    GL_LDS(_sb2 + voff_##LD, (char*)(P) + woff + 8192); } while (0)
#define LDA_(dst, b, h) for (int m = 0; m < 4; ++m) for (int k = 0; k < 2; ++k) \
    dst[m][k] = *reinterpret_cast<const bf16x8*>((char*)SA(b, h) + lds_byte(wr * 64 + m * 16 + fr, k * 32 + fq * 8))
#define LDB_(dst, b, h) for (int n = 0; n < 2; ++n) for (int k = 0; k < 2; ++k) \
    dst[n][k] = *reinterpret_cast<const bf16x8*>((char*)SB(b, h) + lds_byte(wc * 32 + n * 16 + fr, k * 32 + fq * 8))
#define MMA(ai, bj, At, Bt_) do { __builtin_amdgcn_s_setprio(1); \
    for (int m = 0; m < 4; ++m) for (int n = 0; n < 2; ++n) for (int k = 0; k < 2; ++k) \
      acc[ai][bj][m][n] = __builtin_amdgcn_mfma_f32_16x16x32_bf16(At[m][k], Bt_[n][k], acc[ai][bj][m][n], 0, 0, 0); \
    __builtin_amdgcn_s_setprio(0); } while (0)
#define WAIT_V(n) asm volatile("s_waitcnt vmcnt(" #n ")" ::: "memory")
#define WAIT_L(n) asm volatile("s_waitcnt lgkmcnt(" #n ")" ::: "memory")
#define BAR __builtin_amdgcn_s_barrier()
#define SCHED __builtin_amdgcn_sched_barrier(0)

  const int tid_u = tidx();
  const int wid = tid_u >> 6, lane = tid_u & 63, wr = wid >> 2, wc = wid & 3, fr = lane & 15, fq = lane >> 4;
  unsigned voff_LDA, voff_LDB;
  { int r_, c_; stage_rc(tid_u * 16, r_, c_); voff_LDA = (unsigned)(r_ * LDA + c_) * 2u; voff_LDB = (unsigned)(r_ * LDB + c_) * 2u; }
  const int woff = __builtin_amdgcn_readfirstlane(wid * 1024);
  acc_t acc = {};
  bf16x8 At[4][2], B0[2][2], B1[2][2];
  int nt = K / BK; asm volatile("" : "+s"(nt));
  STAGE(SB(0, 0), Bt, LDB, bcol, 0); STAGE(SA(0, 0), A, LDA, brow, 0);
  STAGE(SB(0, 1), Bt, LDB, bcol + HALF, 0); STAGE(SA(0, 1), A, LDA, brow + HALF, 0);
  if (wr == 1) BAR;
  WAIT_V(4); BAR;
  STAGE(SB(1, 0), Bt, LDB, bcol, 1); STAGE(SA(1, 0), A, LDA, brow, 1); STAGE(SB(1, 1), Bt, LDB, bcol + HALF, 1);
  WAIT_V(6); BAR;
#pragma unroll 1
  for (int t = 0; t < nt - 2; t += 2) {
    LDB_(B0, 0, 0); SCHED; LDA_(At, 0, 0); STAGE(SA(1, 1), A, LDA, brow + HALF, t + 1);
    WAIT_L(8); BAR; WAIT_L(0); MMA(0, 0, At, B0); BAR; SCHED;
    LDB_(B1, 0, 1); STAGE(SB(0, 0), Bt, LDB, bcol, t + 2);
    BAR; WAIT_L(0); MMA(0, 1, At, B1); BAR;
    LDA_(At, 0, 1); STAGE(SA(0, 0), A, LDA, brow, t + 2);
    BAR; WAIT_L(0); MMA(1, 0, At, B0); BAR; SCHED;
    STAGE(SB(0, 1), Bt, LDB, bcol + HALF, t + 2);
    WAIT_V(6); BAR; MMA(1, 1, At, B1); BAR;
    LDB_(B0, 1, 0); SCHED; LDA_(At, 1, 0); STAGE(SA(0, 1), A, LDA, brow + HALF, t + 2);
    WAIT_L(8); BAR; WAIT_L(0); MMA(0, 0, At, B0); BAR; SCHED;
    LDB_(B1, 1, 1); STAGE(SB(1, 0), Bt, LDB, bcol, t + 3);
    BAR; WAIT_L(0); MMA(0, 1, At, B1); BAR;
    LDA_(At, 1, 1); STAGE(SA(1, 0), A, LDA, brow, t + 3);
    BAR; WAIT_L(0); MMA(1, 0, At, B0); BAR; SCHED;
    STAGE(SB(1, 1), Bt, LDB, bcol + HALF, t + 3);
    WAIT_V(6); BAR; MMA(1, 1, At, B1); BAR;
  }
  { LDB_(B0, 0, 0); LDA_(At, 0, 0); STAGE(SA(1, 1), A, LDA, brow + HALF, nt - 1);
    BAR; WAIT_L(0); MMA(0, 0, At, B0); BAR;
    LDB_(B1, 0, 1); BAR; WAIT_L(0); MMA(0, 1, At, B1); BAR;
    LDA_(At, 0, 1); WAIT_V(4); BAR; WAIT_L(0); MMA(1, 0, At, B0); MMA(1, 1, At, B1); BAR; }
  { LDB_(B0, 1, 0); LDA_(At, 1, 0); WAIT_V(2); BAR; WAIT_L(0); MMA(0, 0, At, B0); BAR;
    LDB_(B1, 1, 1); WAIT_V(0); BAR; WAIT_L(0); MMA(0, 1, At, B1); BAR;
    LDA_(At, 1, 1); BAR; WAIT_L(0); MMA(1, 0, At, B0); MMA(1, 1, At, B1); BAR; }
  if (wr == 0) BAR;
  if (SKIP == 2) {
    float s = 0.f;
#pragma unroll
    for (int ai = 0; ai < 2; ++ai)
#pragma unroll
      for (int bj = 0; bj < 2; ++bj)
#pragma unroll
        for (int m = 0; m < 4; ++m)
#pragma unroll
          for (int n = 0; n < 2; ++n) s += acc[ai][bj][m][n][0] + acc[ai][bj][m][n][1] + acc[ai][bj][m][n][2] + acc[ai][bj][m][n][3];
    if (s == 123.456f) ((float*)shmc)[0] = s;
    __syncthreads();
    return;
  }
  float* tile = (float*)shmc;
  {
    int t2 = tid_u; asm volatile("" : "+v"(t2));
    const int lane2 = t2 & 63, wid2 = t2 >> 6;
    tile += ((wid2 >> 2) * 64 + (lane2 >> 4) * 4) * TST + (wid2 & 3) * 32 + (lane2 & 15);
  }
#pragma unroll
  for (int ai = 0; ai < 2; ++ai) {
    if (ai) __syncthreads();
#pragma unroll
    for (int bj = 0; bj < 2; ++bj)
#pragma unroll
      for (int m = 0; m < 4; ++m)
#pragma unroll
        for (int n = 0; n < 2; ++n)
#pragma unroll
          for (int j = 0; j < 4; ++j)
            tile[(m * 16 + j) * TST + bj * 128 + n * 16] = acc[ai][bj][m][n][j];
    __syncthreads();
    if (SKIP == 0) epi((float*)shmc, brow + ai * 128, bcol);
  }
  __syncthreads();
}

DI void unit_to_tile(int u, int nM, int nN, int& pm, int& pn) {
  const int nig = 8 * nN, gid = u / nig, fm = gid * 8, gsz = min(nM - fm, 8);
  pm = fm + ((u % nig) % gsz); pn = (u % nig) / gsz;
}

#define FOR_CHUNKS(ci) const int tid_e##ci = tidx(); _Pragma("unroll 1") for (int ci = 0; ci < 8; ++ci)
#define CHUNK_SETUP(ci) int tx_ = tid_e##ci; asm volatile("" : "+v"(tx_)); const int idx_ = ci * 512 + tx_; const int lr = idx_ >> 5, lc = (idx_ & 31) * 8; \
    const int row = r0 + lr, col = bcol + lc; float v[8]; \
    { const float4 a_ = *reinterpret_cast<const float4*>(tile + lr * TST + lc), b_ = *reinterpret_cast<const float4*>(tile + lr * TST + lc + 4); \
      v[0] = a_.x; v[1] = a_.y; v[2] = a_.z; v[3] = a_.w; v[4] = b_.x; v[5] = b_.y; v[6] = b_.z; v[7] = b_.w; }
DI uint4 pack8(const float* v) { uint4 o; o.x = pack2(v[0], v[1]); o.y = pack2(v[2], v[3]); o.z = pack2(v[4], v[5]); o.w = pack2(v[6], v[7]); return o; }
DI void unpack8(const uint4& u, float* f) {
  f[0] = __uint_as_float(u.x << 16); f[1] = __uint_as_float(u.x & 0xffff0000u); f[2] = __uint_as_float(u.y << 16); f[3] = __uint_as_float(u.y & 0xffff0000u);
  f[4] = __uint_as_float(u.z << 16); f[5] = __uint_as_float(u.z & 0xffff0000u); f[6] = __uint_as_float(u.w << 16); f[7] = __uint_as_float(u.w & 0xffff0000u);
}
DI void ld8f(const float* p, float* f) { const float4 a = *reinterpret_cast<const float4*>(p), b = *reinterpret_cast<const float4*>(p + 4);
  f[0] = a.x; f[1] = a.y; f[2] = a.z; f[3] = a.w; f[4] = b.x; f[5] = b.y; f[6] = b.z; f[7] = b.w; }

struct EpiStoreBf16 {
  bfr* C; int ldc;
  DI void operator()(float* tile, int r0, int bcol) const {
    FOR_CHUNKS(ci) { CHUNK_SETUP(ci); *reinterpret_cast<uint4*>(C + (long)row * ldc + col) = pack8(v); }
  }
};
struct EpiGate {
  bfr* G; bfr* halo;
  DI void operator()(float* tile, int r0, int bcol) const {
    FOR_CHUNKS(ci) { CHUNK_SETUP(ci); const uint4 pk = pack8(v);
      *reinterpret_cast<uint4*>(G + (long)row * DFF + col) = pk;
      if (lr == 0) *reinterpret_cast<uint4*>(halo + ((long)(row >> 7) * 2 + 0) * DFF + col) = pk;
      if (lr == 127) *reinterpret_cast<uint4*>(halo + ((long)(row >> 7) * 2 + 1) * DFF + col) = pk;
    }
  }
};
#define CH_LR(ci, tx) (((ci) * 512 + (tx)) >> 5)
#define CH_LC(ci, tx) ((((ci) * 512 + (tx)) & 31) * 8)
struct EpiUp {
  bfr* G; const bfr* halo; const float* cw; const float* cb;
  DI void operator()(float* tile, int r0, int bcol) const {
    const int tx = tidx();
    const int lc = (tx & 31) * 8, col = bcol + lc;
    float wm[8], wc[8], wp[8], wb[8];
    ld8f(cw + col, wm); ld8f(cw + DFF + col, wc); ld8f(cw + 2 * DFF + col, wp); ld8f(cb + col, wb);
#pragma unroll
    for (int c0 = 0; c0 < 8; c0 += 4) {
      uint4 q0[4], qm[4], qp[4];
#pragma unroll
      for (int k4 = 0; k4 < 4; ++k4) {
        const int lr = CH_LR(c0 + k4, tx), row = r0 + lr;
        const long idx = (long)row * DFF + col; const int t = row & (S - 1), hb = row >> 7;
        q0[k4] = *reinterpret_cast<const uint4*>(G + idx);
        qm[k4] = make_uint4(0, 0, 0, 0); qp[k4] = make_uint4(0, 0, 0, 0);
        if (t != 0) qm[k4] = lr == 0 ? *reinterpret_cast<const uint4*>(halo + ((long)(hb - 1) * 2 + 1) * DFF + col) : *reinterpret_cast<const uint4*>(G + idx - DFF);
        if (t != S - 1) qp[k4] = lr == 127 ? *reinterpret_cast<const uint4*>(halo + ((long)(hb + 1) * 2 + 0) * DFF + col) : *reinterpret_cast<const uint4*>(G + idx + DFF);
      }
#pragma unroll
      for (int k4 = 0; k4 < 4; ++k4) {
        const int lr = CH_LR(c0 + k4, tx);
        float v[8], g0[8], gm[8], gp[8];
        ld8f(tile + lr * TST + lc, v);
        unpack8(q0[k4], g0); unpack8(qm[k4], gm); unpack8(qp[k4], gp);
#pragma unroll
        for (int k = 0; k < 8; ++k) v[k] = silu(wb[k] + wm[k] * gm[k] + wc[k] * g0[k] + wp[k] * gp[k]) * v[k];
        *reinterpret_cast<uint4*>(tile + lr * TST + lc) = pack8(v);
      }
    }
    __syncthreads();
#pragma unroll
    for (int ci = 0; ci < 8; ++ci) {
      const int lr = CH_LR(ci, tx);
      *reinterpret_cast<uint4*>(G + (long)(r0 + lr) * DFF + col) = *reinterpret_cast<const uint4*>(tile + lr * TST + lc);
    }
  }
};
DI void row_stats_add(float* stats, int row, const float* v, int tx) {
  float s1 = 0.f, s2 = 0.f;
#pragma unroll
  for (int k = 0; k < 8; ++k) { s1 += v[k]; s2 += v[k] * v[k]; }
  s1 += swz_xor<16>(s1); s2 += swz_xor<16>(s2); s1 += swz_xor<8>(s1); s2 += swz_xor<8>(s2); s1 += swz_xor<4>(s1); s2 += swz_xor<4>(s2);
  s1 += swz_xor<2>(s1); s2 += swz_xor<2>(s2); s1 += swz_xor<1>(s1); s2 += swz_xor<1>(s2);
  if ((tx & 31) == 0) { float2* sp = reinterpret_cast<float2*>(stats) + (row & 255); float2 s = *sp; s.x += s1; s.y += s2; *sp = s; }
}
struct EpiResid {
  bfr* out; const bfr* hb; float* stats;
  DI void operator()(float* tile, int r0, int bcol) const {
    const int tx = tidx();
#pragma unroll
    for (int c0 = 0; c0 < 8; c0 += 4) {
      uint4 hq[4];
#pragma unroll
      for (int k4 = 0; k4 < 4; ++k4) hq[k4] = *reinterpret_cast<const uint4*>(hb + (long)(r0 + CH_LR(c0 + k4, tx)) * D + bcol + CH_LC(c0 + k4, tx));
#pragma unroll
      for (int k4 = 0; k4 < 4; ++k4) {
        const int lr = CH_LR(c0 + k4, tx), lc = CH_LC(c0 + k4, tx), row = r0 + lr;
        bfr* op = out + (long)row * D + bcol + lc;
        float v[8], o[8];
        ld8f(tile + lr * TST + lc, v); unpack8(hq[k4], o);
#pragma unroll
        for (int k = 0; k < 8; ++k) o[k] = ALPHA * o[k] + v[k];
        *reinterpret_cast<uint4*>(op) = pack8(o);
        row_stats_add(stats, row, o, tx);
      }
    }
  }
};
struct EpiPle {
  bfr* out; float* out32; const bfr* hb; const bfr* E; const float* bg; float* stats;
  DI void operator()(float* tile, int r0, int bcol) const {
    const int tx = tidx();
#pragma unroll
    for (int c0 = 0; c0 < 8; c0 += 4) {
      uint4 hq[4], eq[4];
#pragma unroll
      for (int k4 = 0; k4 < 4; ++k4) {
        const long idx = (long)(r0 + CH_LR(c0 + k4, tx)) * D + bcol + CH_LC(c0 + k4, tx);
        hq[k4] = *reinterpret_cast<const uint4*>(hb + idx);
        eq[k4] = *reinterpret_cast<const uint4*>(E + idx);
      }
#pragma unroll
      for (int k4 = 0; k4 < 4; ++k4) {
        const int lr = CH_LR(c0 + k4, tx), lc = CH_LC(c0 + k4, tx), row = r0 + lr, col = bcol + lc;
        bfr* op = out + (long)row * D + col;
        float v[8], o[8], e[8], bgv[8];
        ld8f(tile + lr * TST + lc, v); ld8f(bg + col, bgv); unpack8(eq[k4], e); unpack8(hq[k4], o);
#pragma unroll
        for (int k = 0; k < 8; ++k) o[k] = ALPHA * o[k] + e[k] * sigmoidf(v[k] + bgv[k]);
        if (out32) { float* o32 = out32 + (long)row * D + col; *reinterpret_cast<float4*>(o32) = make_float4(o[0], o[1], o[2], o[3]); *reinterpret_cast<float4*>(o32 + 4) = make_float4(o[4], o[5], o[6], o[7]); }
        else *reinterpret_cast<uint4*>(op) = pack8(o);
        row_stats_add(stats, row, o, tx);
      }
    }
  }
};
struct EpiQ {
  bfr* Q; const float* rs; const float2* rope;
  DI void operator()(float* tile, int r0, int bcol) const {
    FOR_CHUNKS(ci) { CHUNK_SETUP(ci);
      if (col < 384) {
        const int head = col / 96, d0 = col % 96; const float rstd = rs[row & 255]; const int b = row >> 11, t = row & (S - 1);
        if (d0 >= 64) {
          const bool lo = d0 < 80; const int jj = (d0 - (lo ? 64 : 80));
          float pw[8]; ld8f(tile + lr * TST + lc + (lo ? 16 : -16), pw);
#pragma unroll
          for (int k = 0; k < 8; ++k) { const float2 cs = rope[t * 16 + jj + k];
            v[k] = lo ? (v[k] * cs.x - pw[k] * cs.y) : (v[k] * cs.x + pw[k] * cs.y); }
        }
#pragma unroll
        for (int k = 0; k < 8; ++k) v[k] *= rstd;
        *reinterpret_cast<uint4*>(Q + (((long)(b * 4 + head)) * S + t) * 96 + d0) = pack8(v);
      }
    }
  }
};
struct EpiKV {
  bfr* Kf; bfr* VT; const float* rs;
  DI void operator()(float* tile, int r0, int bcol) const {
    FOR_CHUNKS(ci) { CHUNK_SETUP(ci);
      if ((col & 127) < 64) {
        const int head = col >> 7, d0 = col & 127; const float rstd = rs[row & 255]; const int b = row >> 11, t = row & (S - 1);
#pragma unroll
        for (int k = 0; k < 8; ++k) v[k] *= rstd;
        *reinterpret_cast<uint4*>(Kf + (((long)(b * 4 + head)) * S + t) * 96 + d0) = pack8(v);
      }
    }
    const int b = r0 >> 11, t0 = r0 & (S - 1);
#pragma unroll 1
    for (int it = tidx(); it < 2048; it += NTHREADS) {
      const int vc = it & 127, rc = it >> 7, lcol = (vc >> 6) * 128 + 64 + (vc & 63), lr0 = rc * 8;
      const int head = (bcol + lcol) >> 7, dd = vc & 63;
      float v[8];
#pragma unroll
      for (int k = 0; k < 8; ++k) v[k] = tile[(lr0 + k) * TST + lcol] * rs[(r0 + lr0 + k) & 255];
      *reinterpret_cast<uint4*>(VT + (((long)(b * 4 + head)) * 64 + dd) * S + t0 + lr0) = pack8(v);
    }
  }
};

#define MFMA32(a, b, c) __builtin_amdgcn_mfma_f32_32x32x16_bf16((a), (b), (c), 0, 0, 0)
template <int DQK, bool SWA>
DI void attn_item(const bfr* __restrict__ qb, long q_ld, const bfr* __restrict__ kb, long k_ld, const bfr* __restrict__ vb, long v_ld,
                  int q0, int key_lo, int key_hi, float scale_l2e, float slope_l2e, float sink_l2e,
                  bfr* __restrict__ outp, long out_ld, char* shm) {
  constexpr int KST = DQK + 8;
  constexpr int VST = 72;
  constexpr int NKK = DQK / 16;
  bfr* Ks = (bfr*)shm;
  bfr* Vt = Ks + 64 * KST;
  const int tid = tidx(), wid = tid >> 6, lane = tid & 63, r = lane & 31, h = lane >> 5;
  const int qrow = q0 + wid * 32 + r;
  bf16x8 qf[NKK];
#pragma unroll
  for (int kk = 0; kk < NKK; ++kk) qf[kk] = *reinterpret_cast<const bf16x8*>(qb + (long)qrow * q_ld + kk * 16 + h * 8);
  f32x16 o[2];
#pragma unroll
  for (int i = 0; i < 16; ++i) { o[0][i] = 0.f; o[1][i] = 0.f; }
  float mrun = SWA ? sink_l2e : -1e30f, lrun = SWA ? 1.f : 0.f;
  constexpr int KCH = DQK / 8;
  constexpr bool K2 = (64 * KCH > NTHREADS);
  uint4 pk0, pk1 = make_uint4(0, 0, 0, 0), pvv;
  const int vrow = tid >> 3, vch = tid & 7;
  const int kr0 = tid / KCH, kc0 = (tid % KCH) * 8, kr1 = (tid + NTHREADS) / KCH, kc1 = ((tid + NTHREADS) % KCH) * 8;
  const bool has1 = K2 && (tid + NTHREADS < 64 * KCH);
#define ATT_LOAD(kt_) do { \
    pk0 = *reinterpret_cast<const uint4*>(kb + (long)((kt_) + kr0) * k_ld + kc0); \
    if (has1) pk1 = *reinterpret_cast<const uint4*>(kb + (long)((kt_) + kr1) * k_ld + kc1); \
    pvv = SWA ? *reinterpret_cast<const uint4*>(vb + (long)((kt_) + vrow) * v_ld + vch * 8) \
              : *reinterpret_cast<const uint4*>(vb + (long)vrow * v_ld + (kt_) + vch * 8); } while (0)
  ATT_LOAD(key_lo);
  for (int kt = key_lo; kt < key_hi; kt += 64) {
    __syncthreads();
    *reinterpret_cast<uint4*>(Ks + kr0 * KST + kc0) = pk0;
    if (has1) *reinterpret_cast<uint4*>(Ks + kr1 * KST + kc1) = pk1;
    if (SWA) {
      bfr* vp = Vt + (vch * 8) * VST + vrow;
      vp[0 * VST] = (bfr)(pvv.x & 0xffffu); vp[1 * VST] = (bfr)(pvv.x >> 16);
      vp[2 * VST] = (bfr)(pvv.y & 0xffffu); vp[3 * VST] = (bfr)(pvv.y >> 16);
      vp[4 * VST] = (bfr)(pvv.z & 0xffffu); vp[5 * VST] = (bfr)(pvv.z >> 16);
      vp[6 * VST] = (bfr)(pvv.w & 0xffffu); vp[7 * VST] = (bfr)(pvv.w >> 16);
    } else {
      *reinterpret_cast<uint4*>(Vt + vrow * VST + vch * 8) = pvv;
    }
    if (kt + 64 < key_hi) ATT_LOAD(kt + 64);
    __syncthreads();
    f32x16 s[2];
#pragma unroll
    for (int kh = 0; kh < 2; ++kh) {
#pragma unroll
      for (int i = 0; i < 16; ++i) s[kh][i] = 0.f;
#pragma unroll
      for (int kk = 0; kk < NKK; ++kk) {
        const bf16x8 a = *reinterpret_cast<const bf16x8*>(Ks + (kh * 32 + r) * KST + kk * 16 + h * 8);
        s[kh] = MFMA32(a, qf[kk], s[kh]);
      }
    }
    float mx = -1e30f;
    if (SWA) {
#pragma unroll
      for (int kh = 0; kh < 2; ++kh)
#pragma unroll
        for (int i = 0; i < 16; ++i) {
          const int kpos = kt + kh * 32 + (i & 3) + 8 * (i >> 2) + 4 * h;
          const int dist = abs(qrow - kpos);
          const float v = (dist <= 128) ? s[kh][i] * scale_l2e - slope_l2e * (float)dist : -1e30f;
          s[kh][i] = v; mx = fmaxf(mx, v);
        }
    } else {
#pragma unroll
      for (int kh = 0; kh < 2; ++kh)
#pragma unroll
        for (int i = 0; i < 16; ++i) mx = fmaxf(mx, s[kh][i]);
      mx *= scale_l2e;
    }
    mx = fmaxf(mx, __shfl_xor(mx, 32));
    const float mnew = fmaxf(mrun, mx);
    float ps = 0.f;
    if (SWA) {
#pragma unroll
      for (int kh = 0; kh < 2; ++kh)
#pragma unroll
        for (int i = 0; i < 16; ++i) { const float p = exp2f(s[kh][i] - mnew); s[kh][i] = p; ps += p; }
    } else {
#pragma unroll
      for (int kh = 0; kh < 2; ++kh)
#pragma unroll
        for (int i = 0; i < 16; ++i) { const float p = exp2f(fmaf(s[kh][i], scale_l2e, -mnew)); s[kh][i] = p; ps += p; }
    }
    ps += __shfl_xor(ps, 32);
    if (__any(mnew > mrun)) {
      const float corr = exp2f(mrun - mnew);
      lrun *= corr;
#pragma unroll
      for (int i = 0; i < 16; ++i) { o[0][i] *= corr; o[1][i] *= corr; }
    }
    lrun += ps; mrun = mnew;
#pragma unroll
    for (int kh = 0; kh < 2; ++kh)
#pragma unroll
      for (int s2 = 0; s2 < 2; ++s2) {
        uint4 pbu;
        pbu.x = pack2(s[kh][8 * s2 + 0], s[kh][8 * s2 + 1]); pbu.y = pack2(s[kh][8 * s2 + 2], s[kh][8 * s2 + 3]);
        pbu.z = pack2(s[kh][8 * s2 + 4], s[kh][8 * s2 + 5]); pbu.w = pack2(s[kh][8 * s2 + 6], s[kh][8 * s2 + 7]);
        const bf16x8 pb = __builtin_bit_cast(bf16x8, pbu);
#pragma unroll
        for (int dt = 0; dt < 2; ++dt) {
          const bfr* vp = Vt + (dt * 32 + r) * VST + kh * 32 + 16 * s2 + 4 * h;
          const s16x4 lo = *reinterpret_cast<const s16x4*>(vp);
          const s16x4 hi = *reinterpret_cast<const s16x4*>(vp + 8);
          const bf16x8 a = __builtin_shufflevector(lo, hi, 0, 1, 2, 3, 4, 5, 6, 7);
          o[dt] = MFMA32(a, pb, o[dt]);
        }
      }
  }
  const float inv = 1.f / lrun;
#pragma unroll
  for (int dt = 0; dt < 2; ++dt)
#pragma unroll
    for (int g = 0; g < 4; ++g) {
      uint2 pk; pk.x = pack2(o[dt][4 * g] * inv, o[dt][4 * g + 1] * inv); pk.y = pack2(o[dt][4 * g + 2] * inv, o[dt][4 * g + 3] * inv);
      *reinterpret_cast<uint2*>(outp + (long)qrow * out_ld + dt * 32 + 8 * g + 4 * h) = pk;
    }
}

DI float2 cmul(float2 a, float2 b) { return make_float2(a.x * b.x - a.y * b.y, a.x * b.y + a.y * b.x); }
DI float2 cmulc(float2 a, float2 b) { return make_float2(a.x * b.x + a.y * b.y, a.y * b.x - a.x * b.y); }
constexpr int FST_A = 272, FST_B = 17, FFT_LDS = 16 * FST_A;
DI int fpos(int n) { return (n >> 8) * FST_A + ((n >> 4) & 15) * FST_B + (n & 15); }
DI float2 twid(const float2* TW, int m) {
  const float2 w = TW[m & 2047];
  return (m & 2048) ? make_float2(-w.x, -w.y) : w;
}
DI void dft16_fwd(float2* v) {
  const float C8 = 0.92387953251128674f, S8 = 0.38268343236508977f, R2 = 0.70710678118654752f;
  const float2 w16[8] = {{1.f, 0.f}, {C8, -S8}, {R2, -R2}, {S8, -C8}, {0.f, -1.f}, {-S8, -C8}, {-R2, -R2}, {-C8, -S8}};
#pragma unroll
  for (int s = 0; s < 4; ++s) {
    const int half = 8 >> s;
#pragma unroll
    for (int j = 0; j < 8; ++j) {
      const int pos = j & (half - 1), i0 = ((j - pos) << 1) + pos, i1 = i0 + half;
      const float2 a = v[i0], b = v[i1];
      v[i0] = make_float2(a.x + b.x, a.y + b.y);
      v[i1] = cmul(make_float2(a.x - b.x, a.y - b.y), w16[pos << s]);
    }
  }
}
DI void dft16_inv(float2* v) {
  const float C8 = 0.92387953251128674f, S8 = 0.38268343236508977f, R2 = 0.70710678118654752f;
  const float2 w16[8] = {{1.f, 0.f}, {C8, -S8}, {R2, -R2}, {S8, -C8}, {0.f, -1.f}, {-S8, -C8}, {-R2, -R2}, {-C8, -S8}};
#pragma unroll
  for (int s = 3; s >= 0; --s) {
    const int half = 8 >> s;
#pragma unroll
    for (int j = 0; j < 8; ++j) {
      const int pos = j & (half - 1), i0 = ((j - pos) << 1) + pos, i1 = i0 + half;
      const float2 a = v[i0], b = cmulc(v[i1], w16[pos << s]);
      v[i0] = make_float2(a.x + b.x, a.y + b.y);
      v[i1] = make_float2(a.x - b.x, a.y - b.y);
    }
  }
}
DI int brev4(int i) { return ((i & 1) << 3) | ((i & 2) << 1) | ((i & 4) >> 1) | ((i & 8) >> 3); }
DI void fft_fwd(float2* X, const float2* TW, const int t) {
  float2 v[16];
  const int hi = t >> 4, lo = t & 15;
  {
    float2* p = X + hi * FST_B + lo;
#pragma unroll
    for (int i = 0; i < 16; ++i) v[i] = p[i * FST_A];
    dft16_fwd(v);
#pragma unroll
    for (int i = 0; i < 16; ++i) p[i * FST_A] = cmul(v[i], twid(TW, t * brev4(i)));
  }
  __syncthreads();
  {
    float2* p = X + hi * FST_A + lo;
#pragma unroll
    for (int i = 0; i < 16; ++i) v[i] = p[i * FST_B];
    dft16_fwd(v);
#pragma unroll
    for (int i = 0; i < 16; ++i) p[i * FST_B] = cmul(v[i], twid(TW, 16 * lo * brev4(i)));
  }
  __syncthreads();
  {
    float2* p = X + hi * FST_A + lo * FST_B;
#pragma unroll
    for (int i = 0; i < 16; ++i) v[i] = p[i];
    dft16_fwd(v);
#pragma unroll
    for (int i = 0; i < 16; ++i) p[i] = v[i];
  }
  __syncthreads();
}
DI void fft_inv(float2* X, const float2* TW, const int t) {
  float2 v[16];
  const int hi = t >> 4, lo = t & 15;
  {
    float2* p = X + hi * FST_A + lo * FST_B;
#pragma unroll
    for (int i = 0; i < 16; ++i) v[i] = p[i];
    dft16_inv(v);
#pragma unroll
    for (int i = 0; i < 16; ++i) p[i] = v[i];
  }
  __syncthreads();
  {
    float2* p = X + hi * FST_A + lo;
#pragma unroll
    for (int i = 0; i < 16; ++i) v[i] = cmulc(p[i * FST_B], twid(TW, 16 * lo * brev4(i)));
    dft16_inv(v);
#pragma unroll
    for (int i = 0; i < 16; ++i) p[i * FST_B] = v[i];
  }
  __syncthreads();
  {
    float2* p = X + hi * FST_B + lo;
#pragma unroll
    for (int i = 0; i < 16; ++i) v[i] = cmulc(p[i * FST_A], twid(TW, t * brev4(i)));
    dft16_inv(v);
#pragma unroll
    for (int i = 0; i < 16; ++i) p[i * FST_A] = v[i];
  }
  __syncthreads();
}

DI void transpose_convert(const float* src, int K, int N, bfr* dst, int Kp, int Np, const float* kscale, char* shm) {
  float* tile = (float*)shm;
  const int tk = Kp / 64, tn = Np / 64;
  const int tid = tidx();
#pragma unroll 1
  for (int it = blockIdx.x; it < tk * tn; it += gridDim.x) {
    const int k0 = (it % tk) * 64, n0 = (it / tk) * 64;
    __syncthreads();
    float4 v[2];
#pragma unroll
    for (int q = 0; q < 2; ++q) {
      const int idx = tid + q * NTHREADS, kk = idx >> 4, n4 = (idx & 15) * 4, k = k0 + kk, n = n0 + n4;
      v[q] = make_float4(0.f, 0.f, 0.f, 0.f);
      if (k < K && n < N) { v[q] = *reinterpret_cast<const float4*>(src + (long)k * N + n); if (kscale) { const float sc = kscale[k]; v[q].x *= sc; v[q].y *= sc; v[q].z *= sc; v[q].w *= sc; } }
    }
#pragma unroll
    for (int q = 0; q < 2; ++q) { const int idx = tid + q * NTHREADS; *reinterpret_cast<float4*>(tile + (idx >> 4) * 68 + (idx & 15) * 4) = v[q]; }
    __syncthreads();
#pragma unroll
    for (int q = 0; q < 2; ++q) {
      const int idx = tid + q * NTHREADS, nn = idx >> 4, k4 = (idx & 15) * 4;
      uint2 pk; pk.x = pack2(tile[k4 * 68 + nn], tile[(k4 + 1) * 68 + nn]); pk.y = pack2(tile[(k4 + 2) * 68 + nn], tile[(k4 + 3) * 68 + nn]);
      *reinterpret_cast<uint2*>(dst + (long)(n0 + nn) * Kp + k0 + k4) = pk;
    }
  }
}

DI void ln_rows(const float* src, float* dst32, bfr* dstb, const float* g, const float* bta) {
  const int wid = tidx() >> 6, lane = tidx() & 63;
#pragma unroll 1
  for (int row0 = (blockIdx.x * 8 + wid) * 2; row0 < NT; row0 += gridDim.x * 16) {
    float4 v[2][4];
#pragma unroll
    for (int q = 0; q < 2; ++q)
#pragma unroll
      for (int i = 0; i < 4; ++i) v[q][i] = reinterpret_cast<const float4*>(src + (long)(row0 + q) * D)[i * 64 + lane];
#pragma unroll
    for (int q = 0; q < 2; ++q) {
      const int row = row0 + q;
      float sum = 0.f;
#pragma unroll
      for (int i = 0; i < 4; ++i) sum += v[q][i].x + v[q][i].y + v[q][i].z + v[q][i].w;
#pragma unroll
      for (int o = 32; o >= 1; o >>= 1) sum += __shfl_xor(sum, o);
      const float mu = sum * (1.f / D);
      float sq = 0.f;
#pragma unroll
      for (int i = 0; i < 4; ++i) { v[q][i].x -= mu; v[q][i].y -= mu; v[q][i].z -= mu; v[q][i].w -= mu; sq += v[q][i].x * v[q][i].x + v[q][i].y * v[q][i].y + v[q][i].z * v[q][i].z + v[q][i].w * v[q][i].w; }
#pragma unroll
      for (int o = 32; o >= 1; o >>= 1) sq += __shfl_xor(sq, o);
      const float rstd = rsqrtf(sq * (1.f / D) + 1e-5f);
#pragma unroll
      for (int i = 0; i < 4; ++i) {
        const int c4 = i * 64 + lane;
        const float4 gg = reinterpret_cast<const float4*>(g)[c4], bb = reinterpret_cast<const float4*>(bta)[c4];
        float4 y; y.x = v[q][i].x * rstd * gg.x + bb.x; y.y = v[q][i].y * rstd * gg.y + bb.y; y.z = v[q][i].z * rstd * gg.z + bb.z; y.w = v[q][i].w * rstd * gg.w + bb.w;
        if (dst32) reinterpret_cast<float4*>(dst32 + (long)row * D)[c4] = y;
        uint2 pk; pk.x = pack2(y.x, y.y); pk.y = pack2(y.z, y.w);
        reinterpret_cast<uint2*>(dstb + (long)row * D)[c4] = pk;
      }
    }
  }
}

DI void phase_prep(const PX& P, char* shm) {
  char* ws = P.ws;
  for (int l = 0; l < NL; ++l) {
    bfr* W = (bfr*)(ws + WS_W) + (size_t)l * EW_LAYER;
    transpose_convert(P.in[4] + (size_t)l * 1024 * INW, 1024, INW, W + WO_IN, 1024, 2816, nullptr, shm);
    transpose_convert(P.in[7] + (size_t)l * 256 * 384, 256, 384, W + WO_UQ, 256, 512, P.in[5] + l * 256, shm);
    transpose_convert(P.in[8] + (size_t)l * 128 * 512, 128, 512, W + WO_UKV, 256, 512, P.in[6] + l * 128, shm);
    transpose_convert(P.in[25] + (size_t)l * 1024 * 1024, 1024, 1024, W + WO_OUT, 1024, 1024, P.in[24] + l * 1024, shm);
    transpose_convert(P.in[28] + (size_t)l * 1024 * DFF, 1024, DFF, W + WO_G, 1024, DFF, nullptr, shm);
    transpose_convert(P.in[29] + (size_t)l * 1024 * DFF, 1024, DFF, W + WO_U, 1024, DFF, nullptr, shm);
    transpose_convert(P.in[32] + (size_t)l * DFF * 1024, DFF, 1024, W + WO_D, DFF, 1024, nullptr, shm);
    transpose_convert(P.in[35] + (size_t)l * 256 * 1024, 256, 1024, W + WO_PP, 256, 1024, nullptr, shm);
    transpose_convert(P.in[36] + (size_t)l * 1024 * 1024, 1024, 1024, W + WO_PG, 1024, 1024, nullptr, shm);
  }
  __syncthreads();
  {
    float2* rope = (float2*)(ws + WS_ROPE);
    float2* tw = (float2*)(ws + WS_TW);
    for (int e = blockIdx.x * NTHREADS + tidx(); e < 2048 * 16 + 2048; e += gridDim.x * NTHREADS) {
      if (e < 2048 * 16) {
        const int t = e >> 4, j = e & 15;
        const float invf = exp2f(-(float)j * (13.287712379549449f / 16.0f));
        const float ang = (float)t * invf;
        float sn, cs; sincosf(ang, &sn, &cs);
        rope[e] = make_float2(cs, sn);
      } else {
        const int k = e - 2048 * 16;
        float sn, cs; sincospif((float)k * (1.0f / 2048.0f), &sn, &cs);
        tw[k] = make_float2(cs, -sn);
      }
    }
  }
  {
    float* sm = (float*)shm;
    float* kbuf = (float*)(ws + WS_KBUF);
    const int tid = tidx();
#pragma unroll 1
    for (int it = blockIdx.x; it < NL * (S / 4); it += gridDim.x) {
      const int l = it / (S / 4), tb = (it % (S / 4)) * 4;
      const float* w1 = P.in[11] + l * 33 * 64; const float* b1 = P.in[12] + l * 64; const float* fq = P.in[13] + l * 64;
      const float* w2 = P.in[14] + l * 64 * 64; const float* b2 = P.in[15] + l * 64; const float* w3 = P.in[16] + (size_t)l * 64 * 1024;
      __syncthreads();
      if (tid < 4 * 33) {
        const int q = tid / 33, i = tid % 33, t = tb + q;
        float f;
        if (i == 0) f = (float)t / 2047.0f;
        else {
          const int bi = (i - 1) & 15;
          const float band = 1e-4f + (float)bi * ((15.0f - 1e-4f) / 15.0f);
          const float ang = 6.283185307179586f * (float)t / 2048.0f;
          const float a = band * ang;
          f = (i <= 16) ? cosf(a) : -sinf(a);
        }
        sm[q * 64 + i] = f;
      }
      __syncthreads();
      if (tid < 256) {
        const int q = tid >> 6, j = tid & 63; float a = b1[j];
        for (int i = 0; i < 33; ++i) a += sm[q * 64 + i] * w1[i * 64 + j];
        sm[256 + q * 64 + j] = sinf(fq[j] * a);
      }
      __syncthreads();
      if (tid < 256) {
        const int q = tid >> 6, j = tid & 63; float a = b2[j];
        for (int i = 0; i < 64; ++i) a += sm[256 + q * 64 + i] * w2[i * 64 + j];
        sm[512 + q * 64 + j] = sinf(fq[j] * a);
      }
      __syncthreads();
#pragma unroll 1
      for (int oc = tid; oc < 1024; oc += NTHREADS) {
        float a0 = 0.f, a1 = 0.f, a2 = 0.f, a3 = 0.f;
#pragma unroll 8
        for (int i = 0; i < 64; ++i) { const float w = w3[i * 1024 + oc]; a0 += sm[512 + i] * w; a1 += sm[576 + i] * w; a2 += sm[640 + i] * w; a3 += sm[704 + i] * w; }
        const int o = oc >> 9, dir = (oc >> 8) & 1, c = oc & 255;
        const float mind = -3.0701134573253945f, maxd = -15.350567286626973f;
        const float delta = fabsf(mind + (float)c * ((maxd - mind) / 255.0f));
        float* kb = kbuf + ((size_t)((l * 2 + o) * 256 + c)) * 4096;
        const float av[4] = {a0, a1, a2, a3};
#pragma unroll
        for (int q = 0; q < 4; ++q) {
          const int t = tb + q;
          const float a = av[q] * expf(-((float)t / 2047.0f) * delta);
          if (dir == 0) kb[t] = a;
          else { if (t == 0) kb[2048] = 0.f; else kb[4096 - t] = a; }
        }
      }
    }
  }
  ln_rows(P.in[0], nullptr, (bfr*)(ws + WS_HB), P.in[2], P.in[3]);
}

DI void phase_gemm_in(const PX& P, int l, char* shm, int skip = 0) {
  const bfr* A = (const bfr*)(P.ws + WS_HB);
  const bfr* Bt = (const bfr*)(P.ws + WS_W) + (size_t)l * EW_LAYER + WO_IN;
  EpiStoreBf16 epi{(bfr*)(P.ws + WS_U), INP};
  for (int u = blockIdx.x; u < 256 * 11; u += gridDim.x) {
    int pm, pn; unit_to_tile(u, 256, 11, pm, pn);
#if PROBE_GEMM
    if (skip) gemm_unit<1024, 1024, EpiStoreBf16, PROBE_GEMM>(A, Bt, 1024, pm * 256, pn * 256, shm, epi);
    else
#endif
    gemm_unit<1024, 1024>(A, Bt, 1024, pm * 256, pn * 256, shm, epi);
  }
}

template <int NCOL>
DI void row_rstd(const bfr* Ucol, int brow, float* rs) {
  const int r = tidx() >> 1, hf = tidx() & 1;
  const unsigned uoff = (unsigned)(brow + r) * (unsigned)INP + (unsigned)(hf * NCOL);
  const bfr* up = Ucol + uoff;
  float ss = 0.f;
  uint4 q[NCOL / 8];
#pragma unroll
  for (int c = 0; c < NCOL / 8; ++c) q[c] = *reinterpret_cast<const uint4*>(up + c * 8);
#pragma unroll
  for (int c = 0; c < NCOL / 8; ++c) {
    float f[8]; unpack8(q[c], f);
#pragma unroll
    for (int e = 0; e < 8; ++e) ss += f[e] * f[e];
  }
  ss += __shfl_xor(ss, 1);
  if (hf == 0) rs[r] = rsqrtf(ss / (float)(2 * NCOL) + 1e-6f);
  __syncthreads();
}

DI void phase_premix(const PX& P, int l, char* shm) {
  char* ws = P.ws;
  const bfr* U = (const bfr*)(ws + WS_U);
  const bfr* W = (const bfr*)(ws + WS_W) + (size_t)l * EW_LAYER;
  float* rs = (float*)(shm + 135168);
  const float2* rope = (const float2*)(ws + WS_ROPE);
#ifndef SKIP_Q
  {
    EpiQ epi{(bfr*)(ws + WS_Q), rs, rope};
#pragma unroll 1
    for (int it = blockIdx.x; it < 512; it += gridDim.x) {
      const int pn = it & 1, brow = (it >> 1) * 256;
      row_rstd<128>(U + OQ, brow, rs);
      gemm_unit<INP, 256>(U + OQ, W + WO_UQ, 256, brow, pn * 256, shm, epi);
    }
  }
#endif
#ifndef SKIP_KV
  {
    EpiKV epi{(bfr*)(ws + WS_K), (bfr*)(ws + WS_VT), rs};
#pragma unroll 1
    for (int it = blockIdx.x; it < 512; it += gridDim.x) {
      const int pn = it & 1, brow = (it >> 1) * 256;
      row_rstd<64>(U + OKV, brow, rs);
      gemm_unit<INP, 256>(U + OKV, W + WO_UKV, 256, brow, pn * 256, shm, epi);
    }
  }
#endif
  {
    bfr* Kf = (bfr*)(ws + WS_K);
    for (long e = (long)blockIdx.x * NTHREADS + tidx(); e < (long)NT * 16; e += (long)gridDim.x * NTHREADS) {
      const int jj = (int)(e & 15); const long row = e >> 4; const int b = (int)(row >> 11), t = (int)(row & (S - 1));
      const float x1 = bf2f(U[row * INP + OKR + jj]), x2 = bf2f(U[row * INP + OKR + 16 + jj]);
      const float2 cs = rope[t * 16 + jj];
      const bfr o1 = f2bf(x1 * cs.x - x2 * cs.y), o2 = f2bf(x2 * cs.x + x1 * cs.y);
#pragma unroll
      for (int hh = 0; hh < 4; ++hh) {
        bfr* kp = Kf + (((long)(b * 4 + hh)) * S + t) * 96 + 64 + jj;
        kp[0] = o1; kp[16] = o2;
      }
    }
  }
  {
    bfr* tile = (bfr*)shm;
    bfr* HYT = (bfr*)(ws + WS_HYT);
    const float* cw = P.in[9] + l * 3 * 768; const float* cbias = P.in[10] + l * 768;
    const int tid = tidx();
#pragma unroll 1
    for (int it = blockIdx.x; it < 1024; it += gridDim.x) {
      const int b = it >> 5, t0 = (it & 31) * 64;
      __syncthreads();
#pragma unroll 1
      for (int e0 = tid; e0 < 96 * 64; e0 += 4 * NTHREADS) {
        uint4 q0[4], qm[4], qp[4];
#pragma unroll
        for (int i = 0; i < 4; ++i) {
          const int e = e0 + i * NTHREADS, c8 = e % 96, tl = e / 96, t = t0 + tl;
          const bfr* ub = U + ((long)b * S + t) * INP + OHY + c8 * 8;
          q0[i] = *reinterpret_cast<const uint4*>(ub);
          qm[i] = make_uint4(0, 0, 0, 0); qp[i] = make_uint4(0, 0, 0, 0);
          if (t > 0) qm[i] = *reinterpret_cast<const uint4*>(ub - INP);
          if (t < S - 1) qp[i] = *reinterpret_cast<const uint4*>(ub + INP);
        }
#pragma unroll
        for (int i = 0; i < 4; ++i) {
          const int e = e0 + i * NTHREADS, c8 = e % 96, tl = e / 96, c = c8 * 8;
          float u0[8], um[8], up[8], w[8], a[8];
          unpack8(q0[i], u0); unpack8(qm[i], um); unpack8(qp[i], up);
          ld8f(cbias + c, a);
          ld8f(cw + c, w);
#pragma unroll
          for (int j = 0; j < 8; ++j) a[j] += w[j] * um[j];
          ld8f(cw + 768 + c, w);
#pragma unroll
          for (int j = 0; j < 8; ++j) a[j] += w[j] * u0[j];
          ld8f(cw + 1536 + c, w);
          const int tr = (tl + 2 * c8) & 63;
#pragma unroll
          for (int j = 0; j < 8; ++j) tile[(c + j) * 66 + tr] = f2bf(a[j] + w[j] * up[j]);
        }
      }
      __syncthreads();
#pragma unroll 1
      for (int e = tid; e < 768 * 8; e += NTHREADS) {
        const int c = e >> 3, ch = e & 7, rot = c >> 3;
        const unsigned* tp = reinterpret_cast<const unsigned*>(tile + c * 66);
        uint4 v; v.x = tp[(ch * 4 + rot) & 31]; v.y = tp[(ch * 4 + 1 + rot) & 31]; v.z = tp[(ch * 4 + 2 + rot) & 31]; v.w = tp[(ch * 4 + 3 + rot) & 31];
        *reinterpret_cast<uint4*>(HYT + ((long)(b * 768 + c)) * S + t0 + ch * 8) = v;
      }
    }
  }
  if (l == 0) {
    const int tid = tidx(), hw = tid >> 8, t = tid & 255;
    float2* X = (float2*)shm + hw * FFT_LDS; float2* TW = (float2*)(shm + 2 * FFT_LDS * 8);
    const float* kbuf = (const float*)(ws + WS_KBUF);
    float2* KF = (float2*)(ws + WS_KF);
    const float2* twg = (const float2*)(ws + WS_TW);
    for (int it0 = blockIdx.x * 2; it0 < 1024; it0 += gridDim.x * 2) {
      const int it = it0 + hw;
      __syncthreads();
      for (int e = tid; e < 2048; e += NTHREADS) TW[e] = twg[e];
      for (int e = t; e < 4096; e += 256) X[fpos(e)] = make_float2(kbuf[(size_t)it * 4096 + e], 0.f);
      __syncthreads();
      fft_fwd(X, TW, t);
      for (int e = t; e < 4096; e += 256) { const float2 v = X[fpos(e)]; KF[(size_t)it * 4096 + e] = make_float2(v.x * (1.f / 4096.f), v.y * (1.f / 4096.f)); }
    }
  }
}

DI void ssd_item(const PX& P, int l, int item, char* shm) {
  constexpr int ST = 136;
  const bfr* U = (const bfr*)(P.ws + WS_U);
  bfr* YS = (bfr*)(P.ws + WS_YSSD);
  const int b = item >> 3, dir = (item >> 2) & 1, hd = item & 3, g = hd >> 1;
  const int tid = tidx(), wid = tid >> 6, lane = tid & 63, r = lane & 31, h = lane >> 5;
  const float* cw = P.in[19] + l * 3 * 768; const float* cbias = P.in[20] + l * 768;
  const float dtb = P.in[21][l * 8 + dir * 4 + hd];
  const float Acoef = -__expf(P.in[22][l * 8 + dir * 4 + hd]);
  bfr* Cs = (bfr*)shm;
  bfr* Bs = Cs + 128 * ST;
  bfr* BTd = Bs + 128 * ST;
  bfr* XT = BTd + 128 * ST;
  bfr* Rb = XT + 64 * ST;
  float* acs = (float*)(Rb + 64 * ST);
  float* dts = acs + 128;
  f32x16 racc;
#pragma unroll
  for (int i = 0; i < 16; ++i) racc[i] = 0.f;
  for (int e = tid; e < 64 * ST / 2; e += NTHREADS) reinterpret_cast<unsigned*>(Rb)[e] = 0u;
#pragma unroll 1
  for (int ci = 0; ci < 16; ++ci) {
    __syncthreads();
    if (wid == 0) {
      float a2[2], d2[2];
#pragma unroll
      for (int q = 0; q < 2; ++q) {
        const int k = lane * 2 + q, step = ci * 128 + k, t = dir == 0 ? step : S - 1 - step;
        const float xr = bf2f(U[((long)b * S + t) * INP + ODT + dir * 4 + hd]) + dtb;
        d2[q] = xr > 20.f ? xr : log1pf(__expf(xr));
        a2[q] = d2[q] * Acoef;
      }
      const float pairsum = a2[0] + a2[1];
      float sc = pairsum;
      int lane_o = lane; asm volatile("" : "+v"(lane_o));
#pragma unroll
      for (int o = 1; o < 64; o <<= 1) { const float v = __shfl_up(sc, o); sc += (lane_o >= o) ? v : 0.f; }
      acs[lane * 2] = sc - a2[1]; acs[lane * 2 + 1] = sc;
      dts[lane * 2] = d2[0]; dts[lane * 2 + 1] = d2[1];
    }
    __syncthreads();
    const float atot = acs[127];
#pragma unroll 1
    for (int i0 = 0; i0 < 10; i0 += 5) {
      uint4 q0[5], qm[5], qp[5];
#pragma unroll
      for (int i = 0; i < 5; ++i) {
        const int it = tid + (i0 + i) * NTHREADS, k = it / 40, cc8 = it % 40;
        const int step = ci * 128 + k, t = dir == 0 ? step : S - 1 - step;
        const int col = cc8 < 8 ? hd * 64 + cc8 * 8 : (cc8 < 24 ? 256 + g * 128 + (cc8 - 8) * 8 : 512 + g * 128 + (cc8 - 24) * 8);
        const bfr* ub = U + ((long)b * S + t) * INP + OXBC + col;
        q0[i] = *reinterpret_cast<const uint4*>(ub);
        qm[i] = make_uint4(0, 0, 0, 0); qp[i] = make_uint4(0, 0, 0, 0);
        if (t > 0) qm[i] = *reinterpret_cast<const uint4*>(ub - INP);
        if (t < S - 1) qp[i] = *reinterpret_cast<const uint4*>(ub + INP);
      }
#pragma unroll
      for (int i = 0; i < 5; ++i) {
        const int it = tid + (i0 + i) * NTHREADS, k = it / 40, cc8 = it % 40;
        const int col = cc8 < 8 ? hd * 64 + cc8 * 8 : (cc8 < 24 ? 256 + g * 128 + (cc8 - 8) * 8 : 512 + g * 128 + (cc8 - 24) * 8);
        float u0[8], um[8], up[8], w[8], a[8];
        unpack8(q0[i], u0); unpack8(qm[i], um); unpack8(qp[i], up);
        ld8f(cbias + col, a);
        ld8f(cw + col, w);
#pragma unroll
        for (int j = 0; j < 8; ++j) a[j] += w[j] * um[j];
        ld8f(cw + 768 + col, w);
#pragma unroll
        for (int j = 0; j < 8; ++j) a[j] += w[j] * u0[j];
        ld8f(cw + 1536 + col, w);
#pragma unroll
        for (int j = 0; j < 8; ++j) a[j] = silu(a[j] + w[j] * up[j]);
        if (cc8 < 8) {
          const float dtk = dts[k];
#pragma unroll
          for (int j = 0; j < 8; ++j) XT[(cc8 * 8 + j) * ST + k] = f2bf(a[j] * dtk);
        } else if (cc8 < 24) {
          const int n0 = (cc8 - 8) * 8;
          *reinterpret_cast<uint4*>(Bs + k * ST + n0) = pack8(a);
          const float dec = __expf(atot - acs[k]);
#pragma unroll
          for (int j = 0; j < 8; ++j) BTd[(n0 + j) * ST + k] = f2bf(a[j] * dec);
        } else {
          *reinterpret_cast<uint4*>(Cs + k * ST + (cc8 - 24) * 8) = pack8(a);
        }
      }
    }
    __syncthreads();
    const int ti = wid >> 1;
    f32x16 cb[2];
#pragma unroll
    for (int q = 0; q < 2; ++q) {
      const int si = (wid & 1) * 2 + q;
#pragma unroll
      for (int i = 0; i < 16; ++i) cb[q][i] = 0.f;
      if (si <= ti) {
#pragma unroll
        for (int kk = 0; kk < 8; ++kk) {
          const bf16x8 av = *reinterpret_cast<const bf16x8*>(Cs + (32 * ti + r) * ST + kk * 16 + h * 8);
          const bf16x8 bv = *reinterpret_cast<const bf16x8*>(Bs + (32 * si + r) * ST + kk * 16 + h * 8);
          cb[q] = MFMA32(av, bv, cb[q]);
        }
      }
    }
    __syncthreads();
#pragma unroll
    for (int q = 0; q < 2; ++q) {
      const int si = (wid & 1) * 2 + q; int s = 32 * si + r; asm volatile("" : "+v"(s));
      const float as = acs[s];
#pragma unroll
      for (int i = 0; i < 16; ++i) {
        const int t = 32 * ti + (i & 3) + 8 * (i >> 2) + 4 * h;
        const float v = (s <= t) ? cb[q][i] * __expf(acs[t] - as) : 0.f;
        Bs[t * ST + s] = f2bf(v);
      }
    }
    __syncthreads();
    {
      const int pi = wid & 1;
      f32x16 y1, y2;
#pragma unroll
      for (int i = 0; i < 16; ++i) { y1[i] = 0.f; y2[i] = 0.f; }
#pragma unroll
      for (int kk = 0; kk < 8; ++kk) {
        const bf16x8 xv = *reinterpret_cast<const bf16x8*>(XT + (32 * pi + r) * ST + kk * 16 + h * 8);
        if (kk * 16 < 32 * ti + 32) {
          const bf16x8 mv = *reinterpret_cast<const bf16x8*>(Bs + (32 * ti + r) * ST + kk * 16 + h * 8);
          y1 = MFMA32(mv, xv, y1);
        }
        const bf16x8 cv = *reinterpret_cast<const bf16x8*>(Cs + (32 * ti + r) * ST + kk * 16 + h * 8);
        const bf16x8 rv = *reinterpret_cast<const bf16x8*>(Rb + (32 * pi + r) * ST + kk * 16 + h * 8);
        y2 = MFMA32(cv, rv, y2);
      }
#pragma unroll
      for (int i = 0; i < 16; ++i) {
        const int k = 32 * ti + (i & 3) + 8 * (i >> 2) + 4 * h;
        const int step = ci * 128 + k, t = dir == 0 ? step : S - 1 - step;
        const float y = y1[i] + __expf(acs[k]) * y2[i];
        YS[((size_t)dir * NT + (size_t)b * S + t) * 256 + hd * 64 + 32 * pi + r] = f2bf(y);
      }
    }
    {
      const int pi = wid >> 2, ni = wid & 3;
      const float ed = __expf(atot);
#pragma unroll
      for (int i = 0; i < 16; ++i) racc[i] *= ed;
#pragma unroll
      for (int kk = 0; kk < 8; ++kk) {
        const bf16x8 xv = *reinterpret_cast<const bf16x8*>(XT + (32 * pi + r) * ST + kk * 16 + h * 8);
        const bf16x8 bv = *reinterpret_cast<const bf16x8*>(BTd + (32 * ni + r) * ST + kk * 16 + h * 8);
        racc = MFMA32(xv, bv, racc);
      }
      __syncthreads();
#pragma unroll
      for (int i = 0; i < 16; ++i) Rb[(32 * pi + (i & 3) + 8 * (i >> 2) + 4 * h) * ST + 32 * ni + r] = f2bf(racc[i]);
    }
  }
}

DI void hyena_item(const PX& P, int l, int item0, char* shm) {
  const int tid = tidx(), hw = tid >> 8, t = tid & 255;
  const int item = item0 + hw;
  const int c = item >> 4, bp = item & 15, b0 = bp * 2, b1 = b0 + 1;
  float2* X = (float2*)shm + hw * FFT_LDS;
  float2* TW = (float2*)(shm + 2 * FFT_LDS * 8);
  float2* Z1 = TW + 2048 + hw * 2048;
  const bfr* HYT = (const bfr*)(P.ws + WS_HYT);
  const float2* twg = (const float2*)(P.ws + WS_TW);
  const float2* KF0 = (const float2*)(P.ws + WS_KF) + ((size_t)((l * 2 + 0) * 256 + c)) * 4096;
  const float2* KF1 = (const float2*)(P.ws + WS_KF) + ((size_t)((l * 2 + 1) * 256 + c)) * 4096;
  const float bias0 = P.in[17][(l * 2 + 0) * 256 + c], bias1 = P.in[17][(l * 2 + 1) * 256 + c];
  const bfr* v0 = HYT + ((size_t)(b0 * 768 + c)) * S; const bfr* v1 = HYT + ((size_t)(b1 * 768 + c)) * S;
  const bfr* x10 = v0 + 256 * S; const bfr* x11 = v1 + 256 * S;
  const bfr* x20 = v0 + 512 * S; const bfr* x21 = v1 + 512 * S;
  bfr* yo0 = (bfr*)(P.ws + WS_YH) + ((size_t)(b0 * 256 + c)) * S; bfr* yo1 = (bfr*)(P.ws + WS_YH) + ((size_t)(b1 * 256 + c)) * S;
  __syncthreads();
  for (int e = tid; e < 2048; e += NTHREADS) TW[e] = twg[e];
  {
    float a[8], b[8];
    unpack8(*reinterpret_cast<const uint4*>(v0 + t * 8), a); unpack8(*reinterpret_cast<const uint4*>(v1 + t * 8), b);
#pragma unroll
    for (int k = 0; k < 8; ++k) { X[fpos(t * 8 + k)] = make_float2(a[k], b[k]); X[fpos(2048 + t * 8 + k)] = make_float2(0.f, 0.f); }
  }
  __syncthreads();
  fft_fwd(X, TW, t);
  { float2 kf[16];
#pragma unroll
    for (int i = 0; i < 16; ++i) kf[i] = KF0[t + i * 256];
#pragma unroll
    for (int i = 0; i < 16; ++i) { const int p = fpos(t + i * 256); X[p] = cmul(X[p], kf[i]); } }
  __syncthreads();
  fft_inv(X, TW, t);
  {
    float a[8], b[8], g0[8], g1[8];
    unpack8(*reinterpret_cast<const uint4*>(v0 + t * 8), a); unpack8(*reinterpret_cast<const uint4*>(v1 + t * 8), b);
    unpack8(*reinterpret_cast<const uint4*>(x10 + t * 8), g0); unpack8(*reinterpret_cast<const uint4*>(x11 + t * 8), g1);
    float2 z[8];
#pragma unroll
    for (int k = 0; k < 8; ++k) { const float2 y = X[fpos(t * 8 + k)]; z[k] = make_float2(g0[k] * (y.x + bias0 * a[k]), g1[k] * (y.y + bias0 * b[k])); }
    __syncthreads();
#pragma unroll
    for (int k = 0; k < 8; ++k) { Z1[t * 8 + k] = z[k]; X[fpos(t * 8 + k)] = z[k]; X[fpos(2048 + t * 8 + k)] = make_float2(0.f, 0.f); }
  }
  __syncthreads();
  fft_fwd(X, TW, t);
  { float2 kf[16];
#pragma unroll
    for (int i = 0; i < 16; ++i) kf[i] = KF1[t + i * 256];
#pragma unroll
    for (int i = 0; i < 16; ++i) { const int p = fpos(t + i * 256); X[p] = cmul(X[p], kf[i]); } }
  __syncthreads();
  fft_inv(X, TW, t);
  {
    float g0[8], g1[8], o0[8], o1[8];
    unpack8(*reinterpret_cast<const uint4*>(x20 + t * 8), g0); unpack8(*reinterpret_cast<const uint4*>(x21 + t * 8), g1);
#pragma unroll
    for (int k = 0; k < 8; ++k) { const float2 y = X[fpos(t * 8 + k)], z1 = Z1[t * 8 + k]; o0[k] = g0[k] * (y.x + bias1 * z1.x); o1[k] = g1[k] * (y.y + bias1 * z1.y); }
    *reinterpret_cast<uint4*>(yo0 + t * 8) = pack8(o0); *reinterpret_cast<uint4*>(yo1 + t * 8) = pack8(o1);
  }
}

DI void phase_mix(const PX& P, int l, char* shm) {
  char* ws = P.ws;
  for (int rep = 0; rep < ((PROBE_MIX & 1) ? 2 : 1); ++rep)
  for (int it = blockIdx.x; it < 256; it += gridDim.x) ssd_item(P, l, it, shm);
  {
    const float sc = 0.10206207261596575f * LOG2E;
    for (int it = blockIdx.x; it < 1024; it += gridDim.x) {
      const int qblk = it & 7, bh = it >> 3, b = bh >> 2, hh = bh & 3;
      const bfr* q = (const bfr*)(ws + WS_Q) + (size_t)bh * S * 96;
      const bfr* k = (const bfr*)(ws + WS_K) + (size_t)bh * S * 96;
      const bfr* vt = (const bfr*)(ws + WS_VT) + (size_t)bh * 64 * S;
      bfr* o = (bfr*)(ws + WS_Y) + (size_t)b * S * 512 + hh * 64;
      attn_item<96, false>(q, 96, k, 96, vt, S, qblk * 256, 0, S, sc, 0.f, 0.f, o, 512, shm);
    }
  }
  {
    const bfr* U = (const bfr*)(ws + WS_U);
    for (int it = blockIdx.x; it < 1024; it += gridDim.x) {
      const int qblk = it & 7, bh = it >> 3, b = bh >> 2, hh = bh & 3, kvh = hh >> 1;
      const bfr* q = U + (size_t)b * S * INP + OSQ + hh * 64;
      const bfr* k = U + (size_t)b * S * INP + OSK + kvh * 64;
      const bfr* v = U + (size_t)b * S * INP + OSV + kvh * 64;
      bfr* o = (bfr*)(ws + WS_Y) + (size_t)b * S * 512 + 256 + hh * 64;
      const int q0 = qblk * 256, klo = max(q0 - 128, 0), khi = min(q0 + 256 + 128, S);
      const float slope = exp2f(-2.f * (float)(hh + 1));
      attn_item<64, true>(q, INP, k, INP, v, INP, q0, klo, khi, 0.125f * LOG2E, slope * LOG2E, P.in[18][l * 4 + hh] * LOG2E, o, 512, shm);
    }
  }
  for (int rep = 0; rep < ((PROBE_MIX & 8) ? 2 : 1); ++rep)
  for (int it = blockIdx.x * 2; it < 4096; it += gridDim.x * 2) hyena_item(P, l, it, shm);
}

DI void norm_store(float* vals, bfr* op) {
  float ss = 0.f;
#pragma unroll
  for (int k = 0; k < 16; ++k) ss += vals[k] * vals[k];
  ss += swz_xor<1>(ss); ss += swz_xor<2>(ss); ss += swz_xor<4>(ss); ss += swz_xor<8>(ss);
  const float rstd = rsqrtf(ss * (1.f / 256.f) + 1e-6f);
#pragma unroll
  for (int k = 0; k < 16; ++k) vals[k] *= rstd;
  *reinterpret_cast<uint4*>(op) = pack8(vals); *reinterpret_cast<uint4*>(op + 8) = pack8(vals + 8);
}

DI void phase_norm(const PX& P, int l, char* shm) {
  char* ws = P.ws;
  const bfr* U = (const bfr*)(ws + WS_U);
  const bfr* Y = (const bfr*)(ws + WS_Y);
  const bfr* YH = (const bfr*)(ws + WS_YH);
  const bfr* YS = (const bfr*)(ws + WS_YSSD);
  bfr* YN = (bfr*)(ws + WS_YN);
  bfr* hy = (bfr*)shm;
  const float* cw = P.in[19] + l * 3 * 768; const float* cbias = P.in[20] + l * 768;
  const int tid = tidx(), wid = tid >> 6, lane = tid & 63;
  const int grp = wid & 3, tsub = (wid >> 2) * 32, tk = lane >> 4, c16 = (lane & 15) * 16;
#pragma unroll 1
  for (int it = blockIdx.x; it < 1024; it += gridDim.x) {
    const int b = it >> 5, t0 = (it & 31) * 64;
    __syncthreads();
    for (int e = tid; e < 2048; e += NTHREADS) {
      const int c = e >> 3, ch = e & 7, rot = c >> 4;
      const uint4 v = *reinterpret_cast<const uint4*>(YH + ((size_t)(b * 256 + c)) * S + t0 + ch * 8);
      unsigned* tp = reinterpret_cast<unsigned*>(hy + c * 66);
      tp[(ch * 4 + rot) & 31] = v.x; tp[(ch * 4 + 1 + rot) & 31] = v.y; tp[(ch * 4 + 2 + rot) & 31] = v.z; tp[(ch * 4 + 3 + rot) & 31] = v.w;
    }
    __syncthreads();
    if (grp == 0 || grp == 2) {
      uint4 qa[8], qb[8];
#pragma unroll
      for (int i = 0; i < 8; ++i) {
        const long row = (long)b * S + t0 + tsub + i * 4 + tk;
        const bfr* yp = Y + row * 512 + (grp == 0 ? 0 : 256) + c16;
        qa[i] = *reinterpret_cast<const uint4*>(yp); qb[i] = *reinterpret_cast<const uint4*>(yp + 8);
      }
#pragma unroll
      for (int i = 0; i < 8; ++i) {
        const long row = (long)b * S + t0 + tsub + i * 4 + tk;
        float vals[16];
        unpack8(qa[i], vals); unpack8(qb[i], vals + 8);
        norm_store(vals, YN + row * 1024 + grp * 256 + c16);
      }
    } else if (grp == 1) {
#pragma unroll 2
      for (int i = 0; i < 8; ++i) {
        const int tl = tsub + i * 4 + tk; const long row = (long)b * S + t0 + tl;
        const int tr = (tl + 2 * (lane & 15)) & 63;
        float vals[16];
#pragma unroll
        for (int k = 0; k < 16; ++k) vals[k] = bf2f(hy[(c16 + k) * 66 + tr]);
        norm_store(vals, YN + row * 1024 + 256 + c16);
      }
    } else {
      const int hd = c16 >> 6;
      const float dsum = P.in[23][l * 8 + hd] + P.in[23][l * 8 + 4 + hd];
#pragma unroll 1
      for (int i = 0; i < 8; ++i) {
        const int tl = tsub + i * 4 + tk, t = t0 + tl; const long row = (long)b * S + t;
        const bfr* ub = U + row * INP + OXBC + c16;
        uint4 q0[2], qm[2], qp[2], qf[2], qbk[2], qz[2];
#pragma unroll
        for (int hf = 0; hf < 2; ++hf) {
          q0[hf] = *reinterpret_cast<const uint4*>(ub + hf * 8);
          qm[hf] = make_uint4(0, 0, 0, 0); qp[hf] = make_uint4(0, 0, 0, 0);
          if (t > 0) qm[hf] = *reinterpret_cast<const uint4*>(ub - INP + hf * 8);
          if (t < S - 1) qp[hf] = *reinterpret_cast<const uint4*>(ub + INP + hf * 8);
          qf[hf] = *reinterpret_cast<const uint4*>(YS + (size_t)row * 256 + c16 + hf * 8);
          qbk[hf] = *reinterpret_cast<const uint4*>(YS + ((size_t)NT + row) * 256 + c16 + hf * 8);
          qz[hf] = *reinterpret_cast<const uint4*>(U + row * INP + OZ + c16 + hf * 8);
        }
        float vals[16];
#pragma unroll
        for (int hf = 0; hf < 2; ++hf) {
          float u0[8], um[8], up[8], w[8], a[8];
          unpack8(q0[hf], u0); unpack8(qm[hf], um); unpack8(qp[hf], up);
          ld8f(cbias + c16 + hf * 8, a);
          ld8f(cw + c16 + hf * 8, w);
#pragma unroll
          for (int k = 0; k < 8; ++k) a[k] += w[k] * um[k];
          ld8f(cw + 768 + c16 + hf * 8, w);
#pragma unroll
          for (int k = 0; k < 8; ++k) a[k] += w[k] * u0[k];
          ld8f(cw + 1536 + c16 + hf * 8, w);
#pragma unroll
          for (int k = 0; k < 8; ++k) a[k] += w[k] * up[k];
          unpack8(qf[hf], u0); unpack8(qbk[hf], um); unpack8(qz[hf], up);
#pragma unroll
          for (int k = 0; k < 8; ++k) vals[hf * 8 + k] = (u0[k] + um[k] + dsum * silu(a[k])) * silu(up[k]);
        }
        norm_store(vals, YN + row * 1024 + 768 + c16);
      }
    }
  }
}

DI void ln_panel(const bfr* pre, float* out, bfr* hb, const float* stats, int brow, const float* g, const float* bta, bool write_f32) {
  const int tid = tidx(), wid = tid >> 6, lane = tid & 63;
#pragma unroll 1
  for (int r4 = wid * 4; r4 < 256; r4 += 32) {
    uint4 q[4][2];
#pragma unroll
    for (int qq = 0; qq < 4; ++qq)
#pragma unroll
      for (int i = 0; i < 2; ++i) q[qq][i] = write_f32 ? make_uint4(0, 0, 0, 0) : *reinterpret_cast<const uint4*>(pre + (long)(brow + r4 + qq) * D + i * 512 + lane * 8);
#pragma unroll
    for (int qq = 0; qq < 4; ++qq) {
      const int row = brow + r4 + qq;
      const float2 st = reinterpret_cast<const float2*>(stats)[r4 + qq];
      const float mu = st.x * (1.f / D);
      const float rstd = rsqrtf(fmaxf(st.y * (1.f / D) - mu * mu, 0.f) + 1e-5f);
#pragma unroll
      for (int i = 0; i < 2; ++i) {
        const int c0 = i * 512 + lane * 8;
        float v[8], gg[8], bb[8];
        if (write_f32) ld8f(out + (long)row * D + c0, v); else unpack8(q[qq][i], v);
        ld8f(g + c0, gg); ld8f(bta + c0, bb);
#pragma unroll
        for (int k = 0; k < 8; ++k) v[k] = (v[k] - mu) * rstd * gg[k] + bb[k];
        if (write_f32) { float* op = out + (long)row * D + c0; *reinterpret_cast<float4*>(op) = make_float4(v[0], v[1], v[2], v[3]); *reinterpret_cast<float4*>(op + 4) = make_float4(v[4], v[5], v[6], v[7]); }
        *reinterpret_cast<uint4*>(hb + (long)row * D + c0) = pack8(v);
      }
    }
  }
}

template <int LDA, int LDB>
DI void phase_gemm_ln(const PX& P, const bfr* A, const bfr* Bt, int K, const float* g, const float* bta, char* shm) {
  float* stats = (float*)(shm + 136192);
  EpiResid epi{(bfr*)(P.ws + WS_PRE), (const bfr*)(P.ws + WS_HB), stats};
#pragma unroll 1
  for (int pm = blockIdx.x; pm < 256; pm += gridDim.x) {
    { const int t = tidx(); if (t < 512) stats[t] = 0.f; }
    __syncthreads();
#pragma unroll 1
    for (int pn = 0; pn < 4; ++pn) gemm_unit<LDA, LDB>(A, Bt, K, pm * 256, pn * 256, shm, epi);
    ln_panel((const bfr*)(P.ws + WS_PRE), P.out, (bfr*)(P.ws + WS_HB), stats, pm * 256, g, bta, false);
    __syncthreads();
  }
}

template <int LDA, int LDB, int K, class Epi>
DI void phase_gemm(const bfr* A, const bfr* Bt, int nN, char* shm, const Epi& epi) {
  for (int u = blockIdx.x; u < 256 * nN; u += gridDim.x) {
    int pm, pn; unit_to_tile(u, 256, nN, pm, pn);
    gemm_unit<LDA, LDB>(A, Bt, K, pm * 256, pn * 256, shm, epi);
  }
}

DI void phase_ple(const PX& P, int l, char* shm) {
  char* ws = P.ws;
  const bfr* W = (const bfr*)(ws + WS_W) + (size_t)l * EW_LAYER;
  bfr* E = (bfr*)(ws + WS_YN);
  float* stats = (float*)(shm + 136192);
  EpiStoreBf16 e1{E, 1024};
  EpiPle e2{(bfr*)(ws + WS_PRE), (l == NL - 1) ? P.out : nullptr, (const bfr*)(ws + WS_HB), E, P.in[37] + l * 1024, stats};
#pragma unroll 1
  for (int pm = blockIdx.x; pm < 256; pm += gridDim.x) {
    { const int t = tidx(); if (t < 512) stats[t] = 0.f; }
    __syncthreads();
#pragma unroll 1
    for (int pn = 0; pn < 4; ++pn) gemm_unit<256, 256>((const bfr*)(ws + WS_PB), W + WO_PP, 256, pm * 256, pn * 256, shm, e1);
#pragma unroll 1
    for (int pn = 0; pn < 4; ++pn) gemm_unit<1024, 1024>((const bfr*)(ws + WS_HB), W + WO_PG, 1024, pm * 256, pn * 256, shm, e2);
    ln_panel((const bfr*)(ws + WS_PRE), P.out, (bfr*)(ws + WS_HB), stats, pm * 256, P.in[38] + l * D, P.in[39] + l * D, l == NL - 1);
    __syncthreads();
  }
}

DI void convert_p(const PX& P, int l) {
  const float4* src = reinterpret_cast<const float4*>(P.in[1] + (size_t)l * NT * PLE);
  uint2* dst = reinterpret_cast<uint2*>(P.ws + WS_PB);
  for (size_t e = (size_t)blockIdx.x * NTHREADS + tidx(); e < (size_t)NT * PLE / 4; e += (size_t)gridDim.x * NTHREADS) {
    const float4 v = src[e]; uint2 pk; pk.x = pack2(v.x, v.y); pk.y = pack2(v.z, v.w); dst[e] = pk;
  }
}

constexpr int NPH_LAYER = 9;
constexpr int NPHASES = 1 + NL * NPH_LAYER;

DI void run_phase(const Params& P0, int ph, char* shm, int skip = 0) {
  PX P;
  int z = 0; asm volatile("" : "+v"(z)); z = __builtin_amdgcn_readfirstlane(z);
  P.in = (in_tab_t)(&P0.in[0]) + z; P.out = P0.out + z; P.ws = P0.ws + z;
  char* ws = P.ws;
  if (ph == 0) { phase_prep(P, shm); return; }
  const int l = (ph - 1) / NPH_LAYER, k = (ph - 1) % NPH_LAYER;
  const bfr* W = (const bfr*)(ws + WS_W) + (size_t)l * EW_LAYER;
  const bfr* HB = (const bfr*)(ws + WS_HB);
  switch (k) {
    case 0: phase_gemm_in(P, l, shm, skip); break;
    case 1: phase_premix(P, l, shm); break;
    case 2: phase_mix(P, l, shm); break;
    case 3: phase_norm(P, l, shm); break;
    case 4: phase_gemm_ln<1024, 1024>(P, (const bfr*)(ws + WS_YN), W + WO_OUT, 1024, P.in[26] + l * D, P.in[27] + l * D, shm); convert_p(P, l); break;
    case 5: { EpiGate e{(bfr*)(ws + WS_U), (bfr*)(ws + WS_HALO)}; phase_gemm<1024, 1024, 1024>(HB, W + WO_G, 11, shm, e); } break;
    case 6: { EpiUp e{(bfr*)(ws + WS_U), (const bfr*)(ws + WS_HALO), P.in[30] + (size_t)l * 3 * DFF, P.in[31] + (size_t)l * DFF};
              phase_gemm<1024, 1024, 1024>(HB, W + WO_U, 11, shm, e); } break;
    case 7: phase_gemm_ln<DFF, DFF>(P, (const bfr*)(ws + WS_U), W + WO_D, DFF, P.in[33] + l * D, P.in[34] + l * D, shm); break;
    case 8: phase_ple(P, l, shm); break;
  }
}

DI void grid_barrier(unsigned* bar, unsigned target) {
  __syncthreads();
  if (tidx() == 0) {
    __builtin_amdgcn_fence(__ATOMIC_RELEASE, "agent");
    __hip_atomic_fetch_add(bar, 1u, __ATOMIC_RELAXED, __HIP_MEMORY_SCOPE_AGENT);
    while (__hip_atomic_load(bar, __ATOMIC_RELAXED, __HIP_MEMORY_SCOPE_AGENT) < target) __builtin_amdgcn_s_sleep(1);
    __builtin_amdgcn_fence(__ATOMIC_ACQUIRE, "agent");
  }
  __syncthreads();
}

template <int PH>
DI void do_phase(const Params& P, int lo, int hi, char* shm) {
  if (PH >= lo && PH < hi) {
#if PROBE_DUP
    if (PH > 0 && ((PROBE_DUP >> ((PH - 1) % NPH_LAYER)) & 1)) { run_phase(P, PH, shm, 1); __syncthreads(); }
    if (PH == 0 && (PROBE_DUP & 0x8000)) { run_phase(P, PH, shm, 1); __syncthreads(); }
#endif
    run_phase(P, PH, shm);
    if (PH + 1 < hi) grid_barrier((unsigned*)(P.ws + WS_BAR), (unsigned)(PH + 1 - lo) * gridDim.x);
  }
}

__global__ __launch_bounds__(NTHREADS, 2) void mega(Params P, int ph_lo, int ph_hi) {
  extern __shared__ __attribute__((aligned(16))) char shm[];
  tid_init();
  if (ph_hi - ph_lo > 1) cg::this_grid().sync();
#ifdef DIAGPH
  run_phase(P, DIAGPH, shm);
#else
  do_phase<0>(P, ph_lo, ph_hi, shm);
  do_phase<1>(P, ph_lo, ph_hi, shm);
  do_phase<2>(P, ph_lo, ph_hi, shm);
  do_phase<3>(P, ph_lo, ph_hi, shm);
  do_phase<4>(P, ph_lo, ph_hi, shm);
  do_phase<5>(P, ph_lo, ph_hi, shm);
  do_phase<6>(P, ph_lo, ph_hi, shm);
  do_phase<7>(P, ph_lo, ph_hi, shm);
  do_phase<8>(P, ph_lo, ph_hi, shm);
  do_phase<9>(P, ph_lo, ph_hi, shm);
  do_phase<10>(P, ph_lo, ph_hi, shm);
  do_phase<11>(P, ph_lo, ph_hi, shm);
  do_phase<12>(P, ph_lo, ph_hi, shm);
  do_phase<13>(P, ph_lo, ph_hi, shm);
  do_phase<14>(P, ph_lo, ph_hi, shm);
  do_phase<15>(P, ph_lo, ph_hi, shm);
  do_phase<16>(P, ph_lo, ph_hi, shm);
  do_phase<17>(P, ph_lo, ph_hi, shm);
  do_phase<18>(P, ph_lo, ph_hi, shm);
#endif
}

extern "C" void kernel_launch(void* const* d_in, const int* in_sizes, int n_in, void* d_out, int out_size, void* d_ws,
                              size_t ws_size, hipStream_t stream) {
  static int grid = 0;
  if (grid == 0) {
    int dev = 0, cus = 0, per_cu = 0;
    hipGetDevice(&dev);
    hipDeviceGetAttribute(&cus, hipDeviceAttributeMultiprocessorCount, dev);
    hipFuncSetAttribute((const void*)mega, hipFuncAttributeMaxDynamicSharedMemorySize, LDS_BYTES);
    hipOccupancyMaxActiveBlocksPerMultiprocessor(&per_cu, (const void*)mega, NTHREADS, LDS_BYTES);
    if (per_cu < 1) per_cu = 1;
    grid = cus * per_cu;
    if (ws_size < WS_END) fprintf(stderr, "workspace too small: %zu < %zu\n", ws_size, (size_t)WS_END);
  }
  Params p{};
  for (int i = 0; i < 40; ++i) p.in[i] = (const float*)d_in[i];
  p.out = (float*)d_out; p.ws = (char*)d_ws;
#if COOP
  hipMemsetAsync((char*)d_ws + WS_BAR, 0, 256, stream);
  int lo = 0, hi = NPHASES;
  void* args[] = {&p, &lo, &hi};
  hipError_t e = hipLaunchCooperativeKernel((const void*)mega, dim3(grid), dim3(NTHREADS), args, LDS_BYTES, stream);
  if (e != hipSuccess) fprintf(stderr, "cooperative launch failed: %s (grid %d)\n", hipGetErrorString(e), grid);
#else
  for (int ph = 0; ph < NPHASES; ++ph) hipLaunchKernelGGL(mega, dim3(grid), dim3(NTHREADS), LDS_BYTES, stream, p, ph, ph + 1);
#endif
}
```

```cpp
#include <hip/hip_runtime.h>
#include <hip/hip_bf16.h>
#include <hip/hip_cooperative_groups.h>
#include <cstdio>
namespace cg = cooperative_groups;

#ifndef PROBE_DUP
#define PROBE_DUP 0
#define PROBE_MIX 0
#define PROBE_GEMM 0
#endif
#ifndef COOP
#define COOP 1
#endif

typedef unsigned short bfr;
using bf16x8 = __attribute__((ext_vector_type(8))) short;
using s16x4  = __attribute__((ext_vector_type(4))) short;
using f32x4  = __attribute__((ext_vector_type(4))) float;
using f32x16 = __attribute__((ext_vector_type(16))) float;
#define DI __device__ __forceinline__

constexpr int NB = 32, S = 2048, D = 1024, NT = NB * S, NL = 2;
constexpr int INW = 2728, INP = 2816, DFF = 2816, PLE = 256;
constexpr int OQ = 0, OKV = 256, OKR = 384, OHY = 416, OSQ = 1184, OSK = 1440, OSV = 1568, OZ = 1696, OXBC = 1952, ODT = 2720;
constexpr float ALPHA = 1.4142135623730951f;
constexpr float LOG2E = 1.4426950408889634f;

constexpr size_t EW_IN = 2816ull * 1024, EW_UQ = 512ull * 256, EW_UKV = 512ull * 256, EW_OUT = 1024ull * 1024,
                 EW_G = 2816ull * 1024, EW_U = 2816ull * 1024, EW_D = 1024ull * 2816, EW_PP = 1024ull * 256, EW_PG = 1024ull * 1024;
constexpr size_t WO_IN = 0, WO_UQ = WO_IN + EW_IN, WO_UKV = WO_UQ + EW_UQ, WO_OUT = WO_UKV + EW_UKV, WO_G = WO_OUT + EW_OUT,
                 WO_U = WO_G + EW_G, WO_D = WO_U + EW_U, WO_PP = WO_D + EW_D, WO_PG = WO_PP + EW_PP, EW_LAYER = WO_PG + EW_PG;
constexpr size_t WS_W = 0;
constexpr size_t WS_KBUF = WS_W + NL * EW_LAYER * 2;
constexpr size_t WS_KF = WS_KBUF + 2ull * 2 * 256 * 4096 * 4;
constexpr size_t WS_ROPE = WS_KF + 2ull * 2 * 256 * 4096 * 8;
constexpr size_t WS_TW = WS_ROPE + 2048ull * 16 * 8;
constexpr size_t WS_HALO = WS_TW + 2048ull * 8;
constexpr size_t WS_HB = WS_HALO + 512ull * 2 * 2816 * 2;
constexpr size_t WS_U = WS_HB + (size_t)NT * 1024 * 2;
constexpr size_t WS_Y = WS_U + (size_t)NT * 2816 * 2;
constexpr size_t WS_Q = WS_Y + (size_t)NT * 512 * 2;
constexpr size_t WS_K = WS_Q + (size_t)NT * 384 * 2;
constexpr size_t WS_VT = WS_K + (size_t)NT * 384 * 2;
constexpr size_t WS_YN = WS_Q;
constexpr size_t WS_HYT = WS_VT + (size_t)NT * 256 * 2;
constexpr size_t WS_PB = WS_HYT;
constexpr size_t WS_PRE = WS_HYT + (size_t)NT * 256 * 2;
constexpr size_t WS_YSSD = WS_HYT + (size_t)NT * 768 * 2;
constexpr size_t WS_YH = WS_YSSD + 2ull * NT * 256 * 2;
constexpr size_t WS_BAR = WS_YH + (size_t)NT * 256 * 2;
constexpr size_t WS_END = WS_BAR + 256;

constexpr int LDS_BYTES = 147456;
constexpr int NTHREADS = 512;

struct Params {
  const float* in[40];
  float* out;
  char* ws;
};

typedef const float* const __attribute__((address_space(4)))* in_tab_t;
struct PX {
  in_tab_t in;
  float* out;
  char* ws;
};
__shared__ int s_wave_tab[64];
DI int hw_slot() { return (int)(__builtin_amdgcn_s_getreg((5 << 11) | (0 << 6) | 4) & 63u); }
DI void tid_init() {
  const int t = threadIdx.x;
  if ((t & 63) == 0) s_wave_tab[hw_slot()] = t >> 6;
  __syncthreads();
}
DI int tidx() {
  int w = s_wave_tab[hw_slot()];
  asm volatile("" : "+v"(w));
  w = __builtin_amdgcn_readfirstlane(w);
  int t = (w << 6) | (int)__builtin_amdgcn_mbcnt_hi(~0u, __builtin_amdgcn_mbcnt_lo(~0u, 0u));
  asm volatile("" : "+v"(t));
  return t;
}
DI const char* uni_ptr(const char* p) {
  const unsigned long long v = (unsigned long long)p;
  const unsigned lo = __builtin_amdgcn_readfirstlane((unsigned)v), hi = __builtin_amdgcn_readfirstlane((unsigned)(v >> 32));
  return (const char*)(((unsigned long long)hi << 32) | lo);
}
template <int M> DI float swz_xor(float v) { return __int_as_float(__builtin_amdgcn_ds_swizzle(__float_as_int(v), (M << 10) | 0x1f)); }
typedef __bf16 bf16x2_t __attribute__((ext_vector_type(2)));
DI bfr f2bf(float x) { return __builtin_bit_cast(bfr, (__bf16)x); }
DI float bf2f(bfr v) { return __uint_as_float(((unsigned)v) << 16); }
DI unsigned pack2(float a, float b) { bf16x2_t v = {(__bf16)a, (__bf16)b}; return __builtin_bit_cast(unsigned, v); }
DI float silu(float x) { return x / (1.f + __expf(-x)); }
DI float sigmoidf(float x) { return 1.f / (1.f + __expf(-x)); }

constexpr int BM = 256, BK = 64, HALF = 128, HT = HALF * BK;
DI int lds_byte(int r, int c) {
  int st = (r >> 4) * 2 + (c >> 5), rr = r & 15, cc = c & 31, ob = rr * 64 + cc * 2;
  return st * 1024 + (ob ^ (((ob >> 9) & 1) << 5));
}
DI void stage_rc(int b, int& R, int& C) {
  int st = b / 1024, sb = b % 1024, swz = sb ^ (((sb >> 9) & 1) << 5);
  R = (st >> 1) * 16 + swz / 64; C = (st & 1) * 32 + (swz % 64) / 2;
}

typedef f32x4 acc_t[2][2][4][2];
constexpr int TST = 260;

template <int LDA, int LDB, class Epi, int SKIP = 0>
DI void gemm_unit(const bfr* __restrict__ A, const bfr* __restrict__ Bt, int K, int brow, int bcol, char* shmc, const Epi& epi) {
  bfr* shm = (bfr*)shmc;
#define SA(b, h) (shm + ((b) * 2 + (h)) * HT)
#define SB(b, h) (shm + (4 + (b) * 2 + (h)) * HT)
#define GL_LDS(gp, lp) __builtin_amdgcn_global_load_lds((const unsigned*)(gp), (__attribute__((address_space(3))) unsigned*)(lp), 16, 0, 0)
#define STAGE(P, BASE, LD, br, kt) do { const char* _sb = (const char*)(BASE) + ((long)(br) * (LD) + (kt) * BK) * 2; \
    const char* _sb2 = uni_ptr(_sb + 64 * (LD) * 2); \
    GL_LDS(_sb + voff_##LD, (char*)(P) + woff); \
    GL_LDS(_sb2 + voff_##LD, (char*)(P) + woff + 8192); } while (0)
#define LDA_(dst, b, h) for (int m = 0; m < 4; ++m) for (int k = 0; k < 2; ++k) \
    dst[m][k] = *reinterpret_cast<const bf16x8*>((char*)SA(b, h) + lds_byte(wr * 64 + m * 16 + fr, k * 32 + fq * 8))
#define LDB_(dst, b, h) for (int n = 0; n < 2; ++n) for (int k = 0; k < 2; ++k) \
    dst[n][k] = *reinterpret_cast<const bf16x8*>((char*)SB(b, h) + lds_byte(wc * 32 + n * 16 + fr, k * 32 + fq * 8))
#define MMA(ai, bj, At, Bt_) do { __builtin_amdgcn_s_setprio(1); \
    for (int m = 0; m < 4; ++m) for (int n = 0; n < 2; ++n) for (int k = 0; k < 2; ++k) \
      acc[ai][bj][m][n] = __builtin_amdgcn_mfma_f32_16x16x32_bf16(At[m][k], Bt_[n][k], acc[ai][bj][m][n], 0, 0, 0); \
    __builtin_amdgcn_s_setprio(0); } while (0)
#define WAIT_V(n) asm volatile("s_waitcnt vmcnt(" #n ")" ::: "memory")
#define WAIT_L(n) asm volatile("s_waitcnt lgkmcnt(" #n ")" ::: "memory")
#define BAR __builtin_amdgcn_s_barrier()
#define SCHED __builtin_amdgcn_sched_barrier(0)

  const int tid_u = tidx();
  const int wid = tid_u >> 6, lane = tid_u & 63, wr = wid >> 2, wc = wid & 3, fr = lane & 15, fq = lane >> 4;
  unsigned voff_LDA, voff_LDB;
  { int r_, c_; stage_rc(tid_u * 16, r_, c_); voff_LDA = (unsigned)(r_ * LDA + c_) * 2u; voff_LDB = (unsigned)(r_ * LDB + c_) * 2u; }
  const int woff = __builtin_amdgcn_readfirstlane(wid * 1024);
  acc_t acc = {};
  bf16x8 At[4][2], B0[2][2], B1[2][2];
  int nt = K / BK; asm volatile("" : "+s"(nt));
  STAGE(SB(0, 0), Bt, LDB, bcol, 0); STAGE(SA(0, 0), A, LDA, brow, 0);
  STAGE(SB(0, 1), Bt, LDB, bcol + HALF, 0); STAGE(SA(0, 1), A, LDA, brow + HALF, 0);
  if (wr == 1) BAR;
  WAIT_V(4); BAR;
  STAGE(SB(1, 0), Bt, LDB, bcol, 1); STAGE(SA(1, 0), A, LDA, brow, 1); STAGE(SB(1, 1), Bt, LDB, bcol + HALF, 1);
  WAIT_V(6); BAR;
#pragma unroll 1
  for (int t = 0; t < nt - 2; t += 2) {
    LDB_(B0, 0, 0); SCHED; LDA_(At, 0, 0); STAGE(SA(1, 1), A, LDA, brow + HALF, t + 1);
    WAIT_L(8); BAR; WAIT_L(0); MMA(0, 0, At, B0); BAR; SCHED;
    LDB_(B1, 0, 1); STAGE(SB(0, 0), Bt, LDB, bcol, t + 2);
    BAR; WAIT_L(0); MMA(0, 1, At, B1); BAR;
    LDA_(At, 0, 1); STAGE(SA(0, 0), A, LDA, brow, t + 2);
    BAR; WAIT_L(0); MMA(1, 0, At, B0); BAR; SCHED;
    STAGE(SB(0, 1), Bt, LDB, bcol + HALF, t + 2);
    WAIT_V(6); BAR; MMA(1, 1, At, B1); BAR;
    LDB_(B0, 1, 0); SCHED; LDA_(At, 1, 0); STAGE(SA(0, 1), A, LDA, brow + HALF, t + 2);
    WAIT_L(8); BAR; WAIT_L(0); MMA(0, 0, At, B0); BAR; SCHED;
    LDB_(B1, 1, 1); STAGE(SB(1, 0), Bt, LDB, bcol, t + 3);
    BAR; WAIT_L(0); MMA(0, 1, At, B1); BAR;
    LDA_(At, 1, 1); STAGE(SA(1, 0), A, LDA, brow, t + 3);
    BAR; WAIT_L(0); MMA(1, 0, At, B0); BAR; SCHED;
    STAGE(SB(1, 1), Bt, LDB, bcol + HALF, t + 3);
    WAIT_V(6); BAR; MMA(1, 1, At, B1); BAR;
  }
  { LDB_(B0, 0, 0); LDA_(At, 0, 0); STAGE(SA(1, 1), A, LDA, brow + HALF, nt - 1);
    BAR; WAIT_L(0); MMA(0, 0, At, B0); BAR;
    LDB_(B1, 0, 1); BAR; WAIT_L(0); MMA(0, 1, At, B1); BAR;
    LDA_(At, 0, 1); WAIT_V(4); BAR; WAIT_L(0); MMA(1, 0, At, B0); MMA(1, 1, At, B1); BAR; }
  { LDB_(B0, 1, 0); LDA_(At, 1, 0); WAIT_V(2); BAR; WAIT_L(0); MMA(0, 0, At, B0); BAR;
    LDB_(B1, 1, 1); WAIT_V(0); BAR; WAIT_L(0); MMA(0, 1, At, B1); BAR;
    LDA_(At, 1, 1); BAR; WAIT_L(0); MMA(1, 0, At, B0); MMA(1, 1, At, B1); BAR; }
  if (wr == 0) BAR;
  if (SKIP == 2) {
    float s = 0.f;
#pragma unroll
    for (int ai = 0; ai < 2; ++ai)
#pragma unroll
      for (int bj = 0; bj < 2; ++bj)
#pragma unroll
        for (int m = 0; m < 4; ++m)
#pragma unroll
          for (int n = 0; n < 2; ++n) s += acc[ai][bj][m][n][0] + acc[ai][bj][m][n][1] + acc[ai][bj][m][n][2] + acc[ai][bj][m][n][3];
    if (s == 123.456f) ((float*)shmc)[0] = s;
    __syncthreads();
    return;
  }
  float* tile = (float*)shmc;
  {
    int t2 = tid_u; asm volatile("" : "+v"(t2));
    const int lane2 = t2 & 63, wid2 = t2 >> 6;
    tile += ((wid2 >> 2) * 64 + (lane2 >> 4) * 4) * TST + (wid2 & 3) * 32 + (lane2 & 15);
  }
#pragma unroll
  for (int ai = 0; ai < 2; ++ai) {
    if (ai) __syncthreads();
#pragma unroll
    for (int bj = 0; bj < 2; ++bj)
#pragma unroll
      for (int m = 0; m < 4; ++m)
#pragma unroll
        for (int n = 0; n < 2; ++n)
#pragma unroll
          for (int j = 0; j < 4; ++j)
            tile[(m * 16 + j) * TST + bj * 128 + n * 16] = acc[ai][bj][m][n][j];
    __syncthreads();
    if (SKIP == 0) epi((float*)shmc, brow + ai * 128, bcol);
  }
  __syncthreads();
}

DI void unit_to_tile(int u, int nM, int nN, int& pm, int& pn) {
  const int nig = 8 * nN, gid = u / nig, fm = gid * 8, gsz = min(nM - fm, 8);
  pm = fm + ((u % nig) % gsz); pn = (u % nig) / gsz;
}

#define FOR_CHUNKS(ci) const int tid_e##ci = tidx(); _Pragma("unroll 1") for (int ci = 0; ci < 8; ++ci)
#define CHUNK_SETUP(ci) int tx_ = tid_e##ci; asm volatile("" : "+v"(tx_)); const int idx_ = ci * 512 + tx_; const int lr = idx_ >> 5, lc = (idx_ & 31) * 8; \
    const int row = r0 + lr, col = bcol + lc; float v[8]; \
    { const float4 a_ = *reinterpret_cast<const float4*>(tile + lr * TST + lc), b_ = *reinterpret_cast<const float4*>(tile + lr * TST + lc + 4); \
      v[0] = a_.x; v[1] = a_.y; v[2] = a_.z; v[3] = a_.w; v[4] = b_.x; v[5] = b_.y; v[6] = b_.z; v[7] = b_.w; }
DI uint4 pack8(const float* v) { uint4 o; o.x = pack2(v[0], v[1]); o.y = pack2(v[2], v[3]); o.z = pack2(v[4], v[5]); o.w = pack2(v[6], v[7]); return o; }
DI void unpack8(const uint4& u, float* f) {
  f[0] = __uint_as_float(u.x << 16); f[1] = __uint_as_float(u.x & 0xffff0000u); f[2] = __uint_as_float(u.y << 16); f[3] = __uint_as_float(u.y & 0xffff0000u);
  f[4] = __uint_as_float(u.z << 16); f[5] = __uint_as_float(u.z & 0xffff0000u); f[6] = __uint_as_float(u.w << 16); f[7] = __uint_as_float(u.w & 0xffff0000u);
}
DI void ld8f(const float* p, float* f) { const float4 a = *reinterpret_cast<const float4*>(p), b = *reinterpret_cast<const float4*>(p + 4);
  f[0] = a.x; f[1] = a.y; f[2] = a.z; f[3] = a.w; f[4] = b.x; f[5] = b.y; f[6] = b.z; f[7] = b.w; }

struct EpiStoreBf16 {
  bfr* C; int ldc;
  DI void operator()(float* tile, int r0, int bcol) const {
    FOR_CHUNKS(ci) { CHUNK_SETUP(ci); *reinterpret_cast<uint4*>(C + (long)row * ldc + col) = pack8(v); }
  }
};
struct EpiGate {
  bfr* G; bfr* halo;
  DI void operator()(float* tile, int r0, int bcol) const {
    FOR_CHUNKS(ci) { CHUNK_SETUP(ci); const uint4 pk = pack8(v);
      *reinterpret_cast<uint4*>(G + (long)row * DFF + col) = pk;
      if (lr == 0) *reinterpret_cast<uint4*>(halo + ((long)(row >> 7) * 2 + 0) * DFF + col) = pk;
      if (lr == 127) *reinterpret_cast<uint4*>(halo + ((long)(row >> 7) * 2 + 1) * DFF + col) = pk;
    }
  }
};
#define CH_LR(ci, tx) (((ci) * 512 + (tx)) >> 5)
#define CH_LC(ci, tx) ((((ci) * 512 + (tx)) & 31) * 8)
struct EpiUp {
  bfr* G; const bfr* halo; const float* cw; const float* cb;
  DI void operator()(float* tile, int r0, int bcol) const {
    const int tx = tidx();
    const int lc = (tx & 31) * 8, col = bcol + lc;
    float wm[8], wc[8], wp[8], wb[8];
    ld8f(cw + col, wm); ld8f(cw + DFF + col, wc); ld8f(cw + 2 * DFF + col, wp); ld8f(cb + col, wb);
#pragma unroll
    for (int c0 = 0; c0 < 8; c0 += 4) {
      uint4 q0[4], qm[4], qp[4];
#pragma unroll
      for (int k4 = 0; k4 < 4; ++k4) {
        const int lr = CH_LR(c0 + k4, tx), row = r0 + lr;
        const long idx = (long)row * DFF + col; const int t = row & (S - 1), hb = row >> 7;
        q0[k4] = *reinterpret_cast<const uint4*>(G + idx);
        qm[k4] = make_uint4(0, 0, 0, 0); qp[k4] = make_uint4(0, 0, 0, 0);
        if (t != 0) qm[k4] = lr == 0 ? *reinterpret_cast<const uint4*>(halo + ((long)(hb - 1) * 2 + 1) * DFF + col) : *reinterpret_cast<const uint4*>(G + idx - DFF);
        if (t != S - 1) qp[k4] = lr == 127 ? *reinterpret_cast<const uint4*>(halo + ((long)(hb + 1) * 2 + 0) * DFF + col) : *reinterpret_cast<const uint4*>(G + idx + DFF);
      }
#pragma unroll
      for (int k4 = 0; k4 < 4; ++k4) {
        const int lr = CH_LR(c0 + k4, tx);
        float v[8], g0[8], gm[8], gp[8];
        ld8f(tile + lr * TST + lc, v);
        unpack8(q0[k4], g0); unpack8(qm[k4], gm); unpack8(qp[k4], gp);
#pragma unroll
        for (int k = 0; k < 8; ++k) v[k] = silu(wb[k] + wm[k] * gm[k] + wc[k] * g0[k] + wp[k] * gp[k]) * v[k];
        *reinterpret_cast<uint4*>(tile + lr * TST + lc) = pack8(v);
      }
    }
    __syncthreads();
#pragma unroll
    for (int ci = 0; ci < 8; ++ci) {
      const int lr = CH_LR(ci, tx);
      *reinterpret_cast<uint4*>(G + (long)(r0 + lr) * DFF + col) = *reinterpret_cast<const uint4*>(tile + lr * TST + lc);
    }
  }
};
DI void row_stats_add(float* stats, int row, const float* v, int tx) {
  float s1 = 0.f, s2 = 0.f;
#pragma unroll
  for (int k = 0; k < 8; ++k) { s1 += v[k]; s2 += v[k] * v[k]; }
  s1 += swz_xor<16>(s1); s2 += swz_xor<16>(s2); s1 += swz_xor<8>(s1); s2 += swz_xor<8>(s2); s1 += swz_xor<4>(s1); s2 += swz_xor<4>(s2);
  s1 += swz_xor<2>(s1); s2 += swz_xor<2>(s2); s1 += swz_xor<1>(s1); s2 += swz_xor<1>(s2);
  if ((tx & 31) == 0) { float2* sp = reinterpret_cast<float2*>(stats) + (row & 255); float2 s = *sp; s.x += s1; s.y += s2; *sp = s; }
}
struct EpiResid {
  bfr* out; const bfr* hb; float* stats;
  DI void operator()(float* tile, int r0, int bcol) const {
    const int tx = tidx();
#pragma unroll
    for (int c0 = 0; c0 < 8; c0 += 4) {
      uint4 hq[4];
#pragma unroll
      for (int k4 = 0; k4 < 4; ++k4) hq[k4] = *reinterpret_cast<const uint4*>(hb + (long)(r0 + CH_LR(c0 + k4, tx)) * D + bcol + CH_LC(c0 + k4, tx));
#pragma unroll
      for (int k4 = 0; k4 < 4; ++k4) {
        const int lr = CH_LR(c0 + k4, tx), lc = CH_LC(c0 + k4, tx), row = r0 + lr;
        bfr* op = out + (long)row * D + bcol + lc;
        float v[8], o[8];
        ld8f(tile + lr * TST + lc, v); unpack8(hq[k4], o);
#pragma unroll
        for (int k = 0; k < 8; ++k) o[k] = ALPHA * o[k] + v[k];
        *reinterpret_cast<uint4*>(op) = pack8(o);
        row_stats_add(stats, row, o, tx);
      }
    }
  }
};
struct EpiPle {
  bfr* out; float* out32; const bfr* hb; const bfr* E; const float* bg; float* stats;
  DI void operator()(float* tile, int r0, int bcol) const {
    const int tx = tidx();
#pragma unroll
    for (int c0 = 0; c0 < 8; c0 += 4) {
      uint4 hq[4], eq[4];
#pragma unroll
      for (int k4 = 0; k4 < 4; ++k4) {
        const long idx = (long)(r0 + CH_LR(c0 + k4, tx)) * D + bcol + CH_LC(c0 + k4, tx);
        hq[k4] = *reinterpret_cast<const uint4*>(hb + idx);
        eq[k4] = *reinterpret_cast<const uint4*>(E + idx);
      }
#pragma unroll
      for (int k4 = 0; k4 < 4; ++k4) {
        const int lr = CH_LR(c0 + k4, tx), lc = CH_LC(c0 + k4, tx), row = r0 + lr, col = bcol + lc;
        bfr* op = out + (long)row * D + col;
        float v[8], o[8], e[8], bgv[8];
        ld8f(tile + lr * TST + lc, v); ld8f(bg + col, bgv); unpack8(eq[k4], e); unpack8(hq[k4], o);
#pragma unroll
        for (int k = 0; k < 8; ++k) o[k] = ALPHA * o[k] + e[k] * sigmoidf(v[k] + bgv[k]);
        if (out32) { float* o32 = out32 + (long)row * D + col; *reinterpret_cast<float4*>(o32) = make_float4(o[0], o[1], o[2], o[3]); *reinterpret_cast<float4*>(o32 + 4) = make_float4(o[4], o[5], o[6], o[7]); }
        else *reinterpret_cast<uint4*>(op) = pack8(o);
        row_stats_add(stats, row, o, tx);
      }
    }
  }
};
struct EpiQ {
  bfr* Q; const float* rs; const float2* rope;
  DI void operator()(float* tile, int r0, int bcol) const {
    FOR_CHUNKS(ci) { CHUNK_SETUP(ci);
      if (col < 384) {
        const int head = col / 96, d0 = col % 96; const float rstd = rs[row & 255]; const int b = row >> 11, t = row & (S - 1);
        if (d0 >= 64) {
          const bool lo = d0 < 80; const int jj = (d0 - (lo ? 64 : 80));
          float pw[8]; ld8f(tile + lr * TST + lc + (lo ? 16 : -16), pw);
#pragma unroll
          for (int k = 0; k < 8; ++k) { const float2 cs = rope[t * 16 + jj + k];
            v[k] = lo ? (v[k] * cs.x - pw[k] * cs.y) : (v[k] * cs.x + pw[k] * cs.y); }
        }
#pragma unroll
        for (int k = 0; k < 8; ++k) v[k] *= rstd;
        *reinterpret_cast<uint4*>(Q + (((long)(b * 4 + head)) * S + t) * 96 + d0) = pack8(v);
      }
    }
  }
};
struct EpiKV {
  bfr* Kf; bfr* VT; const float* rs;
  DI void operator()(float* tile, int r0, int bcol) const {
    FOR_CHUNKS(ci) { CHUNK_SETUP(ci);
      if ((col & 127) < 64) {
        const int head = col >> 7, d0 = col & 127; const float rstd = rs[row & 255]; const int b = row >> 11, t = row & (S - 1);
#pragma unroll
        for (int k = 0; k < 8; ++k) v[k] *= rstd;
        *reinterpret_cast<uint4*>(Kf + (((long)(b * 4 + head)) * S + t) * 96 + d0) = pack8(v);
      }
    }
    const int b = r0 >> 11, t0 = r0 & (S - 1);
#pragma unroll 1
    for (int it = tidx(); it < 2048; it += NTHREADS) {
      const int vc = it & 127, rc = it >> 7, lcol = (vc >> 6) * 128 + 64 + (vc & 63), lr0 = rc * 8;
      const int head = (bcol + lcol) >> 7, dd = vc & 63;
      float v[8];
#pragma unroll
      for (int k = 0; k < 8; ++k) v[k] = tile[(lr0 + k) * TST + lcol] * rs[(r0 + lr0 + k) & 255];
      *reinterpret_cast<uint4*>(VT + (((long)(b * 4 + head)) * 64 + dd) * S + t0 + lr0) = pack8(v);
    }
  }
};

#define MFMA32(a, b, c) __builtin_amdgcn_mfma_f32_32x32x16_bf16((a), (b), (c), 0, 0, 0)
template <int DQK, bool SWA>
DI void attn_item(const bfr* __restrict__ qb, long q_ld, const bfr* __restrict__ kb, long k_ld, const bfr* __restrict__ vb, long v_ld,
                  int q0, int key_lo, int key_hi, float scale_l2e, float slope_l2e, float sink_l2e,
                  bfr* __restrict__ outp, long out_ld, char* shm) {
  constexpr int KST = DQK + 8;
  constexpr int VST = 72;
  constexpr int NKK = DQK / 16;
  bfr* Ks = (bfr*)shm;
  bfr* Vt = Ks + 64 * KST;
  const int tid = tidx(), wid = tid >> 6, lane = tid & 63, r = lane & 31, h = lane >> 5;
  const int qrow = q0 + wid * 32 + r;
  bf16x8 qf[NKK];
#pragma unroll
  for (int kk = 0; kk < NKK; ++kk) qf[kk] = *reinterpret_cast<const bf16x8*>(qb + (long)qrow * q_ld + kk * 16 + h * 8);
  f32x16 o[2];
#pragma unroll
  for (int i = 0; i < 16; ++i) { o[0][i] = 0.f; o[1][i] = 0.f; }
  float mrun = SWA ? sink_l2e : -1e30f, lrun = SWA ? 1.f : 0.f;
  constexpr int KCH = DQK / 8;
  constexpr bool K2 = (64 * KCH > NTHREADS);
  uint4 pk0, pk1 = make_uint4(0, 0, 0, 0), pvv;
  const int vrow = tid >> 3, vch = tid & 7;
  const int kr0 = tid / KCH, kc0 = (tid % KCH) * 8, kr1 = (tid + NTHREADS) / KCH, kc1 = ((tid + NTHREADS) % KCH) * 8;
  const bool has1 = K2 && (tid + NTHREADS < 64 * KCH);
#define ATT_LOAD(kt_) do { \
    pk0 = *reinterpret_cast<const uint4*>(kb + (long)((kt_) + kr0) * k_ld + kc0); \
    if (has1) pk1 = *reinterpret_cast<const uint4*>(kb + (long)((kt_) + kr1) * k_ld + kc1); \
    pvv = SWA ? *reinterpret_cast<const uint4*>(vb + (long)((kt_) + vrow) * v_ld + vch * 8) \
              : *reinterpret_cast<const uint4*>(vb + (long)vrow * v_ld + (kt_) + vch * 8); } while (0)
  ATT_LOAD(key_lo);
  for (int kt = key_lo; kt < key_hi; kt += 64) {
    __syncthreads();
    *reinterpret_cast<uint4*>(Ks + kr0 * KST + kc0) = pk0;
    if (has1) *reinterpret_cast<uint4*>(Ks + kr1 * KST + kc1) = pk1;
    if (SWA) {
      bfr* vp = Vt + (vch * 8) * VST + vrow;
      vp[0 * VST] = (bfr)(pvv.x & 0xffffu); vp[1 * VST] = (bfr)(pvv.x >> 16);
      vp[2 * VST] = (bfr)(pvv.y & 0xffffu); vp[3 * VST] = (bfr)(pvv.y >> 16);
      vp[4 * VST] = (bfr)(pvv.z & 0xffffu); vp[5 * VST] = (bfr)(pvv.z >> 16);
      vp[6 * VST] = (bfr)(pvv.w & 0xffffu); vp[7 * VST] = (bfr)(pvv.w >> 16);
    } else {
      *reinterpret_cast<uint4*>(Vt + vrow * VST + vch * 8) = pvv;
    }
    if (kt + 64 < key_hi) ATT_LOAD(kt + 64);
    __syncthreads();
    f32x16 s[2];
#pragma unroll
    for (int kh = 0; kh < 2; ++kh) {
#pragma unroll
      for (int i = 0; i < 16; ++i) s[kh][i] = 0.f;
#pragma unroll
      for (int kk = 0; kk < NKK; ++kk) {
        const bf16x8 a = *reinterpret_cast<const bf16x8*>(Ks + (kh * 32 + r) * KST + kk * 16 + h * 8);
        s[kh] = MFMA32(a, qf[kk], s[kh]);
      }
    }
    float mx = -1e30f;
    if (SWA) {
#pragma unroll
      for (int kh = 0; kh < 2; ++kh)
#pragma unroll
        for (int i = 0; i < 16; ++i) {
          const int kpos = kt + kh * 32 + (i & 3) + 8 * (i >> 2) + 4 * h;
          const int dist = abs(qrow - kpos);
          const float v = (dist <= 128) ? s[kh][i] * scale_l2e - slope_l2e * (float)dist : -1e30f;
          s[kh][i] = v; mx = fmaxf(mx, v);
        }
    } else {
#pragma unroll
      for (int kh = 0; kh < 2; ++kh)
#pragma unroll
        for (int i = 0; i < 16; ++i) mx = fmaxf(mx, s[kh][i]);
      mx *= scale_l2e;
    }
    mx = fmaxf(mx, __shfl_xor(mx, 32));
    const float mnew = fmaxf(mrun, mx);
    float ps = 0.f;
    if (SWA) {
#pragma unroll
      for (int kh = 0; kh < 2; ++kh)
#pragma unroll
        for (int i = 0; i < 16; ++i) { const float p = __builtin_amdgcn_exp2f(s[kh][i] - mnew); s[kh][i] = p; ps += p; }
    } else {
#pragma unroll
      for (int kh = 0; kh < 2; ++kh)
#pragma unroll
        for (int i = 0; i < 16; ++i) { const float p = __builtin_amdgcn_exp2f(fmaf(s[kh][i], scale_l2e, -mnew)); s[kh][i] = p; ps += p; }
    }
    ps += __shfl_xor(ps, 32);
    if (__any(mnew > mrun)) {
      const float corr = __builtin_amdgcn_exp2f(mrun - mnew);
      lrun *= corr;
#pragma unroll
      for (int i = 0; i < 16; ++i) { o[0][i] *= corr; o[1][i] *= corr; }
    }
    lrun += ps; mrun = mnew;
#pragma unroll
    for (int kh = 0; kh < 2; ++kh)
#pragma unroll
      for (int s2 = 0; s2 < 2; ++s2) {
        uint4 pbu;
        pbu.x = pack2(s[kh][8 * s2 + 0], s[kh][8 * s2 + 1]); pbu.y = pack2(s[kh][8 * s2 + 2], s[kh][8 * s2 + 3]);
        pbu.z = pack2(s[kh][8 * s2 + 4], s[kh][8 * s2 + 5]); pbu.w = pack2(s[kh][8 * s2 + 6], s[kh][8 * s2 + 7]);
        const bf16x8 pb = __builtin_bit_cast(bf16x8, pbu);
#pragma unroll
        for (int dt = 0; dt < 2; ++dt) {
          const bfr* vp = Vt + (dt * 32 + r) * VST + kh * 32 + 16 * s2 + 4 * h;
          const s16x4 lo = *reinterpret_cast<const s16x4*>(vp);
          const s16x4 hi = *reinterpret_cast<const s16x4*>(vp + 8);
          const bf16x8 a = __builtin_shufflevector(lo, hi, 0, 1, 2, 3, 4, 5, 6, 7);
          o[dt] = MFMA32(a, pb, o[dt]);
        }
      }
  }
  const float inv = 1.f / lrun;
#pragma unroll
  for (int dt = 0; dt < 2; ++dt)
#pragma unroll
    for (int g = 0; g < 4; ++g) {
      uint2 pk; pk.x = pack2(o[dt][4 * g] * inv, o[dt][4 * g + 1] * inv); pk.y = pack2(o[dt][4 * g + 2] * inv, o[dt][4 * g + 3] * inv);
      *reinterpret_cast<uint2*>(outp + (long)qrow * out_ld + dt * 32 + 8 * g + 4 * h) = pk;
    }
}

DI float2 cmul(float2 a, float2 b) { return make_float2(a.x * b.x - a.y * b.y, a.x * b.y + a.y * b.x); }
DI float2 cmulc(float2 a, float2 b) { return make_float2(a.x * b.x + a.y * b.y, a.y * b.x - a.x * b.y); }
constexpr int FST_A = 272, FST_B = 17, FFT_LDS = 16 * FST_A;
DI int fpos(int n) { return (n >> 8) * FST_A + ((n >> 4) & 15) * FST_B + (n & 15); }
DI float2 twid(const float2* TW, int m) {
  const float2 w = TW[m & 2047];
  return (m & 2048) ? make_float2(-w.x, -w.y) : w;
}
DI void dft16_fwd(float2* v) {
  const float C8 = 0.92387953251128674f, S8 = 0.38268343236508977f, R2 = 0.70710678118654752f;
  const float2 w16[8] = {{1.f, 0.f}, {C8, -S8}, {R2, -R2}, {S8, -C8}, {0.f, -1.f}, {-S8, -C8}, {-R2, -R2}, {-C8, -S8}};
#pragma unroll
  for (int s = 0; s < 4; ++s) {
    const int half = 8 >> s;
#pragma unroll
    for (int j = 0; j < 8; ++j) {
      const int pos = j & (half - 1), i0 = ((j - pos) << 1) + pos, i1 = i0 + half;
      const float2 a = v[i0], b = v[i1];
      v[i0] = make_float2(a.x + b.x, a.y + b.y);
      v[i1] = cmul(make_float2(a.x - b.x, a.y - b.y), w16[pos << s]);
    }
  }
}
DI void dft16_inv(float2* v) {
  const float C8 = 0.92387953251128674f, S8 = 0.38268343236508977f, R2 = 0.70710678118654752f;
  const float2 w16[8] = {{1.f, 0.f}, {C8, -S8}, {R2, -R2}, {S8, -C8}, {0.f, -1.f}, {-S8, -C8}, {-R2, -R2}, {-C8, -S8}};
#pragma unroll
  for (int s = 3; s >= 0; --s) {
    const int half = 8 >> s;
#pragma unroll
    for (int j = 0; j < 8; ++j) {
      const int pos = j & (half - 1), i0 = ((j - pos) << 1) + pos, i1 = i0 + half;
      const float2 a = v[i0], b = cmulc(v[i1], w16[pos << s]);
      v[i0] = make_float2(a.x + b.x, a.y + b.y);
      v[i1] = make_float2(a.x - b.x, a.y - b.y);
    }
  }
}
DI int brev4(int i) { return ((i & 1) << 3) | ((i & 2) << 1) | ((i & 4) >> 1) | ((i & 8) >> 3); }
DI void fft_fwd(float2* X, const float2* TW, const int t) {
  float2 v[16];
  const int hi = t >> 4, lo = t & 15;
  {
    float2* p = X + hi * FST_B + lo;
#pragma unroll
    for (int i = 0; i < 16; ++i) v[i] = p[i * FST_A];
    dft16_fwd(v);
#pragma unroll
    for (int i = 0; i < 16; ++i) p[i * FST_A] = cmul(v[i], twid(TW, t * brev4(i)));
  }
  __syncthreads();
  {
    float2* p = X + hi * FST_A + lo;
#pragma unroll
    for (int i = 0; i < 16; ++i) v[i] = p[i * FST_B];
    dft16_fwd(v);
#pragma unroll
    for (int i = 0; i < 16; ++i) p[i * FST_B] = cmul(v[i], twid(TW, 16 * lo * brev4(i)));
  }
  __syncthreads();
  {
    float2* p = X + hi * FST_A + lo * FST_B;
#pragma unroll
    for (int i = 0; i < 16; ++i) v[i] = p[i];
    dft16_fwd(v);
#pragma unroll
    for (int i = 0; i < 16; ++i) p[i] = v[i];
  }
  __syncthreads();
}
DI void fft_inv(float2* X, const float2* TW, const int t) {
  float2 v[16];
  const int hi = t >> 4, lo = t & 15;
  {
    float2* p = X + hi * FST_A + lo * FST_B;
#pragma unroll
    for (int i = 0; i < 16; ++i) v[i] = p[i];
    dft16_inv(v);
#pragma unroll
    for (int i = 0; i < 16; ++i) p[i] = v[i];
  }
  __syncthreads();
  {
    float2* p = X + hi * FST_A + lo;
#pragma unroll
    for (int i = 0; i < 16; ++i) v[i] = cmulc(p[i * FST_B], twid(TW, 16 * lo * brev4(i)));
    dft16_inv(v);
#pragma unroll
    for (int i = 0; i < 16; ++i) p[i * FST_B] = v[i];
  }
  __syncthreads();
  {
    float2* p = X + hi * FST_B + lo;
#pragma unroll
    for (int i = 0; i < 16; ++i) v[i] = cmulc(p[i * FST_A], twid(TW, t * brev4(i)));
    dft16_inv(v);
#pragma unroll
    for (int i = 0; i < 16; ++i) p[i * FST_A] = v[i];
  }
  __syncthreads();
}

DI void transpose_convert(const float* src, int K, int N, bfr* dst, int Kp, int Np, const float* kscale, char* shm) {
  float* tile = (float*)shm;
  const int tk = Kp / 64, tn = Np / 64;
  const int tid = tidx();
#pragma unroll 1
  for (int it = blockIdx.x; it < tk * tn; it += gridDim.x) {
    const int k0 = (it % tk) * 64, n0 = (it / tk) * 64;
    __syncthreads();
    float4 v[2];
#pragma unroll
    for (int q = 0; q < 2; ++q) {
      const int idx = tid + q * NTHREADS, kk = idx >> 4, n4 = (idx & 15) * 4, k = k0 + kk, n = n0 + n4;
      v[q] = make_float4(0.f, 0.f, 0.f, 0.f);
      if (k < K && n < N) { v[q] = *reinterpret_cast<const float4*>(src + (long)k * N + n); if (kscale) { const float sc = kscale[k]; v[q].x *= sc; v[q].y *= sc; v[q].z *= sc; v[q].w *= sc; } }
    }
#pragma unroll
    for (int q = 0; q < 2; ++q) { const int idx = tid + q * NTHREADS; *reinterpret_cast<float4*>(tile + (idx >> 4) * 68 + (idx & 15) * 4) = v[q]; }
    __syncthreads();
#pragma unroll
    for (int q = 0; q < 2; ++q) {
      const int idx = tid + q * NTHREADS, nn = idx >> 4, k4 = (idx & 15) * 4;
      uint2 pk; pk.x = pack2(tile[k4 * 68 + nn], tile[(k4 + 1) * 68 + nn]); pk.y = pack2(tile[(k4 + 2) * 68 + nn], tile[(k4 + 3) * 68 + nn]);
      *reinterpret_cast<uint2*>(dst + (long)(n0 + nn) * Kp + k0 + k4) = pk;
    }
  }
}

DI void ln_rows(const float* src, float* dst32, bfr* dstb, const float* g, const float* bta) {
  const int wid = tidx() >> 6, lane = tidx() & 63;
#pragma unroll 1
  for (int row0 = (blockIdx.x * 8 + wid) * 2; row0 < NT; row0 += gridDim.x * 16) {
    float4 v[2][4];
#pragma unroll
    for (int q = 0; q < 2; ++q)
#pragma unroll
      for (int i = 0; i < 4; ++i) v[q][i] = reinterpret_cast<const float4*>(src + (long)(row0 + q) * D)[i * 64 + lane];
#pragma unroll
    for (int q = 0; q < 2; ++q) {
      const int row = row0 + q;
      float sum = 0.f;
#pragma unroll
      for (int i = 0; i < 4; ++i) sum += v[q][i].x + v[q][i].y + v[q][i].z + v[q][i].w;
#pragma unroll
      for (int o = 32; o >= 1; o >>= 1) sum += __shfl_xor(sum, o);
      const float mu = sum * (1.f / D);
      float sq = 0.f;
#pragma unroll
      for (int i = 0; i < 4; ++i) { v[q][i].x -= mu; v[q][i].y -= mu; v[q][i].z -= mu; v[q][i].w -= mu; sq += v[q][i].x * v[q][i].x + v[q][i].y * v[q][i].y + v[q][i].z * v[q][i].z + v[q][i].w * v[q][i].w; }
#pragma unroll
      for (int o = 32; o >= 1; o >>= 1) sq += __shfl_xor(sq, o);
      const float rstd = rsqrtf(sq * (1.f / D) + 1e-5f);
#pragma unroll
      for (int i = 0; i < 4; ++i) {
        const int c4 = i * 64 + lane;
        const float4 gg = reinterpret_cast<const float4*>(g)[c4], bb = reinterpret_cast<const float4*>(bta)[c4];
        float4 y; y.x = v[q][i].x * rstd * gg.x + bb.x; y.y = v[q][i].y * rstd * gg.y + bb.y; y.z = v[q][i].z * rstd * gg.z + bb.z; y.w = v[q][i].w * rstd * gg.w + bb.w;
        if (dst32) reinterpret_cast<float4*>(dst32 + (long)row * D)[c4] = y;
        uint2 pk; pk.x = pack2(y.x, y.y); pk.y = pack2(y.z, y.w);
        reinterpret_cast<uint2*>(dstb + (long)row * D)[c4] = pk;
      }
    }
  }
}

DI void phase_prep(const PX& P, char* shm) {
  char* ws = P.ws;
  for (int l = 0; l < NL; ++l) {
    bfr* W = (bfr*)(ws + WS_W) + (size_t)l * EW_LAYER;
    transpose_convert(P.in[4] + (size_t)l * 1024 * INW, 1024, INW, W + WO_IN, 1024, 2816, nullptr, shm);
    transpose_convert(P.in[7] + (size_t)l * 256 * 384, 256, 384, W + WO_UQ, 256, 512, P.in[5] + l * 256, shm);
    transpose_convert(P.in[8] + (size_t)l * 128 * 512, 128, 512, W + WO_UKV, 256, 512, P.in[6] + l * 128, shm);
    transpose_convert(P.in[25] + (size_t)l * 1024 * 1024, 1024, 1024, W + WO_OUT, 1024, 1024, P.in[24] + l * 1024, shm);
    transpose_convert(P.in[28] + (size_t)l * 1024 * DFF, 1024, DFF, W + WO_G, 1024, DFF, nullptr, shm);
    transpose_convert(P.in[29] + (size_t)l * 1024 * DFF, 1024, DFF, W + WO_U, 1024, DFF, nullptr, shm);
    transpose_convert(P.in[32] + (size_t)l * DFF * 1024, DFF, 1024, W + WO_D, DFF, 1024, nullptr, shm);
    transpose_convert(P.in[35] + (size_t)l * 256 * 1024, 256, 1024, W + WO_PP, 256, 1024, nullptr, shm);
    transpose_convert(P.in[36] + (size_t)l * 1024 * 1024, 1024, 1024, W + WO_PG, 1024, 1024, nullptr, shm);
  }
  __syncthreads();
  {
    float2* rope = (float2*)(ws + WS_ROPE);
    float2* tw = (float2*)(ws + WS_TW);
    for (int e = blockIdx.x * NTHREADS + tidx(); e < 2048 * 16 + 2048; e += gridDim.x * NTHREADS) {
      if (e < 2048 * 16) {
        const int t = e >> 4, j = e & 15;
        const float invf = exp2f(-(float)j * (13.287712379549449f / 16.0f));
        const float ang = (float)t * invf;
        float sn, cs; sincosf(ang, &sn, &cs);
        rope[e] = make_float2(cs, sn);
      } else {
        const int k = e - 2048 * 16;
        float sn, cs; sincospif((float)k * (1.0f / 2048.0f), &sn, &cs);
        tw[k] = make_float2(cs, -sn);
      }
    }
  }
  {
    float* sm = (float*)shm;
    float* kbuf = (float*)(ws + WS_KBUF);
    const int tid = tidx();
#pragma unroll 1
    for (int it = blockIdx.x; it < NL * (S / 4); it += gridDim.x) {
      const int l = it / (S / 4), tb = (it % (S / 4)) * 4;
      const float* w1 = P.in[11] + l * 33 * 64; const float* b1 = P.in[12] + l * 64; const float* fq = P.in[13] + l * 64;
      const float* w2 = P.in[14] + l * 64 * 64; const float* b2 = P.in[15] + l * 64; const float* w3 = P.in[16] + (size_t)l * 64 * 1024;
      __syncthreads();
      if (tid < 4 * 33) {
        const int q = tid / 33, i = tid % 33, t = tb + q;
        float f;
        if (i == 0) f = (float)t / 2047.0f;
        else {
          const int bi = (i - 1) & 15;
          const float band = 1e-4f + (float)bi * ((15.0f - 1e-4f) / 15.0f);
          const float ang = 6.283185307179586f * (float)t / 2048.0f;
          const float a = band * ang;
          f = (i <= 16) ? cosf(a) : -sinf(a);
        }
        sm[q * 64 + i] = f;
      }
      __syncthreads();
      if (tid < 256) {
        const int q = tid >> 6, j = tid & 63; float a = b1[j];
        for (int i = 0; i < 33; ++i) a += sm[q * 64 + i] * w1[i * 64 + j];
        sm[256 + q * 64 + j] = sinf(fq[j] * a);
      }
      __syncthreads();
      if (tid < 256) {
        const int q = tid >> 6, j = tid & 63; float a = b2[j];
        for (int i = 0; i < 64; ++i) a += sm[256 + q * 64 + i] * w2[i * 64 + j];
        sm[512 + q * 64 + j] = sinf(fq[j] * a);
      }
      __syncthreads();
#pragma unroll 1
      for (int oc = tid; oc < 1024; oc += NTHREADS) {
        float a0 = 0.f, a1 = 0.f, a2 = 0.f, a3 = 0.f;
#pragma unroll 8
        for (int i = 0; i < 64; ++i) { const float w = w3[i * 1024 + oc]; a0 += sm[512 + i] * w; a1 += sm[576 + i] * w; a2 += sm[640 + i] * w; a3 += sm[704 + i] * w; }
        const int o = oc >> 9, dir = (oc >> 8) & 1, c = oc & 255;
        const float mind = -3.0701134573253945f, maxd = -15.350567286626973f;
        const float delta = fabsf(mind + (float)c * ((maxd - mind) / 255.0f));
        float* kb = kbuf + ((size_t)((l * 2 + o) * 256 + c)) * 4096;
        const float av[4] = {a0, a1, a2, a3};
#pragma unroll
        for (int q = 0; q < 4; ++q) {
          const int t = tb + q;
          const float a = av[q] * expf(-((float)t / 2047.0f) * delta);
          if (dir == 0) kb[t] = a;
          else { if (t == 0) kb[2048] = 0.f; else kb[4096 - t] = a; }
        }
      }
    }
  }
  ln_rows(P.in[0], nullptr, (bfr*)(ws + WS_HB), P.in[2], P.in[3]);
}

DI void phase_gemm_in(const PX& P, int l, char* shm, int skip = 0) {
  const bfr* A = (const bfr*)(P.ws + WS_HB);
  const bfr* Bt = (const bfr*)(P.ws + WS_W) + (size_t)l * EW_LAYER + WO_IN;
  EpiStoreBf16 epi{(bfr*)(P.ws + WS_U), INP};
  for (int u = blockIdx.x; u < 256 * 11; u += gridDim.x) {
    int pm, pn; unit_to_tile(u, 256, 11, pm, pn);
#if PROBE_GEMM
    if (skip) gemm_unit<1024, 1024, EpiStoreBf16, PROBE_GEMM>(A, Bt, 1024, pm * 256, pn * 256, shm, epi);
    else
#endif
    gemm_unit<1024, 1024>(A, Bt, 1024, pm * 256, pn * 256, shm, epi);
  }
}

template <int NCOL>
DI void row_rstd(const bfr* Ucol, int brow, float* rs) {
  const int r = tidx() >> 1, hf = tidx() & 1;
  const unsigned uoff = (unsigned)(brow + r) * (unsigned)INP + (unsigned)(hf * NCOL);
  const bfr* up = Ucol + uoff;
  float ss = 0.f;
  uint4 q[NCOL / 8];
#pragma unroll
  for (int c = 0; c < NCOL / 8; ++c) q[c] = *reinterpret_cast<const uint4*>(up + c * 8);
#pragma unroll
  for (int c = 0; c < NCOL / 8; ++c) {
    float f[8]; unpack8(q[c], f);
#pragma unroll
    for (int e = 0; e < 8; ++e) ss += f[e] * f[e];
  }
  ss += __shfl_xor(ss, 1);
  if (hf == 0) rs[r] = rsqrtf(ss / (float)(2 * NCOL) + 1e-6f);
  __syncthreads();
}

DI void phase_premix(const PX& P, int l, char* shm) {
  char* ws = P.ws;
  const bfr* U = (const bfr*)(ws + WS_U);
  const bfr* W = (const bfr*)(ws + WS_W) + (size_t)l * EW_LAYER;
  float* rs = (float*)(shm + 135168);
  const float2* rope = (const float2*)(ws + WS_ROPE);
#ifndef SKIP_Q
  {
    EpiQ epi{(bfr*)(ws + WS_Q), rs, rope};
#pragma unroll 1
    for (int it = blockIdx.x; it < 512; it += gridDim.x) {
      const int pn = it & 1, brow = (it >> 1) * 256;
      row_rstd<128>(U + OQ, brow, rs);
      gemm_unit<INP, 256>(U + OQ, W + WO_UQ, 256, brow, pn * 256, shm, epi);
    }
  }
#endif
#ifndef SKIP_KV
  {
    EpiKV epi{(bfr*)(ws + WS_K), (bfr*)(ws + WS_VT), rs};
#pragma unroll 1
    for (int it = blockIdx.x; it < 512; it += gridDim.x) {
      const int pn = it & 1, brow = (it >> 1) * 256;
      row_rstd<64>(U + OKV, brow, rs);
      gemm_unit<INP, 256>(U + OKV, W + WO_UKV, 256, brow, pn * 256, shm, epi);
    }
  }
#endif
  {
    bfr* Kf = (bfr*)(ws + WS_K);
    for (long e = (long)blockIdx.x * NTHREADS + tidx(); e < (long)NT * 16; e += (long)gridDim.x * NTHREADS) {
      const int jj = (int)(e & 15); const long row = e >> 4; const int b = (int)(row >> 11), t = (int)(row & (S - 1));
      const float x1 = bf2f(U[row * INP + OKR + jj]), x2 = bf2f(U[row * INP + OKR + 16 + jj]);
      const float2 cs = rope[t * 16 + jj];
      const bfr o1 = f2bf(x1 * cs.x - x2 * cs.y), o2 = f2bf(x2 * cs.x + x1 * cs.y);
#pragma unroll
      for (int hh = 0; hh < 4; ++hh) {
        bfr* kp = Kf + (((long)(b * 4 + hh)) * S + t) * 96 + 64 + jj;
        kp[0] = o1; kp[16] = o2;
      }
    }
  }
  {
    bfr* tile = (bfr*)shm;
    bfr* HYT = (bfr*)(ws + WS_HYT);
    const float* cw = P.in[9] + l * 3 * 768; const float* cbias = P.in[10] + l * 768;
    const int tid = tidx();
#pragma unroll 1
    for (int it = blockIdx.x; it < 1024; it += gridDim.x) {
      const int b = it >> 5, t0 = (it & 31) * 64;
      __syncthreads();
#pragma unroll 1
      for (int e0 = tid; e0 < 96 * 64; e0 += 4 * NTHREADS) {
        uint4 q0[4], qm[4], qp[4];
#pragma unroll
        for (int i = 0; i < 4; ++i) {
          const int e = e0 + i * NTHREADS, c8 = e % 96, tl = e / 96, t = t0 + tl;
          const bfr* ub = U + ((long)b * S + t) * INP + OHY + c8 * 8;
          q0[i] = *reinterpret_cast<const uint4*>(ub);
          qm[i] = make_uint4(0, 0, 0, 0); qp[i] = make_uint4(0, 0, 0, 0);
          if (t > 0) qm[i] = *reinterpret_cast<const uint4*>(ub - INP);
          if (t < S - 1) qp[i] = *reinterpret_cast<const uint4*>(ub + INP);
        }
#pragma unroll
        for (int i = 0; i < 4; ++i) {
          const int e = e0 + i * NTHREADS, c8 = e % 96, tl = e / 96, c = c8 * 8;
          float u0[8], um[8], up[8], w[8], a[8];
          unpack8(q0[i], u0); unpack8(qm[i], um); unpack8(qp[i], up);
          ld8f(cbias + c, a);
          ld8f(cw + c, w);
#pragma unroll
          for (int j = 0; j < 8; ++j) a[j] += w[j] * um[j];
          ld8f(cw + 768 + c, w);
#pragma unroll
          for (int j = 0; j < 8; ++j) a[j] += w[j] * u0[j];
          ld8f(cw + 1536 + c, w);
          const int tr = (tl + 2 * c8) & 63;
#pragma unroll
          for (int j = 0; j < 8; ++j) tile[(c + j) * 66 + tr] = f2bf(a[j] + w[j] * up[j]);
        }
      }
      __syncthreads();
#pragma unroll 1
      for (int e = tid; e < 768 * 8; e += NTHREADS) {
        const int c = e >> 3, ch = e & 7, rot = c >> 3;
        const unsigned* tp = reinterpret_cast<const unsigned*>(tile + c * 66);
        uint4 v; v.x = tp[(ch * 4 + rot) & 31]; v.y = tp[(ch * 4 + 1 + rot) & 31]; v.z = tp[(ch * 4 + 2 + rot) & 31]; v.w = tp[(ch * 4 + 3 + rot) & 31];
        *reinterpret_cast<uint4*>(HYT + ((long)(b * 768 + c)) * S + t0 + ch * 8) = v;
      }
    }
  }
  if (l == 0) {
    const int tid = tidx(), hw = tid >> 8, t = tid & 255;
    float2* X = (float2*)shm + hw * FFT_LDS; float2* TW = (float2*)(shm + 2 * FFT_LDS * 8);
    const float* kbuf = (const float*)(ws + WS_KBUF);
    float2* KF = (float2*)(ws + WS_KF);
    const float2* twg = (const float2*)(ws + WS_TW);
    for (int it0 = blockIdx.x * 2; it0 < 1024; it0 += gridDim.x * 2) {
      const int it = it0 + hw;
      __syncthreads();
      for (int e = tid; e < 2048; e += NTHREADS) TW[e] = twg[e];
      for (int e = t; e < 4096; e += 256) X[fpos(e)] = make_float2(kbuf[(size_t)it * 4096 + e], 0.f);
      __syncthreads();
      fft_fwd(X, TW, t);
      for (int e = t; e < 4096; e += 256) { const float2 v = X[fpos(e)]; KF[(size_t)it * 4096 + e] = make_float2(v.x * (1.f / 4096.f), v.y * (1.f / 4096.f)); }
    }
  }
}

DI void ssd_item(const PX& P, int l, int item, char* shm) {
  constexpr int ST = 136;
  const bfr* U = (const bfr*)(P.ws + WS_U);
  bfr* YS = (bfr*)(P.ws + WS_YSSD);
  const int b = item >> 3, dir = (item >> 2) & 1, hd = item & 3, g = hd >> 1;
  const int tid = tidx(), wid = tid >> 6, lane = tid & 63, r = lane & 31, h = lane >> 5;
  const float* cw = P.in[19] + l * 3 * 768; const float* cbias = P.in[20] + l * 768;
  const float dtb = P.in[21][l * 8 + dir * 4 + hd];
  const float Acoef = -__expf(P.in[22][l * 8 + dir * 4 + hd]);
  bfr* Cs = (bfr*)shm;
  bfr* Bs = Cs + 128 * ST;
  bfr* BTd = Bs + 128 * ST;
  bfr* XT = BTd + 128 * ST;
  bfr* Rb = XT + 64 * ST;
  float* acs = (float*)(Rb + 64 * ST);
  float* dts = acs + 128;
  f32x16 racc;
#pragma unroll
  for (int i = 0; i < 16; ++i) racc[i] = 0.f;
  for (int e = tid; e < 64 * ST / 2; e += NTHREADS) reinterpret_cast<unsigned*>(Rb)[e] = 0u;
  float xr_next[2] = {0.f, 0.f};
  if (wid == 0) {
#pragma unroll
    for (int q = 0; q < 2; ++q) {
      const int k = lane * 2 + q, t = dir == 0 ? k : S - 1 - k;
      xr_next[q] = bf2f(U[((long)b * S + t) * INP + ODT + dir * 4 + hd]);
    }
  }
#pragma unroll 1
  for (int ci = 0; ci < 16; ++ci) {
    __syncthreads();
    if (wid == 0) {
      float a2[2], d2[2];
#pragma unroll
      for (int q = 0; q < 2; ++q) {
        const float xr = xr_next[q] + dtb;
        d2[q] = xr > 20.f ? xr : log1pf(__expf(xr));
        a2[q] = d2[q] * Acoef;
      }
      if (ci + 1 < 16) {
#pragma unroll
        for (int q = 0; q < 2; ++q) {
          const int k = lane * 2 + q, step = (ci + 1) * 128 + k, t = dir == 0 ? step : S - 1 - step;
          xr_next[q] = bf2f(U[((long)b * S + t) * INP + ODT + dir * 4 + hd]);
        }
      }
      const float pairsum = a2[0] + a2[1];
      float sc = pairsum;
      int lane_o = lane; asm volatile("" : "+v"(lane_o));
#pragma unroll
      for (int o = 1; o < 64; o <<= 1) { const float v = __shfl_up(sc, o); sc += (lane_o >= o) ? v : 0.f; }
      acs[lane * 2] = sc - a2[1]; acs[lane * 2 + 1] = sc;
      dts[lane * 2] = d2[0]; dts[lane * 2 + 1] = d2[1];
    }
    __syncthreads();
    const float atot = acs[127];
#pragma unroll 1
    for (int i0 = 0; i0 < 10; i0 += 5) {
      uint4 q0[5], qm[5], qp[5];
#pragma unroll
      for (int i = 0; i < 5; ++i) {
        const int it = tid + (i0 + i) * NTHREADS, k = it / 40, cc8 = it % 40;
        const int step = ci * 128 + k, t = dir == 0 ? step : S - 1 - step;
        const int col = cc8 < 8 ? hd * 64 + cc8 * 8 : (cc8 < 24 ? 256 + g * 128 + (cc8 - 8) * 8 : 512 + g * 128 + (cc8 - 24) * 8);
        const bfr* ub = U + ((long)b * S + t) * INP + OXBC + col;
        q0[i] = *reinterpret_cast<const uint4*>(ub);
        qm[i] = make_uint4(0, 0, 0, 0); qp[i] = make_uint4(0, 0, 0, 0);
        if (t > 0) qm[i] = *reinterpret_cast<const uint4*>(ub - INP);
        if (t < S - 1) qp[i] = *reinterpret_cast<const uint4*>(ub + INP);
      }
#pragma unroll
      for (int i = 0; i < 5; ++i) {
        const int it = tid + (i0 + i) * NTHREADS, k = it / 40, cc8 = it % 40;
        const int col = cc8 < 8 ? hd * 64 + cc8 * 8 : (cc8 < 24 ? 256 + g * 128 + (cc8 - 8) * 8 : 512 + g * 128 + (cc8 - 24) * 8);
        float u0[8], um[8], up[8], w[8], a[8];
        unpack8(q0[i], u0); unpack8(qm[i], um); unpack8(qp[i], up);
        ld8f(cbias + col, a);
        ld8f(cw + col, w);
#pragma unroll
        for (int j = 0; j < 8; ++j) a[j] += w[j] * um[j];
        ld8f(cw + 768 + col, w);
#pragma unroll
        for (int j = 0; j < 8; ++j) a[j] += w[j] * u0[j];
        ld8f(cw + 1536 + col, w);
#pragma unroll
        for (int j = 0; j < 8; ++j) a[j] = silu(a[j] + w[j] * up[j]);
        if (cc8 < 8) {
          const float dtk = dts[k];
#pragma unroll
          for (int j = 0; j < 8; ++j) XT[(cc8 * 8 + j) * ST + k] = f2bf(a[j] * dtk);
        } else if (cc8 < 24) {
          const int n0 = (cc8 - 8) * 8;
          *reinterpret_cast<uint4*>(Bs + k * ST + n0) = pack8(a);
          const float dec = __expf(atot - acs[k]);
#pragma unroll
          for (int j = 0; j < 8; ++j) BTd[(n0 + j) * ST + k] = f2bf(a[j] * dec);
        } else {
          *reinterpret_cast<uint4*>(Cs + k * ST + (cc8 - 24) * 8) = pack8(a);
        }
      }
    }
    __syncthreads();
    const int ti = wid >> 1;
    f32x16 cb[2];
#pragma unroll
    for (int q = 0; q < 2; ++q) {
      const int si = (wid & 1) * 2 + q;
#pragma unroll
      for (int i = 0; i < 16; ++i) cb[q][i] = 0.f;
      if (si <= ti) {
#pragma unroll
        for (int kk = 0; kk < 8; ++kk) {
          const bf16x8 av = *reinterpret_cast<const bf16x8*>(Cs + (32 * ti + r) * ST + kk * 16 + h * 8);
          const bf16x8 bv = *reinterpret_cast<const bf16x8*>(Bs + (32 * si + r) * ST + kk * 16 + h * 8);
          cb[q] = MFMA32(av, bv, cb[q]);
        }
      }
    }
    __syncthreads();
#pragma unroll
    for (int q = 0; q < 2; ++q) {
      const int si = (wid & 1) * 2 + q; int s = 32 * si + r; asm volatile("" : "+v"(s));
      const float as = acs[s];
#pragma unroll
      for (int i = 0; i < 16; ++i) {
        const int t = 32 * ti + (i & 3) + 8 * (i >> 2) + 4 * h;
        const float v = (s <= t) ? cb[q][i] * __expf(acs[t] - as) : 0.f;
        Bs[t * ST + s] = f2bf(v);
      }
    }
    __syncthreads();
    {
      const int pi = wid & 1;
      f32x16 y1, y2;
#pragma unroll
      for (int i = 0; i < 16; ++i) { y1[i] = 0.f; y2[i] = 0.f; }
#pragma unroll
      for (int kk = 0; kk < 8; ++kk) {
        const bf16x8 xv = *reinterpret_cast<const bf16x8*>(XT + (32 * pi + r) * ST + kk * 16 + h * 8);
        if (kk * 16 < 32 * ti + 32) {
          const bf16x8 mv = *reinterpret_cast<const bf16x8*>(Bs + (32 * ti + r) * ST + kk * 16 + h * 8);
          y1 = MFMA32(mv, xv, y1);
        }
        const bf16x8 cv = *reinterpret_cast<const bf16x8*>(Cs + (32 * ti + r) * ST + kk * 16 + h * 8);
        const bf16x8 rv = *reinterpret_cast<const bf16x8*>(Rb + (32 * pi + r) * ST + kk * 16 + h * 8);
        y2 = MFMA32(cv, rv, y2);
      }
#pragma unroll
      for (int i = 0; i < 16; ++i) {
        const int k = 32 * ti + (i & 3) + 8 * (i >> 2) + 4 * h;
        const int step = ci * 128 + k, t = dir == 0 ? step : S - 1 - step;
        const float y = y1[i] + __expf(acs[k]) * y2[i];
        YS[((size_t)dir * NT + (size_t)b * S + t) * 256 + hd * 64 + 32 * pi + r] = f2bf(y);
      }
    }
    {
      const int pi = wid >> 2, ni = wid & 3;
      const float ed = __expf(atot);
#pragma unroll
      for (int i = 0; i < 16; ++i) racc[i] *= ed;
#pragma unroll
      for (int kk = 0; kk < 8; ++kk) {
        const bf16x8 xv = *reinterpret_cast<const bf16x8*>(XT + (32 * pi + r) * ST + kk * 16 + h * 8);
        const bf16x8 bv = *reinterpret_cast<const bf16x8*>(BTd + (32 * ni + r) * ST + kk * 16 + h * 8);
        racc = MFMA32(xv, bv, racc);
      }
      __syncthreads();
#pragma unroll
      for (int i = 0; i < 16; ++i) Rb[(32 * pi + (i & 3) + 8 * (i >> 2) + 4 * h) * ST + 32 * ni + r] = f2bf(racc[i]);
    }
  }
}

DI void hyena_item(const PX& P, int l, int item0, char* shm) {
  const int tid = tidx(), hw = tid >> 8, t = tid & 255;
  const int item = item0 + hw;
  const int c = item >> 4, bp = item & 15, b0 = bp * 2, b1 = b0 + 1;
  float2* X = (float2*)shm + hw * FFT_LDS;
  float2* TW = (float2*)(shm + 2 * FFT_LDS * 8);
  float2* Z1 = TW + 2048 + hw * 2048;
  const bfr* HYT = (const bfr*)(P.ws + WS_HYT);
  const float2* twg = (const float2*)(P.ws + WS_TW);
  const float2* KF0 = (const float2*)(P.ws + WS_KF) + ((size_t)((l * 2 + 0) * 256 + c)) * 4096;
  const float2* KF1 = (const float2*)(P.ws + WS_KF) + ((size_t)((l * 2 + 1) * 256 + c)) * 4096;
  const float bias0 = P.in[17][(l * 2 + 0) * 256 + c], bias1 = P.in[17][(l * 2 + 1) * 256 + c];
  const bfr* v0 = HYT + ((size_t)(b0 * 768 + c)) * S; const bfr* v1 = HYT + ((size_t)(b1 * 768 + c)) * S;
  const bfr* x10 = v0 + 256 * S; const bfr* x11 = v1 + 256 * S;
  const bfr* x20 = v0 + 512 * S; const bfr* x21 = v1 + 512 * S;
  bfr* yo0 = (bfr*)(P.ws + WS_YH) + ((size_t)(b0 * 256 + c)) * S; bfr* yo1 = (bfr*)(P.ws + WS_YH) + ((size_t)(b1 * 256 + c)) * S;
  __syncthreads();
  for (int e = tid; e < 2048; e += NTHREADS) TW[e] = twg[e];
  {
    float a[8], b[8];
    unpack8(*reinterpret_cast<const uint4*>(v0 + t * 8), a); unpack8(*reinterpret_cast<const uint4*>(v1 + t * 8), b);
#pragma unroll
    for (int k = 0; k < 8; ++k) { X[fpos(t * 8 + k)] = make_float2(a[k], b[k]); X[fpos(2048 + t * 8 + k)] = make_float2(0.f, 0.f); }
  }
  __syncthreads();
  fft_fwd(X, TW, t);
  { float2 kf[16];
#pragma unroll
    for (int i = 0; i < 16; ++i) kf[i] = KF0[t + i * 256];
#pragma unroll
    for (int i = 0; i < 16; ++i) { const int p = fpos(t + i * 256); X[p] = cmul(X[p], kf[i]); } }
  __syncthreads();
  fft_inv(X, TW, t);
  {
    float a[8], b[8], g0[8], g1[8];
    unpack8(*reinterpret_cast<const uint4*>(v0 + t * 8), a); unpack8(*reinterpret_cast<const uint4*>(v1 + t * 8), b);
    unpack8(*reinterpret_cast<const uint4*>(x10 + t * 8), g0); unpack8(*reinterpret_cast<const uint4*>(x11 + t * 8), g1);
    float2 z[8];
#pragma unroll
    for (int k = 0; k < 8; ++k) { const float2 y = X[fpos(t * 8 + k)]; z[k] = make_float2(g0[k] * (y.x + bias0 * a[k]), g1[k] * (y.y + bias0 * b[k])); }
    __syncthreads();
#pragma unroll
    for (int k = 0; k < 8; ++k) { Z1[t * 8 + k] = z[k]; X[fpos(t * 8 + k)] = z[k]; X[fpos(2048 + t * 8 + k)] = make_float2(0.f, 0.f); }
  }
  __syncthreads();
  fft_fwd(X, TW, t);
  { float2 kf[16];
#pragma unroll
    for (int i = 0; i < 16; ++i) kf[i] = KF1[t + i * 256];
#pragma unroll
    for (int i = 0; i < 16; ++i) { const int p = fpos(t + i * 256); X[p] = cmul(X[p], kf[i]); } }
  __syncthreads();
  fft_inv(X, TW, t);
  {
    float g0[8], g1[8], o0[8], o1[8];
    unpack8(*reinterpret_cast<const uint4*>(x20 + t * 8), g0); unpack8(*reinterpret_cast<const uint4*>(x21 + t * 8), g1);
#pragma unroll
    for (int k = 0; k < 8; ++k) { const float2 y = X[fpos(t * 8 + k)], z1 = Z1[t * 8 + k]; o0[k] = g0[k] * (y.x + bias1 * z1.x); o1[k] = g1[k] * (y.y + bias1 * z1.y); }
    *reinterpret_cast<uint4*>(yo0 + t * 8) = pack8(o0); *reinterpret_cast<uint4*>(yo1 + t * 8) = pack8(o1);
  }
}

DI void phase_mix(const PX& P, int l, char* shm) {
  char* ws = P.ws;
  for (int rep = 0; rep < ((PROBE_MIX & 1) ? 2 : 1); ++rep)
  for (int it = blockIdx.x; it < 256; it += gridDim.x) ssd_item(P, l, it, shm);
  {
    const float sc = 0.10206207261596575f * LOG2E;
    for (int it = blockIdx.x; it < 1024; it += gridDim.x) {
      const int qblk = it & 7, bh = it >> 3, b = bh >> 2, hh = bh & 3;
      const bfr* q = (const bfr*)(ws + WS_Q) + (size_t)bh * S * 96;
      const bfr* k = (const bfr*)(ws + WS_K) + (size_t)bh * S * 96;
      const bfr* vt = (const bfr*)(ws + WS_VT) + (size_t)bh * 64 * S;
      bfr* o = (bfr*)(ws + WS_Y) + (size_t)b * S * 512 + hh * 64;
      attn_item<96, false>(q, 96, k, 96, vt, S, qblk * 256, 0, S, sc, 0.f, 0.f, o, 512, shm);
    }
  }
  {
    const bfr* U = (const bfr*)(ws + WS_U);
    for (int it = blockIdx.x; it < 1024; it += gridDim.x) {
      const int qblk = it & 7, bh = it >> 3, b = bh >> 2, hh = bh & 3, kvh = hh >> 1;
      const bfr* q = U + (size_t)b * S * INP + OSQ + hh * 64;
      const bfr* k = U + (size_t)b * S * INP + OSK + kvh * 64;
      const bfr* v = U + (size_t)b * S * INP + OSV + kvh * 64;
      bfr* o = (bfr*)(ws + WS_Y) + (size_t)b * S * 512 + 256 + hh * 64;
      const int q0 = qblk * 256, klo = max(q0 - 128, 0), khi = min(q0 + 256 + 128, S);
      const float slope = exp2f(-2.f * (float)(hh + 1));
      attn_item<64, true>(q, INP, k, INP, v, INP, q0, klo, khi, 0.125f * LOG2E, slope * LOG2E, P.in[18][l * 4 + hh] * LOG2E, o, 512, shm);
    }
  }
  for (int rep = 0; rep < ((PROBE_MIX & 8) ? 2 : 1); ++rep)
  for (int it = blockIdx.x * 2; it < 4096; it += gridDim.x * 2) hyena_item(P, l, it, shm);
}

DI void norm_store(float* vals, bfr* op) {
  float ss = 0.f;
#pragma unroll
  for (int k = 0; k < 16; ++k) ss += vals[k] * vals[k];
  ss += swz_xor<1>(ss); ss += swz_xor<2>(ss); ss += swz_xor<4>(ss); ss += swz_xor<8>(ss);
  const float rstd = rsqrtf(ss * (1.f / 256.f) + 1e-6f);
#pragma unroll
  for (int k = 0; k < 16; ++k) vals[k] *= rstd;
  *reinterpret_cast<uint4*>(op) = pack8(vals); *reinterpret_cast<uint4*>(op + 8) = pack8(vals + 8);
}

DI void phase_norm(const PX& P, int l, char* shm) {
  char* ws = P.ws;
  const bfr* U = (const bfr*)(ws + WS_U);
  const bfr* Y = (const bfr*)(ws + WS_Y);
  const bfr* YH = (const bfr*)(ws + WS_YH);
  const bfr* YS = (const bfr*)(ws + WS_YSSD);
  bfr* YN = (bfr*)(ws + WS_YN);
  bfr* hy = (bfr*)shm;
  const float* cw = P.in[19] + l * 3 * 768; const float* cbias = P.in[20] + l * 768;
  const int tid = tidx(), wid = tid >> 6, lane = tid & 63;
  const int grp = wid & 3, tsub = (wid >> 2) * 32, tk = lane >> 4, c16 = (lane & 15) * 16;
#pragma unroll 1
  for (int it = blockIdx.x; it < 1024; it += gridDim.x) {
    const int b = it >> 5, t0 = (it & 31) * 64;
    __syncthreads();
    for (int e = tid; e < 2048; e += NTHREADS) {
      const int c = e >> 3, ch = e & 7, rot = c >> 4;
      const uint4 v = *reinterpret_cast<const uint4*>(YH + ((size_t)(b * 256 + c)) * S + t0 + ch * 8);
      unsigned* tp = reinterpret_cast<unsigned*>(hy + c * 66);
      tp[(ch * 4 + rot) & 31] = v.x; tp[(ch * 4 + 1 + rot) & 31] = v.y; tp[(ch * 4 + 2 + rot) & 31] = v.z; tp[(ch * 4 + 3 + rot) & 31] = v.w;
    }
    __syncthreads();
    if (grp == 0 || grp == 2) {
      uint4 qa[8], qb[8];
#pragma unroll
      for (int i = 0; i < 8; ++i) {
        const long row = (long)b * S + t0 + tsub + i * 4 + tk;
        const bfr* yp = Y + row * 512 + (grp == 0 ? 0 : 256) + c16;
        qa[i] = *reinterpret_cast<const uint4*>(yp); qb[i] = *reinterpret_cast<const uint4*>(yp + 8);
      }
#pragma unroll
      for (int i = 0; i < 8; ++i) {
        const long row = (long)b * S + t0 + tsub + i * 4 + tk;
        float vals[16];
        unpack8(qa[i], vals); unpack8(qb[i], vals + 8);
        norm_store(vals, YN + row * 1024 + grp * 256 + c16);
      }
    } else if (grp == 1) {
#pragma unroll 2
      for (int i = 0; i < 8; ++i) {
        const int tl = tsub + i * 4 + tk; const long row = (long)b * S + t0 + tl;
        const int tr = (tl + 2 * (lane & 15)) & 63;
        float vals[16];
#pragma unroll
        for (int k = 0; k < 16; ++k) vals[k] = bf2f(hy[(c16 + k) * 66 + tr]);
        norm_store(vals, YN + row * 1024 + 256 + c16);
      }
    } else {
      const int hd = c16 >> 6;
      const float dsum = P.in[23][l * 8 + hd] + P.in[23][l * 8 + 4 + hd];
#pragma unroll 1
      for (int i = 0; i < 8; ++i) {
        const int tl = tsub + i * 4 + tk, t = t0 + tl; const long row = (long)b * S + t;
        const bfr* ub = U + row * INP + OXBC + c16;
        uint4 q0[2], qm[2], qp[2], qf[2], qbk[2], qz[2];
#pragma unroll
        for (int hf = 0; hf < 2; ++hf) {
          q0[hf] = *reinterpret_cast<const uint4*>(ub + hf * 8);
          qm[hf] = make_uint4(0, 0, 0, 0); qp[hf] = make_uint4(0, 0, 0, 0);
          if (t > 0) qm[hf] = *reinterpret_cast<const uint4*>(ub - INP + hf * 8);
          if (t < S - 1) qp[hf] = *reinterpret_cast<const uint4*>(ub + INP + hf * 8);
          qf[hf] = *reinterpret_cast<const uint4*>(YS + (size_t)row * 256 + c16 + hf * 8);
          qbk[hf] = *reinterpret_cast<const uint4*>(YS + ((size_t)NT + row) * 256 + c16 + hf * 8);
          qz[hf] = *reinterpret_cast<const uint4*>(U + row * INP + OZ + c16 + hf * 8);
        }
        float vals[16];
#pragma unroll
        for (int hf = 0; hf < 2; ++hf) {
          float u0[8], um[8], up[8], w[8], a[8];
          unpack8(q0[hf], u0); unpack8(qm[hf], um); unpack8(qp[hf], up);
          ld8f(cbias + c16 + hf * 8, a);
          ld8f(cw + c16 + hf * 8, w);
#pragma unroll
          for (int k = 0; k < 8; ++k) a[k] += w[k] * um[k];
          ld8f(cw + 768 + c16 + hf * 8, w);
#pragma unroll
          for (int k = 0; k < 8; ++k) a[k] += w[k] * u0[k];
          ld8f(cw + 1536 + c16 + hf * 8, w);
#pragma unroll
          for (int k = 0; k < 8; ++k) a[k] += w[k] * up[k];
          unpack8(qf[hf], u0); unpack8(qbk[hf], um); unpack8(qz[hf], up);
#pragma unroll
          for (int k = 0; k < 8; ++k) vals[hf * 8 + k] = (u0[k] + um[k] + dsum * silu(a[k])) * silu(up[k]);
        }
        norm_store(vals, YN + row * 1024 + 768 + c16);
      }
    }
  }
}

DI void ln_panel(const bfr* pre, float* out, bfr* hb, const float* stats, int brow, const float* g, const float* bta, bool write_f32) {
  const int tid = tidx(), wid = tid >> 6, lane = tid & 63;
#pragma unroll 1
  for (int r4 = wid * 4; r4 < 256; r4 += 32) {
    uint4 q[4][2];
#pragma unroll
    for (int qq = 0; qq < 4; ++qq)
#pragma unroll
      for (int i = 0; i < 2; ++i) q[qq][i] = write_f32 ? make_uint4(0, 0, 0, 0) : *reinterpret_cast<const uint4*>(pre + (long)(brow + r4 + qq) * D + i * 512 + lane * 8);
#pragma unroll
    for (int qq = 0; qq < 4; ++qq) {
      const int row = brow + r4 + qq;
      const float2 st = reinterpret_cast<const float2*>(stats)[r4 + qq];
      const float mu = st.x * (1.f / D);
      const float rstd = rsqrtf(fmaxf(st.y * (1.f / D) - mu * mu, 0.f) + 1e-5f);
#pragma unroll
      for (int i = 0; i < 2; ++i) {
        const int c0 = i * 512 + lane * 8;
        float v[8], gg[8], bb[8];
        if (write_f32) ld8f(out + (long)row * D + c0, v); else unpack8(q[qq][i], v);
        ld8f(g + c0, gg); ld8f(bta + c0, bb);
#pragma unroll
        for (int k = 0; k < 8; ++k) v[k] = (v[k] - mu) * rstd * gg[k] + bb[k];
        if (write_f32) { float* op = out + (long)row * D + c0; *reinterpret_cast<float4*>(op) = make_float4(v[0], v[1], v[2], v[3]); *reinterpret_cast<float4*>(op + 4) = make_float4(v[4], v[5], v[6], v[7]); }
        *reinterpret_cast<uint4*>(hb + (long)row * D + c0) = pack8(v);
      }
    }
  }
}

template <int LDA, int LDB>
DI void phase_gemm_ln(const PX& P, const bfr* A, const bfr* Bt, int K, const float* g, const float* bta, char* shm) {
  float* stats = (float*)(shm + 136192);
  EpiResid epi{(bfr*)(P.ws + WS_PRE), (const bfr*)(P.ws + WS_HB), stats};
#pragma unroll 1
  for (int pm = blockIdx.x; pm < 256; pm += gridDim.x) {
    { const int t = tidx(); if (t < 512) stats[t] = 0.f; }
    __syncthreads();
#pragma unroll 1
    for (int pn = 0; pn < 4; ++pn) gemm_unit<LDA, LDB>(A, Bt, K, pm * 256, pn * 256, shm, epi);
    ln_panel((const bfr*)(P.ws + WS_PRE), P.out, (bfr*)(P.ws + WS_HB), stats, pm * 256, g, bta, false);
    __syncthreads();
  }
}

template <int LDA, int LDB, int K, class Epi>
DI void phase_gemm(const bfr* A, const bfr* Bt, int nN, char* shm, const Epi& epi) {
  for (int u = blockIdx.x; u < 256 * nN; u += gridDim.x) {
    int pm, pn; unit_to_tile(u, 256, nN, pm, pn);
    gemm_unit<LDA, LDB>(A, Bt, K, pm * 256, pn * 256, shm, epi);
  }
}

DI void phase_ple(const PX& P, int l, char* shm) {
  char* ws = P.ws;
  const bfr* W = (const bfr*)(ws + WS_W) + (size_t)l * EW_LAYER;
  bfr* E = (bfr*)(ws + WS_YN);
  float* stats = (float*)(shm + 136192);
  EpiStoreBf16 e1{E, 1024};
  EpiPle e2{(bfr*)(ws + WS_PRE), (l == NL - 1) ? P.out : nullptr, (const bfr*)(ws + WS_HB), E, P.in[37] + l * 1024, stats};
#pragma unroll 1
  for (int pm = blockIdx.x; pm < 256; pm += gridDim.x) {
    { const int t = tidx(); if (t < 512) stats[t] = 0.f; }
    __syncthreads();
#pragma unroll 1
    for (int pn = 0; pn < 4; ++pn) gemm_unit<256, 256>((const bfr*)(ws + WS_PB), W + WO_PP, 256, pm * 256, pn * 256, shm, e1);
#pragma unroll 1
    for (int pn = 0; pn < 4; ++pn) gemm_unit<1024, 1024>((const bfr*)(ws + WS_HB), W + WO_PG, 1024, pm * 256, pn * 256, shm, e2);
    ln_panel((const bfr*)(ws + WS_PRE), P.out, (bfr*)(ws + WS_HB), stats, pm * 256, P.in[38] + l * D, P.in[39] + l * D, l == NL - 1);
    __syncthreads();
  }
}

DI void convert_p(const PX& P, int l) {
  const float4* src = reinterpret_cast<const float4*>(P.in[1] + (size_t)l * NT * PLE);
  uint2* dst = reinterpret_cast<uint2*>(P.ws + WS_PB);
  for (size_t e = (size_t)blockIdx.x * NTHREADS + tidx(); e < (size_t)NT * PLE / 4; e += (size_t)gridDim.x * NTHREADS) {
    const float4 v = src[e]; uint2 pk; pk.x = pack2(v.x, v.y); pk.y = pack2(v.z, v.w); dst[e] = pk;
  }
}

constexpr int NPH_LAYER = 9;
constexpr int NPHASES = 1 + NL * NPH_LAYER;

DI void run_phase(const Params& P0, int ph, char* shm, int skip = 0) {
  PX P;
  int z = 0; asm volatile("" : "+v"(z)); z = __builtin_amdgcn_readfirstlane(z);
  P.in = (in_tab_t)(&P0.in[0]) + z; P.out = P0.out + z; P.ws = P0.ws + z;
  char* ws = P.ws;
  if (ph == 0) { phase_prep(P, shm); return; }
  const int l = (ph - 1) / NPH_LAYER, k = (ph - 1) % NPH_LAYER;
  const bfr* W = (const bfr*)(ws + WS_W) + (size_t)l * EW_LAYER;
  const bfr* HB = (const bfr*)(ws + WS_HB);
  switch (k) {
    case 0: phase_gemm_in(P, l, shm, skip); break;
    case 1: phase_premix(P, l, shm); break;
    case 2: phase_mix(P, l, shm); break;
    case 3: phase_norm(P, l, shm); break;
    case 4: phase_gemm_ln<1024, 1024>(P, (const bfr*)(ws + WS_YN), W + WO_OUT, 1024, P.in[26] + l * D, P.in[27] + l * D, shm); convert_p(P, l); break;
    case 5: { EpiGate e{(bfr*)(ws + WS_U), (bfr*)(ws + WS_HALO)}; phase_gemm<1024, 1024, 1024>(HB, W + WO_G, 11, shm, e); } break;
    case 6: { EpiUp e{(bfr*)(ws + WS_U), (const bfr*)(ws + WS_HALO), P.in[30] + (size_t)l * 3 * DFF, P.in[31] + (size_t)l * DFF};
              phase_gemm<1024, 1024, 1024>(HB, W + WO_U, 11, shm, e); } break;
    case 7: phase_gemm_ln<DFF, DFF>(P, (const bfr*)(ws + WS_U), W + WO_D, DFF, P.in[33] + l * D, P.in[34] + l * D, shm); break;
    case 8: phase_ple(P, l, shm); break;
  }
}

DI void grid_barrier(unsigned* bar, unsigned target) {
  __syncthreads();
  if (tidx() == 0) {
    __builtin_amdgcn_fence(__ATOMIC_RELEASE, "agent");
    __hip_atomic_fetch_add(bar, 1u, __ATOMIC_RELAXED, __HIP_MEMORY_SCOPE_AGENT);
    while (__hip_atomic_load(bar, __ATOMIC_RELAXED, __HIP_MEMORY_SCOPE_AGENT) < target) __builtin_amdgcn_s_sleep(1);
    __builtin_amdgcn_fence(__ATOMIC_ACQUIRE, "agent");
  }
  __syncthreads();
}

template <int PH>
DI void do_phase(const Params& P, int lo, int hi, char* shm) {
  if (PH >= lo && PH < hi) {
#if PROBE_DUP
    if (PH > 0 && ((PROBE_DUP >> ((PH - 1) % NPH_LAYER)) & 1)) { run_phase(P, PH, shm, 1); __syncthreads(); }
    if (PH == 0 && (PROBE_DUP & 0x8000)) { run_phase(P, PH, shm, 1); __syncthreads(); }
#endif
    run_phase(P, PH, shm);
    if (PH + 1 < hi) grid_barrier((unsigned*)(P.ws + WS_BAR), (unsigned)(PH + 1 - lo) * gridDim.x);
  }
}

__global__ __launch_bounds__(NTHREADS, 2) void mega(Params P, int ph_lo, int ph_hi) {
  extern __shared__ __attribute__((aligned(16))) char shm[];
  tid_init();
  if (ph_hi - ph_lo > 1) cg::this_grid().sync();
#ifdef DIAGPH
  run_phase(P, DIAGPH, shm);
#else
  do_phase<0>(P, ph_lo, ph_hi, shm);
  do_phase<1>(P, ph_lo, ph_hi, shm);
  do_phase<2>(P, ph_lo, ph_hi, shm);
  do_phase<3>(P, ph_lo, ph_hi, shm);
  do_phase<4>(P, ph_lo, ph_hi, shm);
  do_phase<5>(P, ph_lo, ph_hi, shm);
  do_phase<6>(P, ph_lo, ph_hi, shm);
  do_phase<7>(P, ph_lo, ph_hi, shm);
  do_phase<8>(P, ph_lo, ph_hi, shm);
  do_phase<9>(P, ph_lo, ph_hi, shm);
  do_phase<10>(P, ph_lo, ph_hi, shm);
  do_phase<11>(P, ph_lo, ph_hi, shm);
  do_phase<12>(P, ph_lo, ph_hi, shm);
  do_phase<13>(P, ph_lo, ph_hi, shm);
  do_phase<14>(P, ph_lo, ph_hi, shm);
  do_phase<15>(P, ph_lo, ph_hi, shm);
  do_phase<16>(P, ph_lo, ph_hi, shm);
  do_phase<17>(P, ph_lo, ph_hi, shm);
  do_phase<18>(P, ph_lo, ph_hi, shm);
#endif
}

extern "C" void kernel_launch(void* const* d_in, const int* in_sizes, int n_in, void* d_out, int out_size, void* d_ws,
                              size_t ws_size, hipStream_t stream) {
  static int grid = 0;
  if (grid == 0) {
    int dev = 0, cus = 0, per_cu = 0;
    hipGetDevice(&dev);
    hipDeviceGetAttribute(&cus, hipDeviceAttributeMultiprocessorCount, dev);
    hipFuncSetAttribute((const void*)mega, hipFuncAttributeMaxDynamicSharedMemorySize, LDS_BYTES);
    hipOccupancyMaxActiveBlocksPerMultiprocessor(&per_cu, (const void*)mega, NTHREADS, LDS_BYTES);
    if (per_cu < 1) per_cu = 1;
    grid = cus * per_cu;
    if (ws_size < WS_END) fprintf(stderr, "workspace too small: %zu < %zu\n", ws_size, (size_t)WS_END);
  }
  Params p{};
  for (int i = 0; i < 40; ++i) p.in[i] = (const float*)d_in[i];
  p.out = (float*)d_out; p.ws = (char*)d_ws;
#if COOP
  hipMemsetAsync((char*)d_ws + WS_BAR, 0, 256, stream);
  int lo = 0, hi = NPHASES;
  void* args[] = {&p, &lo, &hi};
  hipError_t e = hipLaunchCooperativeKernel((const void*)mega, dim3(grid), dim3(NTHREADS), args, LDS_BYTES, stream);
  if (e != hipSuccess) fprintf(stderr, "cooperative launch failed: %s (grid %d)\n", hipGetErrorString(e), grid);
#else
  for (int ph = 0; ph < NPHASES; ++ph) hipLaunchKernelGGL(mega, dim3(grid), dim3(NTHREADS), LDS_BYTES, stream, p, ph, ph + 1);
#endif
}
```

```cpp
#include <hip/hip_runtime.h>
#include <hip/hip_bf16.h>
#include <hip/hip_cooperative_groups.h>
#include <cstdio>
namespace cg = cooperative_groups;

#ifndef PROBE_DUP
#define PROBE_DUP 0
#define PROBE_MIX 0
#define PROBE_GEMM 0
#endif
#ifndef COOP
#define COOP 1
#endif

typedef unsigned short bfr;
using bf16x8 = __attribute__((ext_vector_type(8))) short;
using s16x4  = __attribute__((ext_vector_type(4))) short;
using f32x4  = __attribute__((ext_vector_type(4))) float;
using f32x16 = __attribute__((ext_vector_type(16))) float;
#define DI __device__ __forceinline__

constexpr int NB = 32, S = 2048, D = 1024, NT = NB * S, NL = 2;
constexpr int INW = 2728, INP = 2816, DFF = 2816, PLE = 256;
constexpr int OQ = 0, OKV = 256, OKR = 384, OHY = 416, OSQ = 1184, OSK = 1440, OSV = 1568, OZ = 1696, OXBC = 1952, ODT = 2720;
constexpr float ALPHA = 1.4142135623730951f;
constexpr float LOG2E = 1.4426950408889634f;

constexpr size_t EW_IN = 2816ull * 1024, EW_UQ = 512ull * 256, EW_UKV = 512ull * 256, EW_OUT = 1024ull * 1024,
                 EW_G = 2816ull * 1024, EW_U = 2816ull * 1024, EW_D = 1024ull * 2816, EW_PP = 1024ull * 256, EW_PG = 1024ull * 1024;
constexpr size_t WO_IN = 0, WO_UQ = WO_IN + EW_IN, WO_UKV = WO_UQ + EW_UQ, WO_OUT = WO_UKV + EW_UKV, WO_G = WO_OUT + EW_OUT,
                 WO_U = WO_G + EW_G, WO_D = WO_U + EW_U, WO_PP = WO_D + EW_D, WO_PG = WO_PP + EW_PP, EW_LAYER = WO_PG + EW_PG;
constexpr size_t WS_W = 0;
constexpr size_t WS_KBUF = WS_W + NL * EW_LAYER * 2;
constexpr size_t WS_KF = WS_KBUF + 2ull * 2 * 256 * 4096 * 4;
constexpr size_t WS_ROPE = WS_KF + 2ull * 2 * 256 * 4096 * 8;
constexpr size_t WS_TW = WS_ROPE + 2048ull * 16 * 8;
constexpr size_t WS_HALO = WS_TW + 2048ull * 8;
constexpr size_t WS_HB = WS_HALO + 512ull * 2 * 2816 * 2;
constexpr size_t WS_U = WS_HB + (size_t)NT * 1024 * 2;
constexpr size_t WS_Y = WS_U + (size_t)NT * 2816 * 2;
constexpr size_t WS_Q = WS_Y + (size_t)NT * 512 * 2;
constexpr size_t WS_K = WS_Q + (size_t)NT * 384 * 2;
constexpr size_t WS_VT = WS_K + (size_t)NT * 384 * 2;
constexpr size_t WS_YN = WS_Q;
constexpr size_t WS_HYT = WS_VT + (size_t)NT * 256 * 2;
constexpr size_t WS_PB = WS_HYT;
constexpr size_t WS_PRE = WS_HYT + (size_t)NT * 256 * 2;
constexpr size_t WS_YSSD = WS_HYT + (size_t)NT * 768 * 2;
constexpr size_t WS_YH = WS_YSSD + 2ull * NT * 256 * 2;
constexpr size_t WS_BAR = WS_YH + (size_t)NT * 256 * 2;
constexpr size_t WS_END = WS_BAR + 256;

constexpr int LDS_BYTES = 147456;
constexpr int NTHREADS = 512;

struct Params {
  const float* in[40];
  float* out;
  char* ws;
};

typedef const float* const __attribute__((address_space(4)))* in_tab_t;
struct PX {
  in_tab_t in;
  float* out;
  char* ws;
};
__shared__ int s_wave_tab[64];
DI int hw_slot() { return (int)(__builtin_amdgcn_s_getreg((5 << 11) | (0 << 6) | 4) & 63u); }
DI void tid_init() {
  const int t = threadIdx.x;
  if ((t & 63) == 0) s_wave_tab[hw_slot()] = t >> 6;
  __syncthreads();
}
DI int tidx() {
  int w = s_wave_tab[hw_slot()];
  asm volatile("" : "+v"(w));
  w = __builtin_amdgcn_readfirstlane(w);
  int t = (w << 6) | (int)__builtin_amdgcn_mbcnt_hi(~0u, __builtin_amdgcn_mbcnt_lo(~0u, 0u));
  asm volatile("" : "+v"(t));
  return t;
}
DI const char* uni_ptr(const char* p) {
  const unsigned long long v = (unsigned long long)p;
  const unsigned lo = __builtin_amdgcn_readfirstlane((unsigned)v), hi = __builtin_amdgcn_readfirstlane((unsigned)(v >> 32));
  return (const char*)(((unsigned long long)hi << 32) | lo);
}
template <int M> DI float swz_xor(float v) { return __int_as_float(__builtin_amdgcn_ds_swizzle(__float_as_int(v), (M << 10) | 0x1f)); }
typedef __bf16 bf16x2_t __attribute__((ext_vector_type(2)));
DI bfr f2bf(float x) { return __builtin_bit_cast(bfr, (__bf16)x); }
DI float bf2f(bfr v) { return __uint_as_float(((unsigned)v) << 16); }
DI unsigned pack2(float a, float b) { bf16x2_t v = {(__bf16)a, (__bf16)b}; return __builtin_bit_cast(unsigned, v); }
DI float silu(float x) { return x * __builtin_amdgcn_rcpf(1.f + __expf(-x)); }
DI float sigmoidf(float x) { return __builtin_amdgcn_rcpf(1.f + __expf(-x)); }

constexpr int BM = 256, BK = 64, HALF = 128, HT = HALF * BK;
DI int lds_byte(int r, int c) {
  int st = (r >> 4) * 2 + (c >> 5), rr = r & 15, cc = c & 31, ob = rr * 64 + cc * 2;
  return st * 1024 + (ob ^ (((ob >> 9) & 1) << 5));
}
DI void stage_rc(int b, int& R, int& C) {
  int st = b / 1024, sb = b % 1024, swz = sb ^ (((sb >> 9) & 1) << 5);
  R = (st >> 1) * 16 + swz / 64; C = (st & 1) * 32 + (swz % 64) / 2;
}

typedef f32x4 acc_t[2][2][4][2];
constexpr int TST = 260;

template <int LDA, int LDB, class Epi, int SKIP = 0>
DI void gemm_unit(const bfr* __restrict__ A, const bfr* __restrict__ Bt, int K, int brow, int bcol, char* shmc, const Epi& epi) {
  bfr* shm = (bfr*)shmc;
#define SA(b, h) (shm + ((b) * 2 + (h)) * HT)
#define SB(b, h) (shm + (4 + (b) * 2 + (h)) * HT)
#define GL_LDS(gp, lp) __builtin_amdgcn_global_load_lds((const unsigned*)(gp), (__attribute__((address_space(3))) unsigned*)(lp), 16, 0, 0)
#define STAGE(P, BASE, LD, br, kt) do { const char* _sb = (const char*)(BASE) + ((long)(br) * (LD) + (kt) * BK) * 2; \
    const char* _sb2 = uni_ptr(_sb + 64 * (LD) * 2); \
    GL_LDS(_sb + voff_##LD, (char*)(P) + woff); \
    GL_LDS(_sb2 + voff_##LD, (char*)(P) + woff + 8192); } while (0)
#define LDA_(dst, b, h) for (int m = 0; m < 4; ++m) for (int k = 0; k < 2; ++k) \
    dst[m][k] = *reinterpret_cast<const bf16x8*>((char*)SA(b, h) + lds_byte(wr * 64 + m * 16 + fr, k * 32 + fq * 8))
#define LDB_(dst, b, h) for (int n = 0; n < 2; ++n) for (int k = 0; k < 2; ++k) \
    dst[n][k] = *reinterpret_cast<const bf16x8*>((char*)SB(b, h) + lds_byte(wc * 32 + n * 16 + fr, k * 32 + fq * 8))
#define MMA(ai, bj, At, Bt_) do { __builtin_amdgcn_s_setprio(1); \
    for (int m = 0; m < 4; ++m) for (int n = 0; n < 2; ++n) for (int k = 0; k < 2; ++k) \
      acc[ai][bj][m][n] = __builtin_amdgcn_mfma_f32_16x16x32_bf16(At[m][k], Bt_[n][k], acc[ai][bj][m][n], 0, 0, 0); \
    __builtin_amdgcn_s_setprio(0); } while (0)
#define WAIT_V(n) asm volatile("s_waitcnt vmcnt(" #n ")" ::: "memory")
#define WAIT_L(n) asm volatile("s_waitcnt lgkmcnt(" #n ")" ::: "memory")
#define BAR __builtin_amdgcn_s_barrier()
#define SCHED __builtin_amdgcn_sched_barrier(0)

  const int tid_u = tidx();
  const int wid = tid_u >> 6, lane = tid_u & 63, wr = wid >> 2, wc = wid & 3, fr = lane & 15, fq = lane >> 4;
  unsigned voff_LDA, voff_LDB;
  { int r_, c_; stage_rc(tid_u * 16, r_, c_); voff_LDA = (unsigned)(r_ * LDA + c_) * 2u; voff_LDB = (unsigned)(r_ * LDB + c_) * 2u; }
  const int woff = __builtin_amdgcn_readfirstlane(wid * 1024);
  acc_t acc = {};
  bf16x8 At[4][2], B0[2][2], B1[2][2];
  int nt = K / BK; asm volatile("" : "+s"(nt));
  STAGE(SB(0, 0), Bt, LDB, bcol, 0); STAGE(SA(0, 0), A, LDA, brow, 0);
  STAGE(SB(0, 1), Bt, LDB, bcol + HALF, 0); STAGE(SA(0, 1), A, LDA, brow + HALF, 0);
  if (wr == 1) BAR;
  WAIT_V(4); BAR;
  STAGE(SB(1, 0), Bt, LDB, bcol, 1); STAGE(SA(1, 0), A, LDA, brow, 1); STAGE(SB(1, 1), Bt, LDB, bcol + HALF, 1);
  WAIT_V(6); BAR;
#pragma unroll 1
  for (int t = 0; t < nt - 2; t += 2) {
    LDB_(B0, 0, 0); SCHED; LDA_(At, 0, 0); STAGE(SA(1, 1), A, LDA, brow + HALF, t + 1);
    WAIT_L(8); BAR; WAIT_L(0); MMA(0, 0, At, B0); BAR; SCHED;
    LDB_(B1, 0, 1); STAGE(SB(0, 0), Bt, LDB, bcol, t + 2);
    BAR; WAIT_L(0); MMA(0, 1, At, B1); BAR;
    LDA_(At, 0, 1); STAGE(SA(0, 0), A, LDA, brow, t + 2);
    BAR; WAIT_L(0); MMA(1, 0, At, B0); BAR; SCHED;
    STAGE(SB(0, 1), Bt, LDB, bcol + HALF, t + 2);
    WAIT_V(6); BAR; MMA(1, 1, At, B1); BAR;
    LDB_(B0, 1, 0); SCHED; LDA_(At, 1, 0); STAGE(SA(0, 1), A, LDA, brow + HALF, t + 2);
    WAIT_L(8); BAR; WAIT_L(0); MMA(0, 0, At, B0); BAR; SCHED;
    LDB_(B1, 1, 1); STAGE(SB(1, 0), Bt, LDB, bcol, t + 3);
    BAR; WAIT_L(0); MMA(0, 1, At, B1); BAR;
    LDA_(At, 1, 1); STAGE(SA(1, 0), A, LDA, brow, t + 3);
    BAR; WAIT_L(0); MMA(1, 0, At, B0); BAR; SCHED;
    STAGE(SB(1, 1), Bt, LDB, bcol + HALF, t + 3);
    WAIT_V(6); BAR; MMA(1, 1, At, B1); BAR;
  }
  { LDB_(B0, 0, 0); LDA_(At, 0, 0); STAGE(SA(1, 1), A, LDA, brow + HALF, nt - 1);
    BAR; WAIT_L(0); MMA(0, 0, At, B0); BAR;
    LDB_(B1, 0, 1); BAR; WAIT_L(0); MMA(0, 1, At, B1); BAR;
    LDA_(At, 0, 1); WAIT_V(4); BAR; WAIT_L(0); MMA(1, 0, At, B0); MMA(1, 1, At, B1); BAR; }
  { LDB_(B0, 1, 0); LDA_(At, 1, 0); WAIT_V(2); BAR; WAIT_L(0); MMA(0, 0, At, B0); BAR;
    LDB_(B1, 1, 1); WAIT_V(0); BAR; WAIT_L(0); MMA(0, 1, At, B1); BAR;
    LDA_(At, 1, 1); BAR; WAIT_L(0); MMA(1, 0, At, B0); MMA(1, 1, At, B1); BAR; }
  if (wr == 0) BAR;
  if (SKIP == 2) {
    float s = 0.f;
#pragma unroll
    for (int ai = 0; ai < 2; ++ai)
#pragma unroll
      for (int bj = 0; bj < 2; ++bj)
#pragma unroll
        for (int m = 0; m < 4; ++m)
#pragma unroll
          for (int n = 0; n < 2; ++n) s += acc[ai][bj][m][n][0] + acc[ai][bj][m][n][1] + acc[ai][bj][m][n][2] + acc[ai][bj][m][n][3];
    if (s == 123.456f) ((float*)shmc)[0] = s;
    __syncthreads();
    return;
  }
  float* tile = (float*)shmc;
  {
    int t2 = tid_u; asm volatile("" : "+v"(t2));
    const int lane2 = t2 & 63, wid2 = t2 >> 6;
    tile += ((wid2 >> 2) * 64 + (lane2 >> 4) * 4) * TST + (wid2 & 3) * 32 + (lane2 & 15);
  }
#pragma unroll
  for (int ai = 0; ai < 2; ++ai) {
    if (ai) __syncthreads();
#pragma unroll
    for (int bj = 0; bj < 2; ++bj)
#pragma unroll
      for (int m = 0; m < 4; ++m)
#pragma unroll
        for (int n = 0; n < 2; ++n)
#pragma unroll
          for (int j = 0; j < 4; ++j)
            tile[(m * 16 + j) * TST + bj * 128 + n * 16] = acc[ai][bj][m][n][j];
    __syncthreads();
    if (SKIP == 0) epi((float*)shmc, brow + ai * 128, bcol);
  }
  __syncthreads();
}

DI void unit_to_tile(int u, int nM, int nN, int& pm, int& pn) {
  const int nig = 8 * nN, gid = u / nig, fm = gid * 8, gsz = min(nM - fm, 8);
  pm = fm + ((u % nig) % gsz); pn = (u % nig) / gsz;
}

#define FOR_CHUNKS(ci) const int tid_e##ci = tidx(); _Pragma("unroll 1") for (int ci = 0; ci < 8; ++ci)
#define CHUNK_SETUP(ci) int tx_ = tid_e##ci; asm volatile("" : "+v"(tx_)); const int idx_ = ci * 512 + tx_; const int lr = idx_ >> 5, lc = (idx_ & 31) * 8; \
    const int row = r0 + lr, col = bcol + lc; float v[8]; \
    { const float4 a_ = *reinterpret_cast<const float4*>(tile + lr * TST + lc), b_ = *reinterpret_cast<const float4*>(tile + lr * TST + lc + 4); \
      v[0] = a_.x; v[1] = a_.y; v[2] = a_.z; v[3] = a_.w; v[4] = b_.x; v[5] = b_.y; v[6] = b_.z; v[7] = b_.w; }
DI uint4 pack8(const float* v) { uint4 o; o.x = pack2(v[0], v[1]); o.y = pack2(v[2], v[3]); o.z = pack2(v[4], v[5]); o.w = pack2(v[6], v[7]); return o; }
DI void unpack8(const uint4& u, float* f) {
  f[0] = __uint_as_float(u.x << 16); f[1] = __uint_as_float(u.x & 0xffff0000u); f[2] = __uint_as_float(u.y << 16); f[3] = __uint_as_float(u.y & 0xffff0000u);
  f[4] = __uint_as_float(u.z << 16); f[5] = __uint_as_float(u.z & 0xffff0000u); f[6] = __uint_as_float(u.w << 16); f[7] = __uint_as_float(u.w & 0xffff0000u);
}
DI void ld8f(const float* p, float* f) { const float4 a = *reinterpret_cast<const float4*>(p), b = *reinterpret_cast<const float4*>(p + 4);
  f[0] = a.x; f[1] = a.y; f[2] = a.z; f[3] = a.w; f[4] = b.x; f[5] = b.y; f[6] = b.z; f[7] = b.w; }

struct EpiStoreBf16 {
  bfr* C; int ldc;
  DI void operator()(float* tile, int r0, int bcol) const {
    FOR_CHUNKS(ci) { CHUNK_SETUP(ci); *reinterpret_cast<uint4*>(C + (long)row * ldc + col) = pack8(v); }
  }
};
struct EpiGate {
  bfr* G; bfr* halo;
  DI void operator()(float* tile, int r0, int bcol) const {
    FOR_CHUNKS(ci) { CHUNK_SETUP(ci); const uint4 pk = pack8(v);
      *reinterpret_cast<uint4*>(G + (long)row * DFF + col) = pk;
      if (lr == 0) *reinterpret_cast<uint4*>(halo + ((long)(row >> 7) * 2 + 0) * DFF + col) = pk;
      if (lr == 127) *reinterpret_cast<uint4*>(halo + ((long)(row >> 7) * 2 + 1) * DFF + col) = pk;
    }
  }
};
#define CH_LR(ci, tx) (((ci) * 512 + (tx)) >> 5)
#define CH_LC(ci, tx) ((((ci) * 512 + (tx)) & 31) * 8)
struct EpiUp {
  bfr* G; const bfr* halo; const float* cw; const float* cb;
  DI void operator()(float* tile, int r0, int bcol) const {
    const int tx = tidx();
    const int lc = (tx & 31) * 8, col = bcol + lc;
    float wm[8], wc[8], wp[8], wb[8];
    ld8f(cw + col, wm); ld8f(cw + DFF + col, wc); ld8f(cw + 2 * DFF + col, wp); ld8f(cb + col, wb);
#pragma unroll
    for (int c0 = 0; c0 < 8; c0 += 4) {
      uint4 q0[4], qm[4], qp[4];
#pragma unroll
      for (int k4 = 0; k4 < 4; ++k4) {
        const int lr = CH_LR(c0 + k4, tx), row = r0 + lr;
        const long idx = (long)row * DFF + col; const int t = row & (S - 1), hb = row >> 7;
        q0[k4] = *reinterpret_cast<const uint4*>(G + idx);
        qm[k4] = make_uint4(0, 0, 0, 0); qp[k4] = make_uint4(0, 0, 0, 0);
        if (t != 0) qm[k4] = lr == 0 ? *reinterpret_cast<const uint4*>(halo + ((long)(hb - 1) * 2 + 1) * DFF + col) : *reinterpret_cast<const uint4*>(G + idx - DFF);
        if (t != S - 1) qp[k4] = lr == 127 ? *reinterpret_cast<const uint4*>(halo + ((long)(hb + 1) * 2 + 0) * DFF + col) : *reinterpret_cast<const uint4*>(G + idx + DFF);
      }
#pragma unroll
      for (int k4 = 0; k4 < 4; ++k4) {
        const int lr = CH_LR(c0 + k4, tx);
        float v[8], g0[8], gm[8], gp[8];
        ld8f(tile + lr * TST + lc, v);
        unpack8(q0[k4], g0); unpack8(qm[k4], gm); unpack8(qp[k4], gp);
#pragma unroll
        for (int k = 0; k < 8; ++k) v[k] = silu(wb[k] + wm[k] * gm[k] + wc[k] * g0[k] + wp[k] * gp[k]) * v[k];
        *reinterpret_cast<uint4*>(tile + lr * TST + lc) = pack8(v);
      }
    }
    __syncthreads();
#pragma unroll
    for (int ci = 0; ci < 8; ++ci) {
      const int lr = CH_LR(ci, tx);
      *reinterpret_cast<uint4*>(G + (long)(r0 + lr) * DFF + col) = *reinterpret_cast<const uint4*>(tile + lr * TST + lc);
    }
  }
};
DI void row_stats_add(float* stats, int row, const float* v, int tx) {
  float s1 = 0.f, s2 = 0.f;
#pragma unroll
  for (int k = 0; k < 8; ++k) { s1 += v[k]; s2 += v[k] * v[k]; }
  s1 += swz_xor<16>(s1); s2 += swz_xor<16>(s2); s1 += swz_xor<8>(s1); s2 += swz_xor<8>(s2); s1 += swz_xor<4>(s1); s2 += swz_xor<4>(s2);
  s1 += swz_xor<2>(s1); s2 += swz_xor<2>(s2); s1 += swz_xor<1>(s1); s2 += swz_xor<1>(s2);
  if ((tx & 31) == 0) { float2* sp = reinterpret_cast<float2*>(stats) + (row & 255); float2 s = *sp; s.x += s1; s.y += s2; *sp = s; }
}
struct EpiResid {
  bfr* out; const bfr* hb; float* stats;
  DI void operator()(float* tile, int r0, int bcol) const {
    const int tx = tidx();
#pragma unroll
    for (int c0 = 0; c0 < 8; c0 += 4) {
      uint4 hq[4];
#pragma unroll
      for (int k4 = 0; k4 < 4; ++k4) hq[k4] = *reinterpret_cast<const uint4*>(hb + (long)(r0 + CH_LR(c0 + k4, tx)) * D + bcol + CH_LC(c0 + k4, tx));
#pragma unroll
      for (int k4 = 0; k4 < 4; ++k4) {
        const int lr = CH_LR(c0 + k4, tx), lc = CH_LC(c0 + k4, tx), row = r0 + lr;
        bfr* op = out + (long)row * D + bcol + lc;
        float v[8], o[8];
        ld8f(tile + lr * TST + lc, v); unpack8(hq[k4], o);
#pragma unroll
        for (int k = 0; k < 8; ++k) o[k] = ALPHA * o[k] + v[k];
        *reinterpret_cast<uint4*>(op) = pack8(o);
        row_stats_add(stats, row, o, tx);
      }
    }
  }
};
struct EpiPle {
  bfr* out; float* out32; const bfr* hb; const bfr* E; const float* bg; float* stats;
  DI void operator()(float* tile, int r0, int bcol) const {
    const int tx = tidx();
#pragma unroll
    for (int c0 = 0; c0 < 8; c0 += 4) {
      uint4 hq[4], eq[4];
#pragma unroll
      for (int k4 = 0; k4 < 4; ++k4) {
        const long idx = (long)(r0 + CH_LR(c0 + k4, tx)) * D + bcol + CH_LC(c0 + k4, tx);
        hq[k4] = *reinterpret_cast<const uint4*>(hb + idx);
        eq[k4] = *reinterpret_cast<const uint4*>(E + idx);
      }
#pragma unroll
      for (int k4 = 0; k4 < 4; ++k4) {
        const int lr = CH_LR(c0 + k4, tx), lc = CH_LC(c0 + k4, tx), row = r0 + lr, col = bcol + lc;
        bfr* op = out + (long)row * D + col;
        float v[8], o[8], e[8], bgv[8];
        ld8f(tile + lr * TST + lc, v); ld8f(bg + col, bgv); unpack8(eq[k4], e); unpack8(hq[k4], o);
#pragma unroll
        for (int k = 0; k < 8; ++k) o[k] = ALPHA * o[k] + e[k] * sigmoidf(v[k] + bgv[k]);
        if (out32) { float* o32 = out32 + (long)row * D + col; *reinterpret_cast<float4*>(o32) = make_float4(o[0], o[1], o[2], o[3]); *reinterpret_cast<float4*>(o32 + 4) = make_float4(o[4], o[5], o[6], o[7]); }
        else *reinterpret_cast<uint4*>(op) = pack8(o);
        row_stats_add(stats, row, o, tx);
      }
    }
  }
};
struct EpiQ {
  bfr* Q; const float* rs; const float2* rope;
  DI void operator()(float* tile, int r0, int bcol) const {
    FOR_CHUNKS(ci) { CHUNK_SETUP(ci);
      if (col < 384) {
        const int head = col / 96, d0 = col % 96; const float rstd = rs[row & 255]; const int b = row >> 11, t = row & (S - 1);
        if (d0 >= 64) {
          const bool lo = d0 < 80; const int jj = (d0 - (lo ? 64 : 80));
          float pw[8]; ld8f(tile + lr * TST + lc + (lo ? 16 : -16), pw);
#pragma unroll
          for (int k = 0; k < 8; ++k) { const float2 cs = rope[t * 16 + jj + k];
            v[k] = lo ? (v[k] * cs.x - pw[k] * cs.y) : (v[k] * cs.x + pw[k] * cs.y); }
        }
#pragma unroll
        for (int k = 0; k < 8; ++k) v[k] *= rstd;
        *reinterpret_cast<uint4*>(Q + (((long)(b * 4 + head)) * S + t) * 96 + d0) = pack8(v);
      }
    }
  }
};
struct EpiKV {
  bfr* Kf; bfr* VT; const float* rs;
  DI void operator()(float* tile, int r0, int bcol) const {
    FOR_CHUNKS(ci) { CHUNK_SETUP(ci);
      if ((col & 127) < 64) {
        const int head = col >> 7, d0 = col & 127; const float rstd = rs[row & 255]; const int b = row >> 11, t = row & (S - 1);
#pragma unroll
        for (int k = 0; k < 8; ++k) v[k] *= rstd;
        *reinterpret_cast<uint4*>(Kf + (((long)(b * 4 + head)) * S + t) * 96 + d0) = pack8(v);
      }
    }
    const int b = r0 >> 11, t0 = r0 & (S - 1);
#pragma unroll 1
    for (int it = tidx(); it < 2048; it += NTHREADS) {
      const int vc = it & 127, rc = it >> 7, lcol = (vc >> 6) * 128 + 64 + (vc & 63), lr0 = rc * 8;
      const int head = (bcol + lcol) >> 7, dd = vc & 63;
      float v[8];
#pragma unroll
      for (int k = 0; k < 8; ++k) v[k] = tile[(lr0 + k) * TST + lcol] * rs[(r0 + lr0 + k) & 255];
      *reinterpret_cast<uint4*>(VT + (((long)(b * 4 + head)) * 64 + dd) * S + t0 + lr0) = pack8(v);
    }
  }
};

#define MFMA32(a, b, c) __builtin_amdgcn_mfma_f32_32x32x16_bf16((a), (b), (c), 0, 0, 0)
template <int DQK, bool SWA>
DI void attn_item(const bfr* __restrict__ qb, long q_ld, const bfr* __restrict__ kb, long k_ld, const bfr* __restrict__ vb, long v_ld,
                  int q0, int key_lo, int key_hi, float scale_l2e, float slope_l2e, float sink_l2e,
                  bfr* __restrict__ outp, long out_ld, char* shm) {
  constexpr int KST = DQK + 8;
  constexpr int VST = 72;
  constexpr int NKK = DQK / 16;
  bfr* Ks = (bfr*)shm;
  bfr* Vt = Ks + 64 * KST;
  const int tid = tidx(), wid = tid >> 6, lane = tid & 63, r = lane & 31, h = lane >> 5;
  const int qrow = q0 + wid * 32 + r;
  bf16x8 qf[NKK];
#pragma unroll
  for (int kk = 0; kk < NKK; ++kk) qf[kk] = *reinterpret_cast<const bf16x8*>(qb + (long)qrow * q_ld + kk * 16 + h * 8);
  f32x16 o[2];
#pragma unroll
  for (int i = 0; i < 16; ++i) { o[0][i] = 0.f; o[1][i] = 0.f; }
  float mrun = SWA ? sink_l2e : -1e30f, lrun = SWA ? 1.f : 0.f;
  constexpr int KCH = DQK / 8;
  constexpr bool K2 = (64 * KCH > NTHREADS);
  uint4 pk0, pk1 = make_uint4(0, 0, 0, 0), pvv;
  const int vrow = tid >> 3, vch = tid & 7;
  const int kr0 = tid / KCH, kc0 = (tid % KCH) * 8, kr1 = (tid + NTHREADS) / KCH, kc1 = ((tid + NTHREADS) % KCH) * 8;
  const bool has1 = K2 && (tid + NTHREADS < 64 * KCH);
#define ATT_LOAD(kt_) do { \
    pk0 = *reinterpret_cast<const uint4*>(kb + (long)((kt_) + kr0) * k_ld + kc0); \
    if (has1) pk1 = *reinterpret_cast<const uint4*>(kb + (long)((kt_) + kr1) * k_ld + kc1); \
    pvv = SWA ? *reinterpret_cast<const uint4*>(vb + (long)((kt_) + vrow) * v_ld + vch * 8) \
              : *reinterpret_cast<const uint4*>(vb + (long)vrow * v_ld + (kt_) + vch * 8); } while (0)
  ATT_LOAD(key_lo);
  for (int kt = key_lo; kt < key_hi; kt += 64) {
    __syncthreads();
    *reinterpret_cast<uint4*>(Ks + kr0 * KST + kc0) = pk0;
    if (has1) *reinterpret_cast<uint4*>(Ks + kr1 * KST + kc1) = pk1;
    if (SWA) {
      bfr* vp = Vt + (vch * 8) * VST + vrow;
      vp[0 * VST] = (bfr)(pvv.x & 0xffffu); vp[1 * VST] = (bfr)(pvv.x >> 16);
      vp[2 * VST] = (bfr)(pvv.y & 0xffffu); vp[3 * VST] = (bfr)(pvv.y >> 16);
      vp[4 * VST] = (bfr)(pvv.z & 0xffffu); vp[5 * VST] = (bfr)(pvv.z >> 16);
      vp[6 * VST] = (bfr)(pvv.w & 0xffffu); vp[7 * VST] = (bfr)(pvv.w >> 16);
    } else {
      *reinterpret_cast<uint4*>(Vt + vrow * VST + vch * 8) = pvv;
    }
    if (kt + 64 < key_hi) ATT_LOAD(kt + 64);
    __syncthreads();
    f32x16 s[2];
#pragma unroll
    for (int kh = 0; kh < 2; ++kh) {
#pragma unroll
      for (int i = 0; i < 16; ++i) s[kh][i] = 0.f;
#pragma unroll
      for (int kk = 0; kk < NKK; ++kk) {
        const bf16x8 a = *reinterpret_cast<const bf16x8*>(Ks + (kh * 32 + r) * KST + kk * 16 + h * 8);
        s[kh] = MFMA32(a, qf[kk], s[kh]);
      }
    }
    float mx = -1e30f;
    if (SWA) {
#pragma unroll
      for (int kh = 0; kh < 2; ++kh)
#pragma unroll
        for (int i = 0; i < 16; ++i) {
          const int kpos = kt + kh * 32 + (i & 3) + 8 * (i >> 2) + 4 * h;
          const int dist = abs(qrow - kpos);
          const float v = (dist <= 128) ? s[kh][i] * scale_l2e - slope_l2e * (float)dist : -1e30f;
          s[kh][i] = v; mx = fmaxf(mx, v);
        }
    } else {
#pragma unroll
      for (int kh = 0; kh < 2; ++kh)
#pragma unroll
        for (int i = 0; i < 16; ++i) mx = fmaxf(mx, s[kh][i]);
      mx *= scale_l2e;
    }
    mx = fmaxf(mx, __shfl_xor(mx, 32));
    const float mnew = fmaxf(mrun, mx);
    float ps = 0.f;
    if (SWA) {
#pragma unroll
      for (int kh = 0; kh < 2; ++kh)
#pragma unroll
        for (int i = 0; i < 16; ++i) { const float p = __builtin_amdgcn_exp2f(s[kh][i] - mnew); s[kh][i] = p; ps += p; }
    } else {
#pragma unroll
      for (int kh = 0; kh < 2; ++kh)
#pragma unroll
        for (int i = 0; i < 16; ++i) { const float p = __builtin_amdgcn_exp2f(fmaf(s[kh][i], scale_l2e, -mnew)); s[kh][i] = p; ps += p; }
    }
    ps += __shfl_xor(ps, 32);
    if (__any(mnew > mrun)) {
      const float corr = __builtin_amdgcn_exp2f(mrun - mnew);
      lrun *= corr;
#pragma unroll
      for (int i = 0; i < 16; ++i) { o[0][i] *= corr; o[1][i] *= corr; }
    }
    lrun += ps; mrun = mnew;
#pragma unroll
    for (int kh = 0; kh < 2; ++kh)
#pragma unroll
      for (int s2 = 0; s2 < 2; ++s2) {
        uint4 pbu;
        pbu.x = pack2(s[kh][8 * s2 + 0], s[kh][8 * s2 + 1]); pbu.y = pack2(s[kh][8 * s2 + 2], s[kh][8 * s2 + 3]);
        pbu.z = pack2(s[kh][8 * s2 + 4], s[kh][8 * s2 + 5]); pbu.w = pack2(s[kh][8 * s2 + 6], s[kh][8 * s2 + 7]);
        const bf16x8 pb = __builtin_bit_cast(bf16x8, pbu);
#pragma unroll
        for (int dt = 0; dt < 2; ++dt) {
          const bfr* vp = Vt + (dt * 32 + r) * VST + kh * 32 + 16 * s2 + 4 * h;
          const s16x4 lo = *reinterpret_cast<const s16x4*>(vp);
          const s16x4 hi = *reinterpret_cast<const s16x4*>(vp + 8);
          const bf16x8 a = __builtin_shufflevector(lo, hi, 0, 1, 2, 3, 4, 5, 6, 7);
          o[dt] = MFMA32(a, pb, o[dt]);
        }
      }
  }
  const float inv = 1.f / lrun;
#pragma unroll
  for (int dt = 0; dt < 2; ++dt)
#pragma unroll
    for (int g = 0; g < 4; ++g) {
      uint2 pk; pk.x = pack2(o[dt][4 * g] * inv, o[dt][4 * g + 1] * inv); pk.y = pack2(o[dt][4 * g + 2] * inv, o[dt][4 * g + 3] * inv);
      *reinterpret_cast<uint2*>(outp + (long)qrow * out_ld + dt * 32 + 8 * g + 4 * h) = pk;
    }
}

DI float2 cmul(float2 a, float2 b) { return make_float2(a.x * b.x - a.y * b.y, a.x * b.y + a.y * b.x); }
DI float2 cmulc(float2 a, float2 b) { return make_float2(a.x * b.x + a.y * b.y, a.y * b.x - a.x * b.y); }
constexpr int FST_A = 272, FST_B = 17, FFT_LDS = 16 * FST_A;
DI int fpos(int n) { return (n >> 8) * FST_A + ((n >> 4) & 15) * FST_B + (n & 15); }
DI float2 twid(const float2* TW, int m) {
  const float2 w = TW[m & 2047];
  return (m & 2048) ? make_float2(-w.x, -w.y) : w;
}
DI void dft16_fwd(float2* v) {
  const float C8 = 0.92387953251128674f, S8 = 0.38268343236508977f, R2 = 0.70710678118654752f;
  const float2 w16[8] = {{1.f, 0.f}, {C8, -S8}, {R2, -R2}, {S8, -C8}, {0.f, -1.f}, {-S8, -C8}, {-R2, -R2}, {-C8, -S8}};
#pragma unroll
  for (int s = 0; s < 4; ++s) {
    const int half = 8 >> s;
#pragma unroll
    for (int j = 0; j < 8; ++j) {
      const int pos = j & (half - 1), i0 = ((j - pos) << 1) + pos, i1 = i0 + half;
      const float2 a = v[i0], b = v[i1];
      v[i0] = make_float2(a.x + b.x, a.y + b.y);
      v[i1] = cmul(make_float2(a.x - b.x, a.y - b.y), w16[pos << s]);
    }
  }
}
DI void dft16_inv(float2* v) {
  const float C8 = 0.92387953251128674f, S8 = 0.38268343236508977f, R2 = 0.70710678118654752f;
  const float2 w16[8] = {{1.f, 0.f}, {C8, -S8}, {R2, -R2}, {S8, -C8}, {0.f, -1.f}, {-S8, -C8}, {-R2, -R2}, {-C8, -S8}};
#pragma unroll
  for (int s = 3; s >= 0; --s) {
    const int half = 8 >> s;
#pragma unroll
    for (int j = 0; j < 8; ++j) {
      const int pos = j & (half - 1), i0 = ((j - pos) << 1) + pos, i1 = i0 + half;
      const float2 a = v[i0], b = cmulc(v[i1], w16[pos << s]);
      v[i0] = make_float2(a.x + b.x, a.y + b.y);
      v[i1] = make_float2(a.x - b.x, a.y - b.y);
    }
  }
}
DI int brev4(int i) { return ((i & 1) << 3) | ((i & 2) << 1) | ((i & 4) >> 1) | ((i & 8) >> 3); }
DI void fft_fwd(float2* X, const float2* TW, const int t) {
  float2 v[16];
  const int hi = t >> 4, lo = t & 15;
  {
    float2* p = X + hi * FST_B + lo;
#pragma unroll
    for (int i = 0; i < 16; ++i) v[i] = p[i * FST_A];
    dft16_fwd(v);
#pragma unroll
    for (int i = 0; i < 16; ++i) p[i * FST_A] = cmul(v[i], twid(TW, t * brev4(i)));
  }
  __syncthreads();
  {
    float2* p = X + hi * FST_A + lo;
#pragma unroll
    for (int i = 0; i < 16; ++i) v[i] = p[i * FST_B];
    dft16_fwd(v);
#pragma unroll
    for (int i = 0; i < 16; ++i) p[i * FST_B] = cmul(v[i], twid(TW, 16 * lo * brev4(i)));
  }
  __syncthreads();
  {
    float2* p = X + hi * FST_A + lo * FST_B;
#pragma unroll
    for (int i = 0; i < 16; ++i) v[i] = p[i];
    dft16_fwd(v);
#pragma unroll
    for (int i = 0; i < 16; ++i) p[i] = v[i];
  }
  __syncthreads();
}
DI void fft_inv(float2* X, const float2* TW, const int t) {
  float2 v[16];
  const int hi = t >> 4, lo = t & 15;
  {
    float2* p = X + hi * FST_A + lo * FST_B;
#pragma unroll
    for (int i = 0; i < 16; ++i) v[i] = p[i];
    dft16_inv(v);
#pragma unroll
    for (int i = 0; i < 16; ++i) p[i] = v[i];
  }
  __syncthreads();
  {
    float2* p = X + hi * FST_A + lo;
#pragma unroll
    for (int i = 0; i < 16; ++i) v[i] = cmulc(p[i * FST_B], twid(TW, 16 * lo * brev4(i)));
    dft16_inv(v);
#pragma unroll
    for (int i = 0; i < 16; ++i) p[i * FST_B] = v[i];
  }
  __syncthreads();
  {
    float2* p = X + hi * FST_B + lo;
#pragma unroll
    for (int i = 0; i < 16; ++i) v[i] = cmulc(p[i * FST_A], twid(TW, t * brev4(i)));
    dft16_inv(v);
#pragma unroll
    for (int i = 0; i < 16; ++i) p[i * FST_A] = v[i];
  }
  __syncthreads();
}

DI void transpose_convert(const float* src, int K, int N, bfr* dst, int Kp, int Np, const float* kscale, char* shm) {
  float* tile = (float*)shm;
  const int tk = Kp / 64, tn = Np / 64;
  const int tid = tidx();
#pragma unroll 1
  for (int it = blockIdx.x; it < tk * tn; it += gridDim.x) {
    const int k0 = (it % tk) * 64, n0 = (it / tk) * 64;
    __syncthreads();
    float4 v[2];
#pragma unroll
    for (int q = 0; q < 2; ++q) {
      const int idx = tid + q * NTHREADS, kk = idx >> 4, n4 = (idx & 15) * 4, k = k0 + kk, n = n0 + n4;
      v[q] = make_float4(0.f, 0.f, 0.f, 0.f);
      if (k < K && n < N) { v[q] = *reinterpret_cast<const float4*>(src + (long)k * N + n); if (kscale) { const float sc = kscale[k]; v[q].x *= sc; v[q].y *= sc; v[q].z *= sc; v[q].w *= sc; } }
    }
#pragma unroll
    for (int q = 0; q < 2; ++q) { const int idx = tid + q * NTHREADS; *reinterpret_cast<float4*>(tile + (idx >> 4) * 68 + (idx & 15) * 4) = v[q]; }
    __syncthreads();
#pragma unroll
    for (int q = 0; q < 2; ++q) {
      const int idx = tid + q * NTHREADS, nn = idx >> 4, k4 = (idx & 15) * 4;
      uint2 pk; pk.x = pack2(tile[k4 * 68 + nn], tile[(k4 + 1) * 68 + nn]); pk.y = pack2(tile[(k4 + 2) * 68 + nn], tile[(k4 + 3) * 68 + nn]);
      *reinterpret_cast<uint2*>(dst + (long)(n0 + nn) * Kp + k0 + k4) = pk;
    }
  }
}

DI void ln_rows(const float* src, float* dst32, bfr* dstb, const float* g, const float* bta) {
  const int wid = tidx() >> 6, lane = tidx() & 63;
#pragma unroll 1
  for (int row0 = (blockIdx.x * 8 + wid) * 2; row0 < NT; row0 += gridDim.x * 16) {
    float4 v[2][4];
#pragma unroll
    for (int q = 0; q < 2; ++q)
#pragma unroll
      for (int i = 0; i < 4; ++i) v[q][i] = reinterpret_cast<const float4*>(src + (long)(row0 + q) * D)[i * 64 + lane];
#pragma unroll
    for (int q = 0; q < 2; ++q) {
      const int row = row0 + q;
      float sum = 0.f;
#pragma unroll
      for (int i = 0; i < 4; ++i) sum += v[q][i].x + v[q][i].y + v[q][i].z + v[q][i].w;
#pragma unroll
      for (int o = 32; o >= 1; o >>= 1) sum += __shfl_xor(sum, o);
      const float mu = sum * (1.f / D);
      float sq = 0.f;
#pragma unroll
      for (int i = 0; i < 4; ++i) { v[q][i].x -= mu; v[q][i].y -= mu; v[q][i].z -= mu; v[q][i].w -= mu; sq += v[q][i].x * v[q][i].x + v[q][i].y * v[q][i].y + v[q][i].z * v[q][i].z + v[q][i].w * v[q][i].w; }
#pragma unroll
      for (int o = 32; o >= 1; o >>= 1) sq += __shfl_xor(sq, o);
      const float rstd = rsqrtf(sq * (1.f / D) + 1e-5f);
#pragma unroll
      for (int i = 0; i < 4; ++i) {
        const int c4 = i * 64 + lane;
        const float4 gg = reinterpret_cast<const float4*>(g)[c4], bb = reinterpret_cast<const float4*>(bta)[c4];
        float4 y; y.x = v[q][i].x * rstd * gg.x + bb.x; y.y = v[q][i].y * rstd * gg.y + bb.y; y.z = v[q][i].z * rstd * gg.z + bb.z; y.w = v[q][i].w * rstd * gg.w + bb.w;
        if (dst32) reinterpret_cast<float4*>(dst32 + (long)row * D)[c4] = y;
        uint2 pk; pk.x = pack2(y.x, y.y); pk.y = pack2(y.z, y.w);
        reinterpret_cast<uint2*>(dstb + (long)row * D)[c4] = pk;
      }
    }
  }
}

DI void phase_prep(const PX& P, char* shm) {
  char* ws = P.ws;
  for (int l = 0; l < NL; ++l) {
    bfr* W = (bfr*)(ws + WS_W) + (size_t)l * EW_LAYER;
    transpose_convert(P.in[4] + (size_t)l * 1024 * INW, 1024, INW, W + WO_IN, 1024, 2816, nullptr, shm);
    transpose_convert(P.in[7] + (size_t)l * 256 * 384, 256, 384, W + WO_UQ, 256, 512, P.in[5] + l * 256, shm);
    transpose_convert(P.in[8] + (size_t)l * 128 * 512, 128, 512, W + WO_UKV, 256, 512, P.in[6] + l * 128, shm);
    transpose_convert(P.in[25] + (size_t)l * 1024 * 1024, 1024, 1024, W + WO_OUT, 1024, 1024, P.in[24] + l * 1024, shm);
    transpose_convert(P.in[28] + (size_t)l * 1024 * DFF, 1024, DFF, W + WO_G, 1024, DFF, nullptr, shm);
    transpose_convert(P.in[29] + (size_t)l * 1024 * DFF, 1024, DFF, W + WO_U, 1024, DFF, nullptr, shm);
    transpose_convert(P.in[32] + (size_t)l * DFF * 1024, DFF, 1024, W + WO_D, DFF, 1024, nullptr, shm);
    transpose_convert(P.in[35] + (size_t)l * 256 * 1024, 256, 1024, W + WO_PP, 256, 1024, nullptr, shm);
    transpose_convert(P.in[36] + (size_t)l * 1024 * 1024, 1024, 1024, W + WO_PG, 1024, 1024, nullptr, shm);
  }
  __syncthreads();
  {
    float2* rope = (float2*)(ws + WS_ROPE);
    float2* tw = (float2*)(ws + WS_TW);
    for (int e = blockIdx.x * NTHREADS + tidx(); e < 2048 * 16 + 2048; e += gridDim.x * NTHREADS) {
      if (e < 2048 * 16) {
        const int t = e >> 4, j = e & 15;
        const float invf = exp2f(-(float)j * (13.287712379549449f / 16.0f));
        const float ang = (float)t * invf;
        float sn, cs; sincosf(ang, &sn, &cs);
        rope[e] = make_float2(cs, sn);
      } else {
        const int k = e - 2048 * 16;
        float sn, cs; sincospif((float)k * (1.0f / 2048.0f), &sn, &cs);
        tw[k] = make_float2(cs, -sn);
      }
    }
  }
  {
    float* sm = (float*)shm;
    float* kbuf = (float*)(ws + WS_KBUF);
    const int tid = tidx();
#pragma unroll 1
    for (int it = blockIdx.x; it < NL * (S / 4); it += gridDim.x) {
      const int l = it / (S / 4), tb = (it % (S / 4)) * 4;
      const float* w1 = P.in[11] + l * 33 * 64; const float* b1 = P.in[12] + l * 64; const float* fq = P.in[13] + l * 64;
      const float* w2 = P.in[14] + l * 64 * 64; const float* b2 = P.in[15] + l * 64; const float* w3 = P.in[16] + (size_t)l * 64 * 1024;
      __syncthreads();
      if (tid < 4 * 33) {
        const int q = tid / 33, i = tid % 33, t = tb + q;
        float f;
        if (i == 0) f = (float)t / 2047.0f;
        else {
          const int bi = (i - 1) & 15;
          const float band = 1e-4f + (float)bi * ((15.0f - 1e-4f) / 15.0f);
          const float ang = 6.283185307179586f * (float)t / 2048.0f;
          const float a = band * ang;
          f = (i <= 16) ? cosf(a) : -sinf(a);
        }
        sm[q * 64 + i] = f;
      }
      __syncthreads();
      if (tid < 256) {
        const int q = tid >> 6, j = tid & 63; float a = b1[j];
        for (int i = 0; i < 33; ++i) a += sm[q * 64 + i] * w1[i * 64 + j];
        sm[256 + q * 64 + j] = sinf(fq[j] * a);
      }
      __syncthreads();
      if (tid < 256) {
        const int q = tid >> 6, j = tid & 63; float a = b2[j];
        for (int i = 0; i < 64; ++i) a += sm[256 + q * 64 + i] * w2[i * 64 + j];
        sm[512 + q * 64 + j] = sinf(fq[j] * a);
      }
      __syncthreads();
#pragma unroll 1
      for (int oc = tid; oc < 1024; oc += NTHREADS) {
        float a0 = 0.f, a1 = 0.f, a2 = 0.f, a3 = 0.f;
#pragma unroll 8
        for (int i = 0; i < 64; ++i) { const float w = w3[i * 1024 + oc]; a0 += sm[512 + i] * w; a1 += sm[576 + i] * w; a2 += sm[640 + i] * w; a3 += sm[704 + i] * w; }
        const int o = oc >> 9, dir = (oc >> 8) & 1, c = oc & 255;
        const float mind = -3.0701134573253945f, maxd = -15.350567286626973f;
        const float delta = fabsf(mind + (float)c * ((maxd - mind) / 255.0f));
        float* kb = kbuf + ((size_t)((l * 2 + o) * 256 + c)) * 4096;
        const float av[4] = {a0, a1, a2, a3};
#pragma unroll
        for (int q = 0; q < 4; ++q) {
          const int t = tb + q;
          const float a = av[q] * expf(-((float)t / 2047.0f) * delta);
          if (dir == 0) kb[t] = a;
          else { if (t == 0) kb[2048] = 0.f; else kb[4096 - t] = a; }
        }
      }
    }
  }
  ln_rows(P.in[0], nullptr, (bfr*)(ws + WS_HB), P.in[2], P.in[3]);
}

DI void phase_gemm_in(const PX& P, int l, char* shm, int skip = 0) {
  const bfr* A = (const bfr*)(P.ws + WS_HB);
  const bfr* Bt = (const bfr*)(P.ws + WS_W) + (size_t)l * EW_LAYER + WO_IN;
  EpiStoreBf16 epi{(bfr*)(P.ws + WS_U), INP};
  for (int u = blockIdx.x; u < 256 * 11; u += gridDim.x) {
    int pm, pn; unit_to_tile(u, 256, 11, pm, pn);
#if PROBE_GEMM
    if (skip) gemm_unit<1024, 1024, EpiStoreBf16, PROBE_GEMM>(A, Bt, 1024, pm * 256, pn * 256, shm, epi);
    else
#endif
    gemm_unit<1024, 1024>(A, Bt, 1024, pm * 256, pn * 256, shm, epi);
  }
}

template <int NCOL>
DI void row_rstd(const bfr* Ucol, int brow, float* rs) {
  const int r = tidx() >> 1, hf = tidx() & 1;
  const unsigned uoff = (unsigned)(brow + r) * (unsigned)INP + (unsigned)(hf * NCOL);
  const bfr* up = Ucol + uoff;
  float ss = 0.f;
  uint4 q[NCOL / 8];
#pragma unroll
  for (int c = 0; c < NCOL / 8; ++c) q[c] = *reinterpret_cast<const uint4*>(up + c * 8);
#pragma unroll
  for (int c = 0; c < NCOL / 8; ++c) {
    float f[8]; unpack8(q[c], f);
#pragma unroll
    for (int e = 0; e < 8; ++e) ss += f[e] * f[e];
  }
  ss += __shfl_xor(ss, 1);
  if (hf == 0) rs[r] = rsqrtf(ss / (float)(2 * NCOL) + 1e-6f);
  __syncthreads();
}

DI void phase_premix(const PX& P, int l, char* shm) {
  char* ws = P.ws;
  const bfr* U = (const bfr*)(ws + WS_U);
  const bfr* W = (const bfr*)(ws + WS_W) + (size_t)l * EW_LAYER;
  float* rs = (float*)(shm + 135168);
  const float2* rope = (const float2*)(ws + WS_ROPE);
#ifndef SKIP_Q
  {
    EpiQ epi{(bfr*)(ws + WS_Q), rs, rope};
#pragma unroll 1
    for (int it = blockIdx.x; it < 512; it += gridDim.x) {
      const int pn = it & 1, brow = (it >> 1) * 256;
      row_rstd<128>(U + OQ, brow, rs);
      gemm_unit<INP, 256>(U + OQ, W + WO_UQ, 256, brow, pn * 256, shm, epi);
    }
  }
#endif
#ifndef SKIP_KV
  {
    EpiKV epi{(bfr*)(ws + WS_K), (bfr*)(ws + WS_VT), rs};
#pragma unroll 1
    for (int it = blockIdx.x; it < 512; it += gridDim.x) {
      const int pn = it & 1, brow = (it >> 1) * 256;
      row_rstd<64>(U + OKV, brow, rs);
      gemm_unit<INP, 256>(U + OKV, W + WO_UKV, 256, brow, pn * 256, shm, epi);
    }
  }
#endif
  {
    bfr* Kf = (bfr*)(ws + WS_K);
    for (long e = (long)blockIdx.x * NTHREADS + tidx(); e < (long)NT * 16; e += (long)gridDim.x * NTHREADS) {
      const int jj = (int)(e & 15); const long row = e >> 4; const int b = (int)(row >> 11), t = (int)(row & (S - 1));
      const float x1 = bf2f(U[row * INP + OKR + jj]), x2 = bf2f(U[row * INP + OKR + 16 + jj]);
      const float2 cs = rope[t * 16 + jj];
      const bfr o1 = f2bf(x1 * cs.x - x2 * cs.y), o2 = f2bf(x2 * cs.x + x1 * cs.y);
#pragma unroll
      for (int hh = 0; hh < 4; ++hh) {
        bfr* kp = Kf + (((long)(b * 4 + hh)) * S + t) * 96 + 64 + jj;
        kp[0] = o1; kp[16] = o2;
      }
    }
  }
  {
    bfr* tile = (bfr*)shm;
    bfr* HYT = (bfr*)(ws + WS_HYT);
    const float* cw = P.in[9] + l * 3 * 768; const float* cbias = P.in[10] + l * 768;
    const int tid = tidx();
#pragma unroll 1
    for (int it = blockIdx.x; it < 1024; it += gridDim.x) {
      const int b = it >> 5, t0 = (it & 31) * 64;
      __syncthreads();
#pragma unroll 1
      for (int e0 = tid; e0 < 96 * 64; e0 += 4 * NTHREADS) {
        uint4 q0[4], qm[4], qp[4];
#pragma unroll
        for (int i = 0; i < 4; ++i) {
          const int e = e0 + i * NTHREADS, c8 = e % 96, tl = e / 96, t = t0 + tl;
          const bfr* ub = U + ((long)b * S + t) * INP + OHY + c8 * 8;
          q0[i] = *reinterpret_cast<const uint4*>(ub);
          qm[i] = make_uint4(0, 0, 0, 0); qp[i] = make_uint4(0, 0, 0, 0);
          if (t > 0) qm[i] = *reinterpret_cast<const uint4*>(ub - INP);
          if (t < S - 1) qp[i] = *reinterpret_cast<const uint4*>(ub + INP);
        }
#pragma unroll
        for (int i = 0; i < 4; ++i) {
          const int e = e0 + i * NTHREADS, c8 = e % 96, tl = e / 96, c = c8 * 8;
          float u0[8], um[8], up[8], w[8], a[8];
          unpack8(q0[i], u0); unpack8(qm[i], um); unpack8(qp[i], up);
          ld8f(cbias + c, a);
          ld8f(cw + c, w);
#pragma unroll
          for (int j = 0; j < 8; ++j) a[j] += w[j] * um[j];
          ld8f(cw + 768 + c, w);
#pragma unroll
          for (int j = 0; j < 8; ++j) a[j] += w[j] * u0[j];
          ld8f(cw + 1536 + c, w);
          const int tr = (tl + 2 * c8) & 63;
#pragma unroll
          for (int j = 0; j < 8; ++j) tile[(c + j) * 66 + tr] = f2bf(a[j] + w[j] * up[j]);
        }
      }
      __syncthreads();
#pragma unroll 1
      for (int e = tid; e < 768 * 8; e += NTHREADS) {
        const int c = e >> 3, ch = e & 7, rot = c >> 3;
        const unsigned* tp = reinterpret_cast<const unsigned*>(tile + c * 66);
        uint4 v; v.x = tp[(ch * 4 + rot) & 31]; v.y = tp[(ch * 4 + 1 + rot) & 31]; v.z = tp[(ch * 4 + 2 + rot) & 31]; v.w = tp[(ch * 4 + 3 + rot) & 31];
        *reinterpret_cast<uint4*>(HYT + ((long)(b * 768 + c)) * S + t0 + ch * 8) = v;
      }
    }
  }
  if (l == 0) {
    const int tid = tidx(), hw = tid >> 8, t = tid & 255;
    float2* X = (float2*)shm + hw * FFT_LDS; float2* TW = (float2*)(shm + 2 * FFT_LDS * 8);
    const float* kbuf = (const float*)(ws + WS_KBUF);
    float2* KF = (float2*)(ws + WS_KF);
    const float2* twg = (const float2*)(ws + WS_TW);
    for (int it0 = blockIdx.x * 2; it0 < 1024; it0 += gridDim.x * 2) {
      const int it = it0 + hw;
      __syncthreads();
      for (int e = tid; e < 2048; e += NTHREADS) TW[e] = twg[e];
      for (int e = t; e < 4096; e += 256) X[fpos(e)] = make_float2(kbuf[(size_t)it * 4096 + e], 0.f);
      __syncthreads();
      fft_fwd(X, TW, t);
      for (int e = t; e < 4096; e += 256) { const float2 v = X[fpos(e)]; KF[(size_t)it * 4096 + e] = make_float2(v.x * (1.f / 4096.f), v.y * (1.f / 4096.f)); }
    }
  }
}

DI void ssd_item(const PX& P, int l, int item, char* shm) {
  constexpr int ST = 136;
  const bfr* U = (const bfr*)(P.ws + WS_U);
  bfr* YS = (bfr*)(P.ws + WS_YSSD);
  const int b = item >> 3, dir = (item >> 2) & 1, hd = item & 3, g = hd >> 1;
  const int tid = tidx(), wid = tid >> 6, lane = tid & 63, r = lane & 31, h = lane >> 5;
  const float* cw = P.in[19] + l * 3 * 768; const float* cbias = P.in[20] + l * 768;
  const float dtb = P.in[21][l * 8 + dir * 4 + hd];
  const float Acoef = -__expf(P.in[22][l * 8 + dir * 4 + hd]);
  bfr* Cs = (bfr*)shm;
  bfr* Bs = Cs + 128 * ST;
  bfr* BTd = Bs + 128 * ST;
  bfr* XT = BTd + 128 * ST;
  bfr* Rb = XT + 64 * ST;
  float* acs = (float*)(Rb + 64 * ST);
  float* dts = acs + 128;
  f32x16 racc;
#pragma unroll
  for (int i = 0; i < 16; ++i) racc[i] = 0.f;
  for (int e = tid; e < 64 * ST / 2; e += NTHREADS) reinterpret_cast<unsigned*>(Rb)[e] = 0u;
  float xr_next[2] = {0.f, 0.f};
  if (wid == 0) {
#pragma unroll
    for (int q = 0; q < 2; ++q) {
      const int k = lane * 2 + q, t = dir == 0 ? k : S - 1 - k;
      xr_next[q] = bf2f(U[((long)b * S + t) * INP + ODT + dir * 4 + hd]);
    }
  }
#pragma unroll 1
  for (int ci = 0; ci < 16; ++ci) {
    __syncthreads();
    if (wid == 0) {
      float a2[2], d2[2];
#pragma unroll
      for (int q = 0; q < 2; ++q) {
        const float xr = xr_next[q] + dtb;
        d2[q] = xr > 20.f ? xr : log1pf(__expf(xr));
        a2[q] = d2[q] * Acoef;
      }
      if (ci + 1 < 16) {
#pragma unroll
        for (int q = 0; q < 2; ++q) {
          const int k = lane * 2 + q, step = (ci + 1) * 128 + k, t = dir == 0 ? step : S - 1 - step;
          xr_next[q] = bf2f(U[((long)b * S + t) * INP + ODT + dir * 4 + hd]);
        }
      }
      const float pairsum = a2[0] + a2[1];
      float sc = pairsum;
      int lane_o = lane; asm volatile("" : "+v"(lane_o));
#pragma unroll
      for (int o = 1; o < 64; o <<= 1) { const float v = __shfl_up(sc, o); sc += (lane_o >= o) ? v : 0.f; }
      acs[lane * 2] = sc - a2[1]; acs[lane * 2 + 1] = sc;
      dts[lane * 2] = d2[0]; dts[lane * 2 + 1] = d2[1];
    }
    __syncthreads();
    const float atot = acs[127];
#pragma unroll 1
    for (int i0 = 0; i0 < 10; i0 += 5) {
      uint4 q0[5], qm[5], qp[5];
#pragma unroll
      for (int i = 0; i < 5; ++i) {
        const int it = tid + (i0 + i) * NTHREADS, k = it / 40, cc8 = it % 40;
        const int step = ci * 128 + k, t = dir == 0 ? step : S - 1 - step;
        const int col = cc8 < 8 ? hd * 64 + cc8 * 8 : (cc8 < 24 ? 256 + g * 128 + (cc8 - 8) * 8 : 512 + g * 128 + (cc8 - 24) * 8);
        const bfr* ub = U + ((long)b * S + t) * INP + OXBC + col;
        q0[i] = *reinterpret_cast<const uint4*>(ub);
        qm[i] = make_uint4(0, 0, 0, 0); qp[i] = make_uint4(0, 0, 0, 0);
        if (t > 0) qm[i] = *reinterpret_cast<const uint4*>(ub - INP);
        if (t < S - 1) qp[i] = *reinterpret_cast<const uint4*>(ub + INP);
      }
#pragma unroll
      for (int i = 0; i < 5; ++i) {
        const int it = tid + (i0 + i) * NTHREADS, k = it / 40, cc8 = it % 40;
        const int col = cc8 < 8 ? hd * 64 + cc8 * 8 : (cc8 < 24 ? 256 + g * 128 + (cc8 - 8) * 8 : 512 + g * 128 + (cc8 - 24) * 8);
        float u0[8], um[8], up[8], w[8], a[8];
        unpack8(q0[i], u0); unpack8(qm[i], um); unpack8(qp[i], up);
        ld8f(cbias + col, a);
        ld8f(cw + col, w);
#pragma unroll
        for (int j = 0; j < 8; ++j) a[j] += w[j] * um[j];
        ld8f(cw + 768 + col, w);
#pragma unroll
        for (int j = 0; j < 8; ++j) a[j] += w[j] * u0[j];
        ld8f(cw + 1536 + col, w);
#pragma unroll
        for (int j = 0; j < 8; ++j) a[j] = silu(a[j] + w[j] * up[j]);
        if (cc8 < 8) {
          const float dtk = dts[k];
#pragma unroll
          for (int j = 0; j < 8; ++j) XT[(cc8 * 8 + j) * ST + k] = f2bf(a[j] * dtk);
        } else if (cc8 < 24) {
          const int n0 = (cc8 - 8) * 8;
          *reinterpret_cast<uint4*>(Bs + k * ST + n0) = pack8(a);
          const float dec = __expf(atot - acs[k]);
#pragma unroll
          for (int j = 0; j < 8; ++j) BTd[(n0 + j) * ST + k] = f2bf(a[j] * dec);
        } else {
          *reinterpret_cast<uint4*>(Cs + k * ST + (cc8 - 24) * 8) = pack8(a);
        }
      }
    }
    __syncthreads();
    const int ti = wid >> 1;
    f32x16 cb[2];
#pragma unroll
    for (int q = 0; q < 2; ++q) {
      const int si = (wid & 1) * 2 + q;
#pragma unroll
      for (int i = 0; i < 16; ++i) cb[q][i] = 0.f;
      if (si <= ti) {
#pragma unroll
        for (int kk = 0; kk < 8; ++kk) {
          const bf16x8 av = *reinterpret_cast<const bf16x8*>(Cs + (32 * ti + r) * ST + kk * 16 + h * 8);
          const bf16x8 bv = *reinterpret_cast<const bf16x8*>(Bs + (32 * si + r) * ST + kk * 16 + h * 8);
          cb[q] = MFMA32(av, bv, cb[q]);
        }
      }
    }
    __syncthreads();
#pragma unroll
    for (int q = 0; q < 2; ++q) {
      const int si = (wid & 1) * 2 + q; int s = 32 * si + r; asm volatile("" : "+v"(s));
      const float as = acs[s];
#pragma unroll
      for (int i = 0; i < 16; ++i) {
        const int t = 32 * ti + (i & 3) + 8 * (i >> 2) + 4 * h;
        const float v = (s <= t) ? cb[q][i] * __expf(acs[t] - as) : 0.f;
        Bs[t * ST + s] = f2bf(v);
      }
    }
    __syncthreads();
    {
      const int pi = wid & 1;
      f32x16 y1, y2;
#pragma unroll
      for (int i = 0; i < 16; ++i) { y1[i] = 0.f; y2[i] = 0.f; }
#pragma unroll
      for (int kk = 0; kk < 8; ++kk) {
        const bf16x8 xv = *reinterpret_cast<const bf16x8*>(XT + (32 * pi + r) * ST + kk * 16 + h * 8);
        if (kk * 16 < 32 * ti + 32) {
          const bf16x8 mv = *reinterpret_cast<const bf16x8*>(Bs + (32 * ti + r) * ST + kk * 16 + h * 8);
          y1 = MFMA32(mv, xv, y1);
        }
        const bf16x8 cv = *reinterpret_cast<const bf16x8*>(Cs + (32 * ti + r) * ST + kk * 16 + h * 8);
        const bf16x8 rv = *reinterpret_cast<const bf16x8*>(Rb + (32 * pi + r) * ST + kk * 16 + h * 8);
        y2 = MFMA32(cv, rv, y2);
      }
#pragma unroll
      for (int i = 0; i < 16; ++i) {
        const int k = 32 * ti + (i & 3) + 8 * (i >> 2) + 4 * h;
        const int step = ci * 128 + k, t = dir == 0 ? step : S - 1 - step;
        const float y = y1[i] + __expf(acs[k]) * y2[i];
        YS[((size_t)dir * NT + (size_t)b * S + t) * 256 + hd * 64 + 32 * pi + r] = f2bf(y);
      }
    }
    {
      const int pi = wid >> 2, ni = wid & 3;
      const float ed = __expf(atot);
#pragma unroll
      for (int i = 0; i < 16; ++i) racc[i] *= ed;
#pragma unroll
      for (int kk = 0; kk < 8; ++kk) {
        const bf16x8 xv = *reinterpret_cast<const bf16x8*>(XT + (32 * pi + r) * ST + kk * 16 + h * 8);
        const bf16x8 bv = *reinterpret_cast<const bf16x8*>(BTd + (32 * ni + r) * ST + kk * 16 + h * 8);
        racc = MFMA32(xv, bv, racc);
      }
      __syncthreads();
#pragma unroll
      for (int i = 0; i < 16; ++i) Rb[(32 * pi + (i & 3) + 8 * (i >> 2) + 4 * h) * ST + 32 * ni + r] = f2bf(racc[i]);
    }
  }
}

DI void hyena_item(const PX& P, int l, int item0, char* shm) {
  const int tid = tidx(), hw = tid >> 8, t = tid & 255;
  const int item = item0 + hw;
  const int c = item >> 4, bp = item & 15, b0 = bp * 2, b1 = b0 + 1;
  float2* X = (float2*)shm + hw * FFT_LDS;
  float2* TW = (float2*)(shm + 2 * FFT_LDS * 8);
  float2* Z1 = TW + 2048 + hw * 2048;
  const bfr* HYT = (const bfr*)(P.ws + WS_HYT);
  const float2* twg = (const float2*)(P.ws + WS_TW);
  const float2* KF0 = (const float2*)(P.ws + WS_KF) + ((size_t)((l * 2 + 0) * 256 + c)) * 4096;
  const float2* KF1 = (const float2*)(P.ws + WS_KF) + ((size_t)((l * 2 + 1) * 256 + c)) * 4096;
  const float bias0 = P.in[17][(l * 2 + 0) * 256 + c], bias1 = P.in[17][(l * 2 + 1) * 256 + c];
  const bfr* v0 = HYT + ((size_t)(b0 * 768 + c)) * S; const bfr* v1 = HYT + ((size_t)(b1 * 768 + c)) * S;
  const bfr* x10 = v0 + 256 * S; const bfr* x11 = v1 + 256 * S;
  const bfr* x20 = v0 + 512 * S; const bfr* x21 = v1 + 512 * S;
  bfr* yo0 = (bfr*)(P.ws + WS_YH) + ((size_t)(b0 * 256 + c)) * S; bfr* yo1 = (bfr*)(P.ws + WS_YH) + ((size_t)(b1 * 256 + c)) * S;
  __syncthreads();
  for (int e = tid; e < 2048; e += NTHREADS) TW[e] = twg[e];
  {
    float a[8], b[8];
    unpack8(*reinterpret_cast<const uint4*>(v0 + t * 8), a); unpack8(*reinterpret_cast<const uint4*>(v1 + t * 8), b);
#pragma unroll
    for (int k = 0; k < 8; ++k) { X[fpos(t * 8 + k)] = make_float2(a[k], b[k]); X[fpos(2048 + t * 8 + k)] = make_float2(0.f, 0.f); }
  }
  __syncthreads();
  fft_fwd(X, TW, t);
  { float2 kf[16];
#pragma unroll
    for (int i = 0; i < 16; ++i) kf[i] = KF0[t + i * 256];
#pragma unroll
    for (int i = 0; i < 16; ++i) { const int p = fpos(t + i * 256); X[p] = cmul(X[p], kf[i]); } }
  __syncthreads();
  fft_inv(X, TW, t);
  {
    float a[8], b[8], g0[8], g1[8];
    unpack8(*reinterpret_cast<const uint4*>(v0 + t * 8), a); unpack8(*reinterpret_cast<const uint4*>(v1 + t * 8), b);
    unpack8(*reinterpret_cast<const uint4*>(x10 + t * 8), g0); unpack8(*reinterpret_cast<const uint4*>(x11 + t * 8), g1);
    float2 z[8];
#pragma unroll
    for (int k = 0; k < 8; ++k) { const float2 y = X[fpos(t * 8 + k)]; z[k] = make_float2(g0[k] * (y.x + bias0 * a[k]), g1[k] * (y.y + bias0 * b[k])); }
    __syncthreads();
#pragma unroll
    for (int k = 0; k < 8; ++k) { Z1[t * 8 + k] = z[k]; X[fpos(t * 8 + k)] = z[k]; X[fpos(2048 + t * 8 + k)] = make_float2(0.f, 0.f); }
  }
  __syncthreads();
  fft_fwd(X, TW, t);
  { float2 kf[16];
#pragma unroll
    for (int i = 0; i < 16; ++i) kf[i] = KF1[t + i * 256];
#pragma unroll
    for (int i = 0; i < 16; ++i) { const int p = fpos(t + i * 256); X[p] = cmul(X[p], kf[i]); } }
  __syncthreads();
  fft_inv(X, TW, t);
  {
    float g0[8], g1[8], o0[8], o1[8];
    unpack8(*reinterpret_cast<const uint4*>(x20 + t * 8), g0); unpack8(*reinterpret_cast<const uint4*>(x21 + t * 8), g1);
#pragma unroll
    for (int k = 0; k < 8; ++k) { const float2 y = X[fpos(t * 8 + k)], z1 = Z1[t * 8 + k]; o0[k] = g0[k] * (y.x + bias1 * z1.x); o1[k] = g1[k] * (y.y + bias1 * z1.y); }
    *reinterpret_cast<uint4*>(yo0 + t * 8) = pack8(o0); *reinterpret_cast<uint4*>(yo1 + t * 8) = pack8(o1);
  }
}

DI void phase_mix(const PX& P, int l, char* shm) {
  char* ws = P.ws;
  for (int rep = 0; rep < ((PROBE_MIX & 1) ? 2 : 1); ++rep)
  for (int it = blockIdx.x; it < 256; it += gridDim.x) ssd_item(P, l, it, shm);
  {
    const float sc = 0.10206207261596575f * LOG2E;
    for (int it = blockIdx.x; it < 1024; it += gridDim.x) {
      const int qblk = it & 7, bh = it >> 3, b = bh >> 2, hh = bh & 3;
      const bfr* q = (const bfr*)(ws + WS_Q) + (size_t)bh * S * 96;
      const bfr* k = (const bfr*)(ws + WS_K) + (size_t)bh * S * 96;
      const bfr* vt = (const bfr*)(ws + WS_VT) + (size_t)bh * 64 * S;
      bfr* o = (bfr*)(ws + WS_Y) + (size_t)b * S * 512 + hh * 64;
      attn_item<96, false>(q, 96, k, 96, vt, S, qblk * 256, 0, S, sc, 0.f, 0.f, o, 512, shm);
    }
  }
  {
    const bfr* U = (const bfr*)(ws + WS_U);
    for (int it = blockIdx.x; it < 1024; it += gridDim.x) {
      const int qblk = it & 7, bh = it >> 3, b = bh >> 2, hh = bh & 3, kvh = hh >> 1;
      const bfr* q = U + (size_t)b * S * INP + OSQ + hh * 64;
      const bfr* k = U + (size_t)b * S * INP + OSK + kvh * 64;
      const bfr* v = U + (size_t)b * S * INP + OSV + kvh * 64;
      bfr* o = (bfr*)(ws + WS_Y) + (size_t)b * S * 512 + 256 + hh * 64;
      const int q0 = qblk * 256, klo = max(q0 - 128, 0), khi = min(q0 + 256 + 128, S);
      const float slope = exp2f(-2.f * (float)(hh + 1));
      attn_item<64, true>(q, INP, k, INP, v, INP, q0, klo, khi, 0.125f * LOG2E, slope * LOG2E, P.in[18][l * 4 + hh] * LOG2E, o, 512, shm);
    }
  }
  for (int rep = 0; rep < ((PROBE_MIX & 8) ? 2 : 1); ++rep)
  for (int it = blockIdx.x * 2; it < 4096; it += gridDim.x * 2) hyena_item(P, l, it, shm);
}

DI void norm_store(float* vals, bfr* op) {
  float ss = 0.f;
#pragma unroll
  for (int k = 0; k < 16; ++k) ss += vals[k] * vals[k];
  ss += swz_xor<1>(ss); ss += swz_xor<2>(ss); ss += swz_xor<4>(ss); ss += swz_xor<8>(ss);
  const float rstd = rsqrtf(ss * (1.f / 256.f) + 1e-6f);
#pragma unroll
  for (int k = 0; k < 16; ++k) vals[k] *= rstd;
  *reinterpret_cast<uint4*>(op) = pack8(vals); *reinterpret_cast<uint4*>(op + 8) = pack8(vals + 8);
}

DI void phase_norm(const PX& P, int l, char* shm) {
  char* ws = P.ws;
  const bfr* U = (const bfr*)(ws + WS_U);
  const bfr* Y = (const bfr*)(ws + WS_Y);
  const bfr* YH = (const bfr*)(ws + WS_YH);
  const bfr* YS = (const bfr*)(ws + WS_YSSD);
  bfr* YN = (bfr*)(ws + WS_YN);
  bfr* hy = (bfr*)shm;
  const float* cw = P.in[19] + l * 3 * 768; const float* cbias = P.in[20] + l * 768;
  const int tid = tidx(), wid = tid >> 6, lane = tid & 63;
  const int grp = wid & 3, tsub = (wid >> 2) * 32, tk = lane >> 4, c16 = (lane & 15) * 16;
#pragma unroll 1
  for (int it = blockIdx.x; it < 1024; it += gridDim.x) {
    const int b = it >> 5, t0 = (it & 31) * 64;
    __syncthreads();
    for (int e = tid; e < 2048; e += NTHREADS) {
      const int c = e >> 3, ch = e & 7, rot = c >> 4;
      const uint4 v = *reinterpret_cast<const uint4*>(YH + ((size_t)(b * 256 + c)) * S + t0 + ch * 8);
      unsigned* tp = reinterpret_cast<unsigned*>(hy + c * 66);
      tp[(ch * 4 + rot) & 31] = v.x; tp[(ch * 4 + 1 + rot) & 31] = v.y; tp[(ch * 4 + 2 + rot) & 31] = v.z; tp[(ch * 4 + 3 + rot) & 31] = v.w;
    }
    __syncthreads();
    if (grp == 0 || grp == 2) {
      uint4 qa[8], qb[8];
#pragma unroll
      for (int i = 0; i < 8; ++i) {
        const long row = (long)b * S + t0 + tsub + i * 4 + tk;
        const bfr* yp = Y + row * 512 + (grp == 0 ? 0 : 256) + c16;
        qa[i] = *reinterpret_cast<const uint4*>(yp); qb[i] = *reinterpret_cast<const uint4*>(yp + 8);
      }
#pragma unroll
      for (int i = 0; i < 8; ++i) {
        const long row = (long)b * S + t0 + tsub + i * 4 + tk;
        float vals[16];
        unpack8(qa[i], vals); unpack8(qb[i], vals + 8);
        norm_store(vals, YN + row * 1024 + grp * 256 + c16);
      }
    } else if (grp == 1) {
#pragma unroll 2
      for (int i = 0; i < 8; ++i) {
        const int tl = tsub + i * 4 + tk; const long row = (long)b * S + t0 + tl;
        const int tr = (tl + 2 * (lane & 15)) & 63;
        float vals[16];
#pragma unroll
        for (int k = 0; k < 16; ++k) vals[k] = bf2f(hy[(c16 + k) * 66 + tr]);
        norm_store(vals, YN + row * 1024 + 256 + c16);
      }
    } else {
      const int hd = c16 >> 6;
      const float dsum = P.in[23][l * 8 + hd] + P.in[23][l * 8 + 4 + hd];
#pragma unroll 1
      for (int i = 0; i < 8; ++i) {
        const int tl = tsub + i * 4 + tk, t = t0 + tl; const long row = (long)b * S + t;
        const bfr* ub = U + row * INP + OXBC + c16;
        uint4 q0[2], qm[2], qp[2], qf[2], qbk[2], qz[2];
#pragma unroll
        for (int hf = 0; hf < 2; ++hf) {
          q0[hf] = *reinterpret_cast<const uint4*>(ub + hf * 8);
          qm[hf] = make_uint4(0, 0, 0, 0); qp[hf] = make_uint4(0, 0, 0, 0);
          if (t > 0) qm[hf] = *reinterpret_cast<const uint4*>(ub - INP + hf * 8);
          if (t < S - 1) qp[hf] = *reinterpret_cast<const uint4*>(ub + INP + hf * 8);
          qf[hf] = *reinterpret_cast<const uint4*>(YS + (size_t)row * 256 + c16 + hf * 8);
          qbk[hf] = *reinterpret_cast<const uint4*>(YS + ((size_t)NT + row) * 256 + c16 + hf * 8);
          qz[hf] = *reinterpret_cast<const uint4*>(U + row * INP + OZ + c16 + hf * 8);
        }
        float vals[16];
#pragma unroll
        for (int hf = 0; hf < 2; ++hf) {
          float u0[8], um[8], up[8], w[8], a[8];
          unpack8(q0[hf], u0); unpack8(qm[hf], um); unpack8(qp[hf], up);
          ld8f(cbias + c16 + hf * 8, a);
          ld8f(cw + c16 + hf * 8, w);
#pragma unroll
          for (int k = 0; k < 8; ++k) a[k] += w[k] * um[k];
          ld8f(cw + 768 + c16 + hf * 8, w);
#pragma unroll
          for (int k = 0; k < 8; ++k) a[k] += w[k] * u0[k];
          ld8f(cw + 1536 + c16 + hf * 8, w);
#pragma unroll
          for (int k = 0; k < 8; ++k) a[k] += w[k] * up[k];
          unpack8(qf[hf], u0); unpack8(qbk[hf], um); unpack8(qz[hf], up);
#pragma unroll
          for (int k = 0; k < 8; ++k) vals[hf * 8 + k] = (u0[k] + um[k] + dsum * silu(a[k])) * silu(up[k]);
        }
        norm_store(vals, YN + row * 1024 + 768 + c16);
      }
    }
  }
}

DI void ln_panel(const bfr* pre, float* out, bfr* hb, const float* stats, int brow, const float* g, const float* bta, bool write_f32) {
  const int tid = tidx(), wid = tid >> 6, lane = tid & 63;
#pragma unroll 1
  for (int r4 = wid * 4; r4 < 256; r4 += 32) {
    uint4 q[4][2];
#pragma unroll
    for (int qq = 0; qq < 4; ++qq)
#pragma unroll
      for (int i = 0; i < 2; ++i) q[qq][i] = write_f32 ? make_uint4(0, 0, 0, 0) : *reinterpret_cast<const uint4*>(pre + (long)(brow + r4 + qq) * D + i * 512 + lane * 8);
#pragma unroll
    for (int qq = 0; qq < 4; ++qq) {
      const int row = brow + r4 + qq;
      const float2 st = reinterpret_cast<const float2*>(stats)[r4 + qq];
      const float mu = st.x * (1.f / D);
      const float rstd = rsqrtf(fmaxf(st.y * (1.f / D) - mu * mu, 0.f) + 1e-5f);
#pragma unroll
      for (int i = 0; i < 2; ++i) {
        const int c0 = i * 512 + lane * 8;
        float v[8], gg[8], bb[8];
        if (write_f32) ld8f(out + (long)row * D + c0, v); else unpack8(q[qq][i], v);
        ld8f(g + c0, gg); ld8f(bta + c0, bb);
#pragma unroll
        for (int k = 0; k < 8; ++k) v[k] = (v[k] - mu) * rstd * gg[k] + bb[k];
        if (write_f32) { float* op = out + (long)row * D + c0; *reinterpret_cast<float4*>(op) = make_float4(v[0], v[1], v[2], v[3]); *reinterpret_cast<float4*>(op + 4) = make_float4(v[4], v[5], v[6], v[7]); }
        *reinterpret_cast<uint4*>(hb + (long)row * D + c0) = pack8(v);
      }
    }
  }
}

template <int LDA, int LDB>
DI void phase_gemm_ln(const PX& P, const bfr* A, const bfr* Bt, int K, const float* g, const float* bta, char* shm) {
  float* stats = (float*)(shm + 136192);
  EpiResid epi{(bfr*)(P.ws + WS_PRE), (const bfr*)(P.ws + WS_HB), stats};
#pragma unroll 1
  for (int pm = blockIdx.x; pm < 256; pm += gridDim.x) {
    { const int t = tidx(); if (t < 512) stats[t] = 0.f; }
    __syncthreads();
#pragma unroll 1
    for (int pn = 0; pn < 4; ++pn) gemm_unit<LDA, LDB>(A, Bt, K, pm * 256, pn * 256, shm, epi);
    ln_panel((const bfr*)(P.ws + WS_PRE), P.out, (bfr*)(P.ws + WS_HB), stats, pm * 256, g, bta, false);
    __syncthreads();
  }
}

template <int LDA, int LDB, int K, class Epi>
DI void phase_gemm(const bfr* A, const bfr* Bt, int nN, char* shm, const Epi& epi) {
  for (int u = blockIdx.x; u < 256 * nN; u += gridDim.x) {
    int pm, pn; unit_to_tile(u, 256, nN, pm, pn);
    gemm_unit<LDA, LDB>(A, Bt, K, pm * 256, pn * 256, shm, epi);
  }
}

DI void phase_ple(const PX& P, int l, char* shm) {
  char* ws = P.ws;
  const bfr* W = (const bfr*)(ws + WS_W) + (size_t)l * EW_LAYER;
  bfr* E = (bfr*)(ws + WS_YN);
  float* stats = (float*)(shm + 136192);
  EpiStoreBf16 e1{E, 1024};
  EpiPle e2{(bfr*)(ws + WS_PRE), (l == NL - 1) ? P.out : nullptr, (const bfr*)(ws + WS_HB), E, P.in[37] + l * 1024, stats};
#pragma unroll 1
  for (int pm = blockIdx.x; pm < 256; pm += gridDim.x) {
    { const int t = tidx(); if (t < 512) stats[t] = 0.f; }
    __syncthreads();
#pragma unroll 1
    for (int pn = 0; pn < 4; ++pn) gemm_unit<256, 256>((const bfr*)(ws + WS_PB), W + WO_PP, 256, pm * 256, pn * 256, shm, e1);
#pragma unroll 1
    for (int pn = 0; pn < 4; ++pn) gemm_unit<1024, 1024>((const bfr*)(ws + WS_HB), W + WO_PG, 1024, pm * 256, pn * 256, shm, e2);
    ln_panel((const bfr*)(ws + WS_PRE), P.out, (bfr*)(ws + WS_HB), stats, pm * 256, P.in[38] + l * D, P.in[39] + l * D, l == NL - 1);
    __syncthreads();
  }
}

DI void convert_p(const PX& P, int l) {
  const float4* src = reinterpret_cast<const float4*>(P.in[1] + (size_t)l * NT * PLE);
  uint2* dst = reinterpret_cast<uint2*>(P.ws + WS_PB);
  for (size_t e = (size_t)blockIdx.x * NTHREADS + tidx(); e < (size_t)NT * PLE / 4; e += (size_t)gridDim.x * NTHREADS) {
    const float4 v = src[e]; uint2 pk; pk.x = pack2(v.x, v.y); pk.y = pack2(v.z, v.w); dst[e] = pk;
  }
}

constexpr int NPH_LAYER = 9;
constexpr int NPHASES = 1 + NL * NPH_LAYER;

DI void run_phase(const Params& P0, int ph, char* shm, int skip = 0) {
  PX P;
  int z = 0; asm volatile("" : "+v"(z)); z = __builtin_amdgcn_readfirstlane(z);
  P.in = (in_tab_t)(&P0.in[0]) + z; P.out = P0.out + z; P.ws = P0.ws + z;
  char* ws = P.ws;
  if (ph == 0) { phase_prep(P, shm); return; }
  const int l = (ph - 1) / NPH_LAYER, k = (ph - 1) % NPH_LAYER;
  const bfr* W = (const bfr*)(ws + WS_W) + (size_t)l * EW_LAYER;
  const bfr* HB = (const bfr*)(ws + WS_HB);
  switch (k) {
    case 0: phase_gemm_in(P, l, shm, skip); break;
    case 1: phase_premix(P, l, shm); break;
    case 2: phase_mix(P, l, shm); break;
    case 3: phase_norm(P, l, shm); break;
    case 4: phase_gemm_ln<1024, 1024>(P, (const bfr*)(ws + WS_YN), W + WO_OUT, 1024, P.in[26] + l * D, P.in[27] + l * D, shm); convert_p(P, l); break;
    case 5: { EpiGate e{(bfr*)(ws + WS_U), (bfr*)(ws + WS_HALO)}; phase_gemm<1024, 1024, 1024>(HB, W + WO_G, 11, shm, e); } break;
    case 6: { EpiUp e{(bfr*)(ws + WS_U), (const bfr*)(ws + WS_HALO), P.in[30] + (size_t)l * 3 * DFF, P.in[31] + (size_t)l * DFF};
              phase_gemm<1024, 1024, 1024>(HB, W + WO_U, 11, shm, e); } break;
    case 7: phase_gemm_ln<DFF, DFF>(P, (const bfr*)(ws + WS_U), W + WO_D, DFF, P.in[33] + l * D, P.in[34] + l * D, shm); break;
    case 8: phase_ple(P, l, shm); break;
  }
}

DI void grid_barrier(unsigned* bar, unsigned target) {
  __syncthreads();
  if (tidx() == 0) {
    __builtin_amdgcn_fence(__ATOMIC_RELEASE, "agent");
    __hip_atomic_fetch_add(bar, 1u, __ATOMIC_RELAXED, __HIP_MEMORY_SCOPE_AGENT);
    while (__hip_atomic_load(bar, __ATOMIC_RELAXED, __HIP_MEMORY_SCOPE_AGENT) < target) __builtin_amdgcn_s_sleep(1);
    __builtin_amdgcn_fence(__ATOMIC_ACQUIRE, "agent");
  }
  __syncthreads();
}

template <int PH>
DI void do_phase(const Params& P, int lo, int hi, char* shm) {
  if (PH >= lo && PH < hi) {
#if PROBE_DUP
    if (PH > 0 && ((PROBE_DUP >> ((PH - 1) % NPH_LAYER)) & 1)) { run_phase(P, PH, shm, 1); __syncthreads(); }
    if (PH == 0 && (PROBE_DUP & 0x8000)) { run_phase(P, PH, shm, 1); __syncthreads(); }
#endif
    run_phase(P, PH, shm);
    if (PH + 1 < hi) grid_barrier((unsigned*)(P.ws + WS_BAR), (unsigned)(PH + 1 - lo) * gridDim.x);
  }
}

__global__ __launch_bounds__(NTHREADS, 2) void mega(Params P, int ph_lo, int ph_hi) {
  extern __shared__ __attribute__((aligned(16))) char shm[];
  tid_init();
  if (ph_hi - ph_lo > 1) cg::this_grid().sync();
#ifdef DIAGPH
  run_phase(P, DIAGPH, shm);
#else
  do_phase<0>(P, ph_lo, ph_hi, shm);
  do_phase<1>(P, ph_lo, ph_hi, shm);
  do_phase<2>(P, ph_lo, ph_hi, shm);
  do_phase<3>(P, ph_lo, ph_hi, shm);
  do_phase<4>(P, ph_lo, ph_hi, shm);
  do_phase<5>(P, ph_lo, ph_hi, shm);
  do_phase<6>(P, ph_lo, ph_hi, shm);
  do_phase<7>(P, ph_lo, ph_hi, shm);
  do_phase<8>(P, ph_lo, ph_hi, shm);
  do_phase<9>(P, ph_lo, ph_hi, shm);
  do_phase<10>(P, ph_lo, ph_hi, shm);
  do_phase<11>(P, ph_lo, ph_hi, shm);
  do_phase<12>(P, ph_lo, ph_hi, shm);
  do_phase<13>(P, ph_lo, ph_hi, shm);
  do_phase<14>(P, ph_lo, ph_hi, shm);
  do_phase<15>(P, ph_lo, ph_hi, shm);
  do_phase<16>(P, ph_lo, ph_hi, shm);
  do_phase<17>(P, ph_lo, ph_hi, shm);
  do_phase<18>(P, ph_lo, ph_hi, shm);
#endif
}

extern "C" void kernel_launch(void* const* d_in, const int* in_sizes, int n_in, void* d_out, int out_size, void* d_ws,
                              size_t ws_size, hipStream_t stream) {
  static int grid = 0;
  if (grid == 0) {
    int dev = 0, cus = 0, per_cu = 0;
    hipGetDevice(&dev);
    hipDeviceGetAttribute(&cus, hipDeviceAttributeMultiprocessorCount, dev);
    hipFuncSetAttribute((const void*)mega, hipFuncAttributeMaxDynamicSharedMemorySize, LDS_BYTES);
    hipOccupancyMaxActiveBlocksPerMultiprocessor(&per_cu, (const void*)mega, NTHREADS, LDS_BYTES);
    if (per_cu < 1) per_cu = 1;
    grid = cus * per_cu;
    if (ws_size < WS_END) fprintf(stderr, "workspace too small: %zu < %zu\n", ws_size, (size_t)WS_END);
  }
  Params p{};
  for (int i = 0; i < 40; ++i) p.in[i] = (const float*)d_in[i];
  p.out = (float*)d_out; p.ws = (char*)d_ws;
#if COOP
  hipMemsetAsync((char*)d_ws + WS_BAR, 0, 256, stream);
  int lo = 0, hi = NPHASES;
  void* args[] = {&p, &lo, &hi};
  hipError_t e = hipLaunchCooperativeKernel((const void*)mega, dim3(grid), dim3(NTHREADS), args, LDS_BYTES, stream);
  if (e != hipSuccess) fprintf(stderr, "cooperative launch failed: %s (grid %d)\n", hipGetErrorString(e), grid);
#else
  for (int ph = 0; ph < NPHASES; ++ph) hipLaunchKernelGGL(mega, dim3(grid), dim3(NTHREADS), LDS_BYTES, stream, p, ph, ph + 1);
#endif
}
```

```cpp
#include <hip/hip_runtime.h>
#include <hip/hip_bf16.h>
#include <hip/hip_cooperative_groups.h>
#include <cstdio>
namespace cg = cooperative_groups;

#ifndef PROBE_DUP
#define PROBE_DUP 0
#define PROBE_MIX 0
#define PROBE_GEMM 0
#endif
#ifndef COOP
#define COOP 1
#endif

typedef unsigned short bfr;
using bf16x8 = __attribute__((ext_vector_type(8))) short;
using s16x4  = __attribute__((ext_vector_type(4))) short;
using f32x4  = __attribute__((ext_vector_type(4))) float;
using f32x16 = __attribute__((ext_vector_type(16))) float;
#define DI __device__ __forceinline__

constexpr int NB = 32, S = 2048, D = 1024, NT = NB * S, NL = 2;
constexpr int INW = 2728, INP = 2816, DFF = 2816, PLE = 256;
constexpr int OQ = 0, OKV = 256, OKR = 384, OHY = 416, OSQ = 1184, OSK = 1440, OSV = 1568, OZ = 1696, OXBC = 1952, ODT = 2720;
constexpr float ALPHA = 1.4142135623730951f;
constexpr float LOG2E = 1.4426950408889634f;

constexpr size_t EW_IN = 2816ull * 1024, EW_UQ = 512ull * 256, EW_UKV = 512ull * 256, EW_OUT = 1024ull * 1024,
                 EW_G = 2816ull * 1024, EW_U = 2816ull * 1024, EW_D = 1024ull * 2816, EW_PP = 1024ull * 256, EW_PG = 1024ull * 1024;
constexpr size_t WO_IN = 0, WO_UQ = WO_IN + EW_IN, WO_UKV = WO_UQ + EW_UQ, WO_OUT = WO_UKV + EW_UKV, WO_G = WO_OUT + EW_OUT,
                 WO_U = WO_G + EW_G, WO_D = WO_U + EW_U, WO_PP = WO_D + EW_D, WO_PG = WO_PP + EW_PP, EW_LAYER = WO_PG + EW_PG;
constexpr size_t WS_W = 0;
constexpr size_t WS_KBUF = WS_W + NL * EW_LAYER * 2;
constexpr size_t WS_KF = WS_KBUF + 2ull * 2 * 256 * 4096 * 4;
constexpr size_t WS_ROPE = WS_KF + 2ull * 2 * 256 * 4096 * 8;
constexpr size_t WS_TW = WS_ROPE + 2048ull * 16 * 8;
constexpr size_t WS_HALO = WS_TW + 2048ull * 8;
constexpr size_t WS_HB = WS_HALO + 512ull * 2 * 2816 * 2;
constexpr size_t WS_U = WS_HB + (size_t)NT * 1024 * 2;
constexpr size_t WS_Y = WS_U + (size_t)NT * 2816 * 2;
constexpr size_t WS_Q = WS_Y + (size_t)NT * 512 * 2;
constexpr size_t WS_K = WS_Q + (size_t)NT * 384 * 2;
constexpr size_t WS_VT = WS_K + (size_t)NT * 384 * 2;
constexpr size_t WS_YN = WS_Q;
constexpr size_t WS_HYT = WS_VT + (size_t)NT * 256 * 2;
constexpr size_t WS_PB = WS_HYT;
constexpr size_t WS_PRE = WS_HYT + (size_t)NT * 256 * 2;
constexpr size_t WS_YSSD = WS_HYT + (size_t)NT * 768 * 2;
constexpr size_t WS_YH = WS_YSSD + 2ull * NT * 256 * 2;
constexpr size_t WS_BAR = WS_YH + (size_t)NT * 256 * 2;
constexpr size_t WS_END = WS_BAR + 256;

constexpr int LDS_BYTES = 147456;
constexpr int NTHREADS = 512;

struct Params {
  const float* in[40];
  float* out;
  char* ws;
};

typedef const float* const __attribute__((address_space(4)))* in_tab_t;
struct PX {
  in_tab_t in;
  float* out;
  char* ws;
};
__shared__ int s_wave_tab[64];
DI int hw_slot() { return (int)(__builtin_amdgcn_s_getreg((5 << 11) | (0 << 6) | 4) & 63u); }
DI void tid_init() {
  const int t = threadIdx.x;
  if ((t & 63) == 0) s_wave_tab[hw_slot()] = t >> 6;
  __syncthreads();
}
DI int tidx() {
  int w = s_wave_tab[hw_slot()];
  asm volatile("" : "+v"(w));
  w = __builtin_amdgcn_readfirstlane(w);
  int t = (w << 6) | (int)__builtin_amdgcn_mbcnt_hi(~0u, __builtin_amdgcn_mbcnt_lo(~0u, 0u));
  asm volatile("" : "+v"(t));
  return t;
}
DI const char* uni_ptr(const char* p) {
  const unsigned long long v = (unsigned long long)p;
  const unsigned lo = __builtin_amdgcn_readfirstlane((unsigned)v), hi = __builtin_amdgcn_readfirstlane((unsigned)(v >> 32));
  return (const char*)(((unsigned long long)hi << 32) | lo);
}
template <int M> DI float swz_xor(float v) { return __int_as_float(__builtin_amdgcn_ds_swizzle(__float_as_int(v), (M << 10) | 0x1f)); }
typedef __bf16 bf16x2_t __attribute__((ext_vector_type(2)));
DI bfr f2bf(float x) { return __builtin_bit_cast(bfr, (__bf16)x); }
DI float bf2f(bfr v) { return __uint_as_float(((unsigned)v) << 16); }
DI unsigned pack2(float a, float b) { bf16x2_t v = {(__bf16)a, (__bf16)b}; return __builtin_bit_cast(unsigned, v); }
DI float silu(float x) { return x * __builtin_amdgcn_rcpf(1.f + __expf(-x)); }
DI float sigmoidf(float x) { return __builtin_amdgcn_rcpf(1.f + __expf(-x)); }

constexpr int BM = 256, BK = 64, HALF = 128, HT = HALF * BK;
DI int lds_byte(int r, int c) {
  int st = (r >> 4) * 2 + (c >> 5), rr = r & 15, cc = c & 31, ob = rr * 64 + cc * 2;
  return st * 1024 + (ob ^ (((ob >> 9) & 1) << 5));
}
DI void stage_rc(int b, int& R, int& C) {
  int st = b / 1024, sb = b % 1024, swz = sb ^ (((sb >> 9) & 1) << 5);
  R = (st >> 1) * 16 + swz / 64; C = (st & 1) * 32 + (swz % 64) / 2;
}

typedef f32x4 acc_t[2][2][4][2];
constexpr int TST = 260;

template <int LDA, int LDB, class Epi, int SKIP = 0>
DI void gemm_unit(const bfr* __restrict__ A, const bfr* __restrict__ Bt, int K, int brow, int bcol, char* shmc, const Epi& epi) {
  bfr* shm = (bfr*)shmc;
#define SA(b, h) (shm + ((b) * 2 + (h)) * HT)
#define SB(b, h) (shm + (4 + (b) * 2 + (h)) * HT)
#define GL_LDS(gp, lp) __builtin_amdgcn_global_load_lds((const unsigned*)(gp), (__attribute__((address_space(3))) unsigned*)(lp), 16, 0, 0)
#define STAGE(P, BASE, LD, br, kt) do { const char* _sb = (const char*)(BASE) + ((long)(br) * (LD) + (kt) * BK) * 2; \
    const char* _sb2 = uni_ptr(_sb + 64 * (LD) * 2); \
    GL_LDS(_sb + voff_##LD, (char*)(P) + woff); \
    GL_LDS(_sb2 + voff_##LD, (char*)(P) + woff + 8192); } while (0)
#define LDA_(dst, b, h) for (int m = 0; m < 4; ++m) for (int k = 0; k < 2; ++k) \
    dst[m][k] = *reinterpret_cast<const bf16x8*>((char*)SA(b, h) + lds_byte(wr * 64 + m * 16 + fr, k * 32 + fq * 8))
#define LDB_(dst, b, h) for (int n = 0; n < 2; ++n) for (int k = 0; k < 2; ++k) \
    dst[n][k] = *reinterpret_cast<const bf16x8*>((char*)SB(b, h) + lds_byte(wc * 32 + n * 16 + fr, k * 32 + fq * 8))
#define MMA(ai, bj, At, Bt_) do { __builtin_amdgcn_s_setprio(1); \
    for (int m = 0; m < 4; ++m) for (int n = 0; n < 2; ++n) for (int k = 0; k < 2; ++k) \
      acc[ai][bj][m][n] = __builtin_amdgcn_mfma_f32_16x16x32_bf16(At[m][k], Bt_[n][k], acc[ai][bj][m][n], 0, 0, 0); \
    __builtin_amdgcn_s_setprio(0); } while (0)
#define WAIT_V(n) asm volatile("s_waitcnt vmcnt(" #n ")" ::: "memory")
#define WAIT_L(n) asm volatile("s_waitcnt lgkmcnt(" #n ")" ::: "memory")
#define BAR __builtin_amdgcn_s_barrier()
#define SCHED __builtin_amdgcn_sched_barrier(0)

  const int tid_u = tidx();
  const int wid = tid_u >> 6, lane = tid_u & 63, wr = wid >> 2, wc = wid & 3, fr = lane & 15, fq = lane >> 4;
  unsigned voff_LDA, voff_LDB;
  { int r_, c_; stage_rc(tid_u * 16, r_, c_); voff_LDA = (unsigned)(r_ * LDA + c_) * 2u; voff_LDB = (unsigned)(r_ * LDB + c_) * 2u; }
  const int woff = __builtin_amdgcn_readfirstlane(wid * 1024);
  acc_t acc = {};
  bf16x8 At[4][2], B0[2][2], B1[2][2];
  int nt = K / BK; asm volatile("" : "+s"(nt));
  STAGE(SB(0, 0), Bt, LDB, bcol, 0); STAGE(SA(0, 0), A, LDA, brow, 0);
  STAGE(SB(0, 1), Bt, LDB, bcol + HALF, 0); STAGE(SA(0, 1), A, LDA, brow + HALF, 0);
  if (wr == 1) BAR;
  WAIT_V(4); BAR;
  STAGE(SB(1, 0), Bt, LDB, bcol, 1); STAGE(SA(1, 0), A, LDA, brow, 1); STAGE(SB(1, 1), Bt, LDB, bcol + HALF, 1);
  WAIT_V(6); BAR;
#pragma unroll 1
  for (int t = 0; t < nt - 2; t += 2) {
    LDB_(B0, 0, 0); SCHED; LDA_(At, 0, 0); STAGE(SA(1, 1), A, LDA, brow + HALF, t + 1);
    WAIT_L(8); BAR; WAIT_L(0); MMA(0, 0, At, B0); BAR; SCHED;
    LDB_(B1, 0, 1); STAGE(SB(0, 0), Bt, LDB, bcol, t + 2);
    BAR; WAIT_L(0); MMA(0, 1, At, B1); BAR;
    LDA_(At, 0, 1); STAGE(SA(0, 0), A, LDA, brow, t + 2);
    BAR; WAIT_L(0); MMA(1, 0, At, B0); BAR; SCHED;
    STAGE(SB(0, 1), Bt, LDB, bcol + HALF, t + 2);
    WAIT_V(6); BAR; MMA(1, 1, At, B1); BAR;
    LDB_(B0, 1, 0); SCHED; LDA_(At, 1, 0); STAGE(SA(0, 1), A, LDA, brow + HALF, t + 2);
    WAIT_L(8); BAR; WAIT_L(0); MMA(0, 0, At, B0); BAR; SCHED;
    LDB_(B1, 1, 1); STAGE(SB(1, 0), Bt, LDB, bcol, t + 3);
    BAR; WAIT_L(0); MMA(0, 1, At, B1); BAR;
    LDA_(At, 1, 1); STAGE(SA(1, 0), A, LDA, brow, t + 3);
    BAR; WAIT_L(0); MMA(1, 0, At, B0); BAR; SCHED;
    STAGE(SB(1, 1), Bt, LDB, bcol + HALF, t + 3);
    WAIT_V(6); BAR; MMA(1, 1, At, B1); BAR;
  }
  { LDB_(B0, 0, 0); LDA_(At, 0, 0); STAGE(SA(1, 1), A, LDA, brow + HALF, nt - 1);
    BAR; WAIT_L(0); MMA(0, 0, At, B0); BAR;
    LDB_(B1, 0, 1); BAR; WAIT_L(0); MMA(0, 1, At, B1); BAR;
    LDA_(At, 0, 1); WAIT_V(4); BAR; WAIT_L(0); MMA(1, 0, At, B0); MMA(1, 1, At, B1); BAR; }
  { LDB_(B0, 1, 0); LDA_(At, 1, 0); WAIT_V(2); BAR; WAIT_L(0); MMA(0, 0, At, B0); BAR;
    LDB_(B1, 1, 1); WAIT_V(0); BAR; WAIT_L(0); MMA(0, 1, At, B1); BAR;
    LDA_(At, 1, 1); BAR; WAIT_L(0); MMA(1, 0, At, B0); MMA(1, 1, At, B1); BAR; }
  if (wr == 0) BAR;
  if (SKIP == 2) {
    float s = 0.f;
#pragma unroll
    for (int ai = 0; ai < 2; ++ai)
#pragma unroll
      for (int bj = 0; bj < 2; ++bj)
#pragma unroll
        for (int m = 0; m < 4; ++m)
#pragma unroll
          for (int n = 0; n < 2; ++n) s += acc[ai][bj][m][n][0] + acc[ai][bj][m][n][1] + acc[ai][bj][m][n][2] + acc[ai][bj][m][n][3];
    if (s == 123.456f) ((float*)shmc)[0] = s;
    __syncthreads();
    return;
  }
  float* tile = (float*)shmc;
  {
    int t2 = tid_u; asm volatile("" : "+v"(t2));
    const int lane2 = t2 & 63, wid2 = t2 >> 6;
    tile += ((wid2 >> 2) * 64 + (lane2 >> 4) * 4) * TST + (wid2 & 3) * 32 + (lane2 & 15);
  }
#pragma unroll
  for (int ai = 0; ai < 2; ++ai) {
    if (ai) __syncthreads();
#pragma unroll
    for (int bj = 0; bj < 2; ++bj)
#pragma unroll
      for (int m = 0; m < 4; ++m)
#pragma unroll
        for (int n = 0; n < 2; ++n)
#pragma unroll
          for (int j = 0; j < 4; ++j)
            tile[(m * 16 + j) * TST + bj * 128 + n * 16] = acc[ai][bj][m][n][j];
    __syncthreads();
    if (SKIP == 0) epi((float*)shmc, brow + ai * 128, bcol);
  }
  __syncthreads();
}

DI void unit_to_tile(int u, int nM, int nN, int& pm, int& pn) {
  const int nig = 8 * nN, gid = u / nig, fm = gid * 8, gsz = min(nM - fm, 8);
  pm = fm + ((u % nig) % gsz); pn = (u % nig) / gsz;
}

#define FOR_CHUNKS(ci) const int tid_e##ci = tidx(); _Pragma("unroll 1") for (int ci = 0; ci < 8; ++ci)
#define CHUNK_SETUP(ci) int tx_ = tid_e##ci; asm volatile("" : "+v"(tx_)); const int idx_ = ci * 512 + tx_; const int lr = idx_ >> 5, lc = (idx_ & 31) * 8; \
    const int row = r0 + lr, col = bcol + lc; float v[8]; \
    { const float4 a_ = *reinterpret_cast<const float4*>(tile + lr * TST + lc), b_ = *reinterpret_cast<const float4*>(tile + lr * TST + lc + 4); \
      v[0] = a_.x; v[1] = a_.y; v[2] = a_.z; v[3] = a_.w; v[4] = b_.x; v[5] = b_.y; v[6] = b_.z; v[7] = b_.w; }
DI uint4 pack8(const float* v) { uint4 o; o.x = pack2(v[0], v[1]); o.y = pack2(v[2], v[3]); o.z = pack2(v[4], v[5]); o.w = pack2(v[6], v[7]); return o; }
DI void unpack8(const uint4& u, float* f) {
  f[0] = __uint_as_float(u.x << 16); f[1] = __uint_as_float(u.x & 0xffff0000u); f[2] = __uint_as_float(u.y << 16); f[3] = __uint_as_float(u.y & 0xffff0000u);
  f[4] = __uint_as_float(u.z << 16); f[5] = __uint_as_float(u.z & 0xffff0000u); f[6] = __uint_as_float(u.w << 16); f[7] = __uint_as_float(u.w & 0xffff0000u);
}
DI void ld8f(const float* p, float* f) { const float4 a = *reinterpret_cast<const float4*>(p), b = *reinterpret_cast<const float4*>(p + 4);
  f[0] = a.x; f[1] = a.y; f[2] = a.z; f[3] = a.w; f[4] = b.x; f[5] = b.y; f[6] = b.z; f[7] = b.w; }

struct EpiStoreBf16 {
  bfr* C; int ldc;
  DI void operator()(float* tile, int r0, int bcol) const {
    FOR_CHUNKS(ci) { CHUNK_SETUP(ci); *reinterpret_cast<uint4*>(C + (long)row * ldc + col) = pack8(v); }
  }
};
struct EpiGate {
  bfr* G; bfr* halo;
  DI void operator()(float* tile, int r0, int bcol) const {
    FOR_CHUNKS(ci) { CHUNK_SETUP(ci); const uint4 pk = pack8(v);
      *reinterpret_cast<uint4*>(G + (long)row * DFF + col) = pk;
      if (lr == 0) *reinterpret_cast<uint4*>(halo + ((long)(row >> 7) * 2 + 0) * DFF + col) = pk;
      if (lr == 127) *reinterpret_cast<uint4*>(halo + ((long)(row >> 7) * 2 + 1) * DFF + col) = pk;
    }
  }
};
#define CH_LR(ci, tx) (((ci) * 512 + (tx)) >> 5)
#define CH_LC(ci, tx) ((((ci) * 512 + (tx)) & 31) * 8)
struct EpiUp {
  bfr* G; const bfr* halo; const float* cw; const float* cb;
  DI void operator()(float* tile, int r0, int bcol) const {
    const int tx = tidx();
    const int lc = (tx & 31) * 8, col = bcol + lc;
    float wm[8], wc[8], wp[8], wb[8];
    ld8f(cw + col, wm); ld8f(cw + DFF + col, wc); ld8f(cw + 2 * DFF + col, wp); ld8f(cb + col, wb);
#pragma unroll
    for (int c0 = 0; c0 < 8; c0 += 4) {
      uint4 q0[4], qm[4], qp[4];
#pragma unroll
      for (int k4 = 0; k4 < 4; ++k4) {
        const int lr = CH_LR(c0 + k4, tx), row = r0 + lr;
        const long idx = (long)row * DFF + col; const int t = row & (S - 1), hb = row >> 7;
        q0[k4] = *reinterpret_cast<const uint4*>(G + idx);
        qm[k4] = make_uint4(0, 0, 0, 0); qp[k4] = make_uint4(0, 0, 0, 0);
        if (t != 0) qm[k4] = lr == 0 ? *reinterpret_cast<const uint4*>(halo + ((long)(hb - 1) * 2 + 1) * DFF + col) : *reinterpret_cast<const uint4*>(G + idx - DFF);
        if (t != S - 1) qp[k4] = lr == 127 ? *reinterpret_cast<const uint4*>(halo + ((long)(hb + 1) * 2 + 0) * DFF + col) : *reinterpret_cast<const uint4*>(G + idx + DFF);
      }
#pragma unroll
      for (int k4 = 0; k4 < 4; ++k4) {
        const int lr = CH_LR(c0 + k4, tx);
        float v[8], g0[8], gm[8], gp[8];
        ld8f(tile + lr * TST + lc, v);
        unpack8(q0[k4], g0); unpack8(qm[k4], gm); unpack8(qp[k4], gp);
#pragma unroll
        for (int k = 0; k < 8; ++k) v[k] = silu(wb[k] + wm[k] * gm[k] + wc[k] * g0[k] + wp[k] * gp[k]) * v[k];
        *reinterpret_cast<uint4*>(tile + lr * TST + lc) = pack8(v);
      }
    }
    __syncthreads();
#pragma unroll
    for (int ci = 0; ci < 8; ++ci) {
      const int lr = CH_LR(ci, tx);
      *reinterpret_cast<uint4*>(G + (long)(r0 + lr) * DFF + col) = *reinterpret_cast<const uint4*>(tile + lr * TST + lc);
    }
  }
};
DI void row_stats_add(float* stats, int row, const float* v, int tx) {
  float s1 = 0.f, s2 = 0.f;
#pragma unroll
  for (int k = 0; k < 8; ++k) { s1 += v[k]; s2 += v[k] * v[k]; }
  s1 += swz_xor<16>(s1); s2 += swz_xor<16>(s2); s1 += swz_xor<8>(s1); s2 += swz_xor<8>(s2); s1 += swz_xor<4>(s1); s2 += swz_xor<4>(s2);
  s1 += swz_xor<2>(s1); s2 += swz_xor<2>(s2); s1 += swz_xor<1>(s1); s2 += swz_xor<1>(s2);
  if ((tx & 31) == 0) { float2* sp = reinterpret_cast<float2*>(stats) + (row & 255); float2 s = *sp; s.x += s1; s.y += s2; *sp = s; }
}
struct EpiResid {
  bfr* out; const bfr* hb; float* stats;
  DI void operator()(float* tile, int r0, int bcol) const {
    const int tx = tidx();
#pragma unroll
    for (int c0 = 0; c0 < 8; c0 += 4) {
      uint4 hq[4];
#pragma unroll
      for (int k4 = 0; k4 < 4; ++k4) hq[k4] = *reinterpret_cast<const uint4*>(hb + (long)(r0 + CH_LR(c0 + k4, tx)) * D + bcol + CH_LC(c0 + k4, tx));
#pragma unroll
      for (int k4 = 0; k4 < 4; ++k4) {
        const int lr = CH_LR(c0 + k4, tx), lc = CH_LC(c0 + k4, tx), row = r0 + lr;
        bfr* op = out + (long)row * D + bcol + lc;
        float v[8], o[8];
        ld8f(tile + lr * TST + lc, v); unpack8(hq[k4], o);
#pragma unroll
        for (int k = 0; k < 8; ++k) o[k] = ALPHA * o[k] + v[k];
        *reinterpret_cast<uint4*>(op) = pack8(o);
        row_stats_add(stats, row, o, tx);
      }
    }
  }
};
struct EpiPle {
  bfr* out; float* out32; const bfr* hb; const bfr* E; const float* bg; float* stats;
  DI void operator()(float* tile, int r0, int bcol) const {
    const int tx = tidx();
#pragma unroll
    for (int c0 = 0; c0 < 8; c0 += 4) {
      uint4 hq[4], eq[4];
#pragma unroll
      for (int k4 = 0; k4 < 4; ++k4) {
        const long idx = (long)(r0 + CH_LR(c0 + k4, tx)) * D + bcol + CH_LC(c0 + k4, tx);
        hq[k4] = *reinterpret_cast<const uint4*>(hb + idx);
        eq[k4] = *reinterpret_cast<const uint4*>(E + idx);
      }
#pragma unroll
      for (int k4 = 0; k4 < 4; ++k4) {
        const int lr = CH_LR(c0 + k4, tx), lc = CH_LC(c0 + k4, tx), row = r0 + lr, col = bcol + lc;
        bfr* op = out + (long)row * D + col;
        float v[8], o[8], e[8], bgv[8];
        ld8f(tile + lr * TST + lc, v); ld8f(bg + col, bgv); unpack8(eq[k4], e); unpack8(hq[k4], o);
#pragma unroll
        for (int k = 0; k < 8; ++k) o[k] = ALPHA * o[k] + e[k] * sigmoidf(v[k] + bgv[k]);
        if (out32) { float* o32 = out32 + (long)row * D + col; *reinterpret_cast<float4*>(o32) = make_float4(o[0], o[1], o[2], o[3]); *reinterpret_cast<float4*>(o32 + 4) = make_float4(o[4], o[5], o[6], o[7]); }
        else *reinterpret_cast<uint4*>(op) = pack8(o);
        row_stats_add(stats, row, o, tx);
      }
    }
  }
};
struct EpiQ {
  bfr* Q; const float* rs; const float2* rope;
  DI void operator()(float* tile, int r0, int bcol) const {
    FOR_CHUNKS(ci) { CHUNK_SETUP(ci);
      if (col < 384) {
        const int head = col / 96, d0 = col % 96; const float rstd = rs[row & 255]; const int b = row >> 11, t = row & (S - 1);
        if (d0 >= 64) {
          const bool lo = d0 < 80; const int jj = (d0 - (lo ? 64 : 80));
          float pw[8]; ld8f(tile + lr * TST + lc + (lo ? 16 : -16), pw);
#pragma unroll
          for (int k = 0; k < 8; ++k) { const float2 cs = rope[t * 16 + jj + k];
            v[k] = lo ? (v[k] * cs.x - pw[k] * cs.y) : (v[k] * cs.x + pw[k] * cs.y); }
        }
#pragma unroll
        for (int k = 0; k < 8; ++k) v[k] *= rstd;
        *reinterpret_cast<uint4*>(Q + (((long)(b * 4 + head)) * S + t) * 96 + d0) = pack8(v);
      }
    }
  }
};
struct EpiKV {
  bfr* Kf; bfr* VT; const float* rs;
  DI void operator()(float* tile, int r0, int bcol) const {
    FOR_CHUNKS(ci) { CHUNK_SETUP(ci);
      if ((col & 127) < 64) {
        const int head = col >> 7, d0 = col & 127; const float rstd = rs[row & 255]; const int b = row >> 11, t = row & (S - 1);
#pragma unroll
        for (int k = 0; k < 8; ++k) v[k] *= rstd;
        *reinterpret_cast<uint4*>(Kf + (((long)(b * 4 + head)) * S + t) * 96 + d0) = pack8(v);
      }
    }
    const int b = r0 >> 11, t0 = r0 & (S - 1);
#pragma unroll 1
    for (int it = tidx(); it < 2048; it += NTHREADS) {
      const int vc = it & 127, rc = it >> 7, lcol = (vc >> 6) * 128 + 64 + (vc & 63), lr0 = rc * 8;
      const int head = (bcol + lcol) >> 7, dd = vc & 63;
      float v[8];
#pragma unroll
      for (int k = 0; k < 8; ++k) v[k] = tile[(lr0 + k) * TST + lcol] * rs[(r0 + lr0 + k) & 255];
      *reinterpret_cast<uint4*>(VT + (((long)(b * 4 + head)) * 64 + dd) * S + t0 + lr0) = pack8(v);
    }
  }
};

#define MFMA32(a, b, c) __builtin_amdgcn_mfma_f32_32x32x16_bf16((a), (b), (c), 0, 0, 0)
template <int DQK, bool SWA>
DI void attn_item(const bfr* __restrict__ qb, long q_ld, const bfr* __restrict__ kb, long k_ld, const bfr* __restrict__ vb, long v_ld,
                  int q0, int key_lo, int key_hi, float scale_l2e, float slope_l2e, float sink_l2e,
                  bfr* __restrict__ outp, long out_ld, char* shm) {
  constexpr int KST = DQK + 8;
  constexpr int VST = 72;
  constexpr int NKK = DQK / 16;
  bfr* Ks = (bfr*)shm;
  bfr* Vt = Ks + 64 * KST;
  const int tid = tidx(), wid = tid >> 6, lane = tid & 63, r = lane & 31, h = lane >> 5;
  const int qrow = q0 + wid * 32 + r;
  bf16x8 qf[NKK];
#pragma unroll
  for (int kk = 0; kk < NKK; ++kk) qf[kk] = *reinterpret_cast<const bf16x8*>(qb + (long)qrow * q_ld + kk * 16 + h * 8);
  f32x16 o[2];
#pragma unroll
  for (int i = 0; i < 16; ++i) { o[0][i] = 0.f; o[1][i] = 0.f; }
  float mrun = SWA ? sink_l2e : -1e30f, lrun = SWA ? 1.f : 0.f;
  constexpr int KCH = DQK / 8;
  constexpr bool K2 = (64 * KCH > NTHREADS);
  uint4 pk0, pk1 = make_uint4(0, 0, 0, 0), pvv;
  const int vrow = tid >> 3, vch = tid & 7;
  const int kr0 = tid / KCH, kc0 = (tid % KCH) * 8, kr1 = (tid + NTHREADS) / KCH, kc1 = ((tid + NTHREADS) % KCH) * 8;
  const bool has1 = K2 && (tid + NTHREADS < 64 * KCH);
#define ATT_LOAD(kt_) do { \
    pk0 = *reinterpret_cast<const uint4*>(kb + (long)((kt_) + kr0) * k_ld + kc0); \
    if (has1) pk1 = *reinterpret_cast<const uint4*>(kb + (long)((kt_) + kr1) * k_ld + kc1); \
    pvv = SWA ? *reinterpret_cast<const uint4*>(vb + (long)((kt_) + vrow) * v_ld + vch * 8) \
              : *reinterpret_cast<const uint4*>(vb + (long)vrow * v_ld + (kt_) + vch * 8); } while (0)
  ATT_LOAD(key_lo);
  for (int kt = key_lo; kt < key_hi; kt += 64) {
    __syncthreads();
    *reinterpret_cast<uint4*>(Ks + kr0 * KST + kc0) = pk0;
    if (has1) *reinterpret_cast<uint4*>(Ks + kr1 * KST + kc1) = pk1;
    if (SWA) {
      bfr* vp = Vt + (vch * 8) * VST + vrow;
      vp[0 * VST] = (bfr)(pvv.x & 0xffffu); vp[1 * VST] = (bfr)(pvv.x >> 16);
      vp[2 * VST] = (bfr)(pvv.y & 0xffffu); vp[3 * VST] = (bfr)(pvv.y >> 16);
      vp[4 * VST] = (bfr)(pvv.z & 0xffffu); vp[5 * VST] = (bfr)(pvv.z >> 16);
      vp[6 * VST] = (bfr)(pvv.w & 0xffffu); vp[7 * VST] = (bfr)(pvv.w >> 16);
    } else {
      *reinterpret_cast<uint4*>(Vt + vrow * VST + vch * 8) = pvv;
    }
    if (kt + 64 < key_hi) ATT_LOAD(kt + 64);
    __syncthreads();
    const bool tile_live = !SWA || ((kt + 63 >= q0 + wid * 32 - 128) && (kt <= q0 + wid * 32 + 31 + 128));
    if (tile_live) {
    f32x16 s[2];
#pragma unroll
    for (int kh = 0; kh < 2; ++kh) {
#pragma unroll
      for (int i = 0; i < 16; ++i) s[kh][i] = 0.f;
#pragma unroll
      for (int kk = 0; kk < NKK; ++kk) {
        const bf16x8 a = *reinterpret_cast<const bf16x8*>(Ks + (kh * 32 + r) * KST + kk * 16 + h * 8);
        s[kh] = MFMA32(a, qf[kk], s[kh]);
      }
    }
    float mx = -1e30f;
    if (SWA) {
#pragma unroll
      for (int kh = 0; kh < 2; ++kh)
#pragma unroll
        for (int i = 0; i < 16; ++i) {
          const int kpos = kt + kh * 32 + (i & 3) + 8 * (i >> 2) + 4 * h;
          const int dist = abs(qrow - kpos);
          const float v = (dist <= 128) ? s[kh][i] * scale_l2e - slope_l2e * (float)dist : -1e30f;
          s[kh][i] = v; mx = fmaxf(mx, v);
        }
    } else {
#pragma unroll
      for (int kh = 0; kh < 2; ++kh)
#pragma unroll
        for (int i = 0; i < 16; ++i) mx = fmaxf(mx, s[kh][i]);
      mx *= scale_l2e;
    }
    mx = fmaxf(mx, __shfl_xor(mx, 32));
    const float mnew = fmaxf(mrun, mx);
    float ps = 0.f;
    if (SWA) {
#pragma unroll
      for (int kh = 0; kh < 2; ++kh)
#pragma unroll
        for (int i = 0; i < 16; ++i) { const float p = __builtin_amdgcn_exp2f(s[kh][i] - mnew); s[kh][i] = p; ps += p; }
    } else {
#pragma unroll
      for (int kh = 0; kh < 2; ++kh)
#pragma unroll
        for (int i = 0; i < 16; ++i) { const float p = __builtin_amdgcn_exp2f(fmaf(s[kh][i], scale_l2e, -mnew)); s[kh][i] = p; ps += p; }
    }
    ps += __shfl_xor(ps, 32);
    if (__any(mnew > mrun)) {
      const float corr = __builtin_amdgcn_exp2f(mrun - mnew);
      lrun *= corr;
#pragma unroll
      for (int i = 0; i < 16; ++i) { o[0][i] *= corr; o[1][i] *= corr; }
    }
    lrun += ps; mrun = mnew;
#pragma unroll
    for (int kh = 0; kh < 2; ++kh)
#pragma unroll
      for (int s2 = 0; s2 < 2; ++s2) {
        uint4 pbu;
        pbu.x = pack2(s[kh][8 * s2 + 0], s[kh][8 * s2 + 1]); pbu.y = pack2(s[kh][8 * s2 + 2], s[kh][8 * s2 + 3]);
        pbu.z = pack2(s[kh][8 * s2 + 4], s[kh][8 * s2 + 5]); pbu.w = pack2(s[kh][8 * s2 + 6], s[kh][8 * s2 + 7]);
        const bf16x8 pb = __builtin_bit_cast(bf16x8, pbu);
#pragma unroll
        for (int dt = 0; dt < 2; ++dt) {
          const bfr* vp = Vt + (dt * 32 + r) * VST + kh * 32 + 16 * s2 + 4 * h;
          const s16x4 lo = *reinterpret_cast<const s16x4*>(vp);
          const s16x4 hi = *reinterpret_cast<const s16x4*>(vp + 8);
          const bf16x8 a = __builtin_shufflevector(lo, hi, 0, 1, 2, 3, 4, 5, 6, 7);
          o[dt] = MFMA32(a, pb, o[dt]);
        }
      }
    }
  }
  const float inv = 1.f / lrun;
#pragma unroll
  for (int dt = 0; dt < 2; ++dt)
#pragma unroll
    for (int g = 0; g < 4; ++g) {
      uint2 pk; pk.x = pack2(o[dt][4 * g] * inv, o[dt][4 * g + 1] * inv); pk.y = pack2(o[dt][4 * g + 2] * inv, o[dt][4 * g + 3] * inv);
      *reinterpret_cast<uint2*>(outp + (long)qrow * out_ld + dt * 32 + 8 * g + 4 * h) = pk;
    }
}

DI float2 cmul(float2 a, float2 b) { return make_float2(a.x * b.x - a.y * b.y, a.x * b.y + a.y * b.x); }
DI float2 cmulc(float2 a, float2 b) { return make_float2(a.x * b.x + a.y * b.y, a.y * b.x - a.x * b.y); }
constexpr int FST_A = 272, FST_B = 17, FFT_LDS = 16 * FST_A;
DI int fpos(int n) { return (n >> 8) * FST_A + ((n >> 4) & 15) * FST_B + (n & 15); }
DI float2 twid(const float2* TW, int m) {
  const float2 w = TW[m & 2047];
  return (m & 2048) ? make_float2(-w.x, -w.y) : w;
}
DI void dft16_fwd(float2* v) {
  const float C8 = 0.92387953251128674f, S8 = 0.38268343236508977f, R2 = 0.70710678118654752f;
  const float2 w16[8] = {{1.f, 0.f}, {C8, -S8}, {R2, -R2}, {S8, -C8}, {0.f, -1.f}, {-S8, -C8}, {-R2, -R2}, {-C8, -S8}};
#pragma unroll
  for (int s = 0; s < 4; ++s) {
    const int half = 8 >> s;
#pragma unroll
    for (int j = 0; j < 8; ++j) {
      const int pos = j & (half - 1), i0 = ((j - pos) << 1) + pos, i1 = i0 + half;
      const float2 a = v[i0], b = v[i1];
      v[i0] = make_float2(a.x + b.x, a.y + b.y);
      v[i1] = cmul(make_float2(a.x - b.x, a.y - b.y), w16[pos << s]);
    }
  }
}
DI void dft16_inv(float2* v) {
  const float C8 = 0.92387953251128674f, S8 = 0.38268343236508977f, R2 = 0.70710678118654752f;
  const float2 w16[8] = {{1.f, 0.f}, {C8, -S8}, {R2, -R2}, {S8, -C8}, {0.f, -1.f}, {-S8, -C8}, {-R2, -R2}, {-C8, -S8}};
#pragma unroll
  for (int s = 3; s >= 0; --s) {
    const int half = 8 >> s;
#pragma unroll
    for (int j = 0; j < 8; ++j) {
      const int pos = j & (half - 1), i0 = ((j - pos) << 1) + pos, i1 = i0 + half;
      const float2 a = v[i0], b = cmulc(v[i1], w16[pos << s]);
      v[i0] = make_float2(a.x + b.x, a.y + b.y);
      v[i1] = make_float2(a.x - b.x, a.y - b.y);
    }
  }
}
DI int brev4(int i) { return ((i & 1) << 3) | ((i & 2) << 1) | ((i & 4) >> 1) | ((i & 8) >> 3); }
DI void fft_fwd(float2* X, const float2* TW, const int t) {
  float2 v[16];
  const int hi = t >> 4, lo = t & 15;
  {
    float2* p = X + hi * FST_B + lo;
#pragma unroll
    for (int i = 0; i < 16; ++i) v[i] = p[i * FST_A];
    dft16_fwd(v);
#pragma unroll
    for (int i = 0; i < 16; ++i) p[i * FST_A] = cmul(v[i], twid(TW, t * brev4(i)));
  }
  __syncthreads();
  {
    float2* p = X + hi * FST_A + lo;
#pragma unroll
    for (int i = 0; i < 16; ++i) v[i] = p[i * FST_B];
    dft16_fwd(v);
#pragma unroll
    for (int i = 0; i < 16; ++i) p[i * FST_B] = cmul(v[i], twid(TW, 16 * lo * brev4(i)));
  }
  __syncthreads();
  {
    float2* p = X + hi * FST_A + lo * FST_B;
#pragma unroll
    for (int i = 0; i < 16; ++i) v[i] = p[i];
    dft16_fwd(v);
#pragma unroll
    for (int i = 0; i < 16; ++i) p[i] = v[i];
  }
  __syncthreads();
}
DI void fft_inv(float2* X, const float2* TW, const int t) {
  float2 v[16];
  const int hi = t >> 4, lo = t & 15;
  {
    float2* p = X + hi * FST_A + lo * FST_B;
#pragma unroll
    for (int i = 0; i < 16; ++i) v[i] = p[i];
    dft16_inv(v);
#pragma unroll
    for (int i = 0; i < 16; ++i) p[i] = v[i];
  }
  __syncthreads();
  {
    float2* p = X + hi * FST_A + lo;
#pragma unroll
    for (int i = 0; i < 16; ++i) v[i] = cmulc(p[i * FST_B], twid(TW, 16 * lo * brev4(i)));
    dft16_inv(v);
#pragma unroll
    for (int i = 0; i < 16; ++i) p[i * FST_B] = v[i];
  }
  __syncthreads();
  {
    float2* p = X + hi * FST_B + lo;
#pragma unroll
    for (int i = 0; i < 16; ++i) v[i] = cmulc(p[i * FST_A], twid(TW, t * brev4(i)));
    dft16_inv(v);
#pragma unroll
    for (int i = 0; i < 16; ++i) p[i * FST_A] = v[i];
  }
  __syncthreads();
}

DI void transpose_convert(const float* src, int K, int N, bfr* dst, int Kp, int Np, const float* kscale, char* shm) {
  float* tile = (float*)shm;
  const int tk = Kp / 64, tn = Np / 64;
  const int tid = tidx();
#pragma unroll 1
  for (int it = blockIdx.x; it < tk * tn; it += gridDim.x) {
    const int k0 = (it % tk) * 64, n0 = (it / tk) * 64;
    __syncthreads();
    float4 v[2];
#pragma unroll
    for (int q = 0; q < 2; ++q) {
      const int idx = tid + q * NTHREADS, kk = idx >> 4, n4 = (idx & 15) * 4, k = k0 + kk, n = n0 + n4;
      v[q] = make_float4(0.f, 0.f, 0.f, 0.f);
      if (k < K && n < N) { v[q] = *reinterpret_cast<const float4*>(src + (long)k * N + n); if (kscale) { const float sc = kscale[k]; v[q].x *= sc; v[q].y *= sc; v[q].z *= sc; v[q].w *= sc; } }
    }
#pragma unroll
    for (int q = 0; q < 2; ++q) { const int idx = tid + q * NTHREADS; *reinterpret_cast<float4*>(tile + (idx >> 4) * 68 + (idx & 15) * 4) = v[q]; }
    __syncthreads();
#pragma unroll
    for (int q = 0; q < 2; ++q) {
      const int idx = tid + q * NTHREADS, nn = idx >> 4, k4 = (idx & 15) * 4;
      uint2 pk; pk.x = pack2(tile[k4 * 68 + nn], tile[(k4 + 1) * 68 + nn]); pk.y = pack2(tile[(k4 + 2) * 68 + nn], tile[(k4 + 3) * 68 + nn]);
      *reinterpret_cast<uint2*>(dst + (long)(n0 + nn) * Kp + k0 + k4) = pk;
    }
  }
}

DI void ln_rows(const float* src, float* dst32, bfr* dstb, const float* g, const float* bta) {
  const int wid = tidx() >> 6, lane = tidx() & 63;
#pragma unroll 1
  for (int row0 = (blockIdx.x * 8 + wid) * 2; row0 < NT; row0 += gridDim.x * 16) {
    float4 v[2][4];
#pragma unroll
    for (int q = 0; q < 2; ++q)
#pragma unroll
      for (int i = 0; i < 4; ++i) v[q][i] = reinterpret_cast<const float4*>(src + (long)(row0 + q) * D)[i * 64 + lane];
#pragma unroll
    for (int q = 0; q < 2; ++q) {
      const int row = row0 + q;
      float sum = 0.f;
#pragma unroll
      for (int i = 0; i < 4; ++i) sum += v[q][i].x + v[q][i].y + v[q][i].z + v[q][i].w;
#pragma unroll
      for (int o = 32; o >= 1; o >>= 1) sum += __shfl_xor(sum, o);
      const float mu = sum * (1.f / D);
      float sq = 0.f;
#pragma unroll
      for (int i = 0; i < 4; ++i) { v[q][i].x -= mu; v[q][i].y -= mu; v[q][i].z -= mu; v[q][i].w -= mu; sq += v[q][i].x * v[q][i].x + v[q][i].y * v[q][i].y + v[q][i].z * v[q][i].z + v[q][i].w * v[q][i].w; }
#pragma unroll
      for (int o = 32; o >= 1; o >>= 1) sq += __shfl_xor(sq, o);
      const float rstd = rsqrtf(sq * (1.f / D) + 1e-5f);
#pragma unroll
      for (int i = 0; i < 4; ++i) {
        const int c4 = i * 64 + lane;
        const float4 gg = reinterpret_cast<const float4*>(g)[c4], bb = reinterpret_cast<const float4*>(bta)[c4];
        float4 y; y.x = v[q][i].x * rstd * gg.x + bb.x; y.y = v[q][i].y * rstd * gg.y + bb.y; y.z = v[q][i].z * rstd * gg.z + bb.z; y.w = v[q][i].w * rstd * gg.w + bb.w;
        if (dst32) reinterpret_cast<float4*>(dst32 + (long)row * D)[c4] = y;
        uint2 pk; pk.x = pack2(y.x, y.y); pk.y = pack2(y.z, y.w);
        reinterpret_cast<uint2*>(dstb + (long)row * D)[c4] = pk;
      }
    }
  }
}

DI void phase_prep(const PX& P, char* shm) {
  char* ws = P.ws;
  for (int l = 0; l < NL; ++l) {
    bfr* W = (bfr*)(ws + WS_W) + (size_t)l * EW_LAYER;
    transpose_convert(P.in[4] + (size_t)l * 1024 * INW, 1024, INW, W + WO_IN, 1024, 2816, nullptr, shm);
    transpose_convert(P.in[7] + (size_t)l * 256 * 384, 256, 384, W + WO_UQ, 256, 512, P.in[5] + l * 256, shm);
    transpose_convert(P.in[8] + (size_t)l * 128 * 512, 128, 512, W + WO_UKV, 256, 512, P.in[6] + l * 128, shm);
    transpose_convert(P.in[25] + (size_t)l * 1024 * 1024, 1024, 1024, W + WO_OUT, 1024, 1024, P.in[24] + l * 1024, shm);
    transpose_convert(P.in[28] + (size_t)l * 1024 * DFF, 1024, DFF, W + WO_G, 1024, DFF, nullptr, shm);
    transpose_convert(P.in[29] + (size_t)l * 1024 * DFF, 1024, DFF, W + WO_U, 1024, DFF, nullptr, shm);
    transpose_convert(P.in[32] + (size_t)l * DFF * 1024, DFF, 1024, W + WO_D, DFF, 1024, nullptr, shm);
    transpose_convert(P.in[35] + (size_t)l * 256 * 1024, 256, 1024, W + WO_PP, 256, 1024, nullptr, shm);
    transpose_convert(P.in[36] + (size_t)l * 1024 * 1024, 1024, 1024, W + WO_PG, 1024, 1024, nullptr, shm);
  }
  __syncthreads();
  {
    float2* rope = (float2*)(ws + WS_ROPE);
    float2* tw = (float2*)(ws + WS_TW);
    for (int e = blockIdx.x * NTHREADS + tidx(); e < 2048 * 16 + 2048; e += gridDim.x * NTHREADS) {
      if (e < 2048 * 16) {
        const int t = e >> 4, j = e & 15;
        const float invf = exp2f(-(float)j * (13.287712379549449f / 16.0f));
        const float ang = (float)t * invf;
        float sn, cs; sincosf(ang, &sn, &cs);
        rope[e] = make_float2(cs, sn);
      } else {
        const int k = e - 2048 * 16;
        float sn, cs; sincospif((float)k * (1.0f / 2048.0f), &sn, &cs);
        tw[k] = make_float2(cs, -sn);
      }
    }
  }
  {
    float* sm = (float*)shm;
    float* kbuf = (float*)(ws + WS_KBUF);
    const int tid = tidx();
#pragma unroll 1
    for (int it = blockIdx.x; it < NL * (S / 4); it += gridDim.x) {
      const int l = it / (S / 4), tb = (it % (S / 4)) * 4;
      const float* w1 = P.in[11] + l * 33 * 64; const float* b1 = P.in[12] + l * 64; const float* fq = P.in[13] + l * 64;
      const float* w2 = P.in[14] + l * 64 * 64; const float* b2 = P.in[15] + l * 64; const float* w3 = P.in[16] + (size_t)l * 64 * 1024;
      __syncthreads();
      if (tid < 4 * 33) {
        const int q = tid / 33, i = tid % 33, t = tb + q;
        float f;
        if (i == 0) f = (float)t / 2047.0f;
        else {
          const int bi = (i - 1) & 15;
          const float band = 1e-4f + (float)bi * ((15.0f - 1e-4f) / 15.0f);
          const float ang = 6.283185307179586f * (float)t / 2048.0f;
          const float a = band * ang;
          f = (i <= 16) ? cosf(a) : -sinf(a);
        }
        sm[q * 64 + i] = f;
      }
      __syncthreads();
      if (tid < 256) {
        const int q = tid >> 6, j = tid & 63; float a = b1[j];
        for (int i = 0; i < 33; ++i) a += sm[q * 64 + i] * w1[i * 64 + j];
        sm[256 + q * 64 + j] = sinf(fq[j] * a);
      }
      __syncthreads();
      if (tid < 256) {
        const int q = tid >> 6, j = tid & 63; float a = b2[j];
        for (int i = 0; i < 64; ++i) a += sm[256 + q * 64 + i] * w2[i * 64 + j];
        sm[512 + q * 64 + j] = sinf(fq[j] * a);
      }
      __syncthreads();
#pragma unroll 1
      for (int oc = tid; oc < 1024; oc += NTHREADS) {
        float a0 = 0.f, a1 = 0.f, a2 = 0.f, a3 = 0.f;
#pragma unroll 8
        for (int i = 0; i < 64; ++i) { const float w = w3[i * 1024 + oc]; a0 += sm[512 + i] * w; a1 += sm[576 + i] * w; a2 += sm[640 + i] * w; a3 += sm[704 + i] * w; }
        const int o = oc >> 9, dir = (oc >> 8) & 1, c = oc & 255;
        const float mind = -3.0701134573253945f, maxd = -15.350567286626973f;
        const float delta = fabsf(mind + (float)c * ((maxd - mind) / 255.0f));
        float* kb = kbuf + ((size_t)((l * 2 + o) * 256 + c)) * 4096;
        const float av[4] = {a0, a1, a2, a3};
#pragma unroll
        for (int q = 0; q < 4; ++q) {
          const int t = tb + q;
          const float a = av[q] * expf(-((float)t / 2047.0f) * delta);
          if (dir == 0) kb[t] = a;
          else { if (t == 0) kb[2048] = 0.f; else kb[4096 - t] = a; }
        }
      }
    }
  }
  ln_rows(P.in[0], nullptr, (bfr*)(ws + WS_HB), P.in[2], P.in[3]);
}

DI void phase_gemm_in(const PX& P, int l, char* shm, int skip = 0) {
  const bfr* A = (const bfr*)(P.ws + WS_HB);
  const bfr* Bt = (const bfr*)(P.ws + WS_W) + (size_t)l * EW_LAYER + WO_IN;
  EpiStoreBf16 epi{(bfr*)(P.ws + WS_U), INP};
  for (int u = blockIdx.x; u < 256 * 11; u += gridDim.x) {
    int pm, pn; unit_to_tile(u, 256, 11, pm, pn);
#if PROBE_GEMM
    if (skip) gemm_unit<1024, 1024, EpiStoreBf16, PROBE_GEMM>(A, Bt, 1024, pm * 256, pn * 256, shm, epi);
    else
#endif
    gemm_unit<1024, 1024>(A, Bt, 1024, pm * 256, pn * 256, shm, epi);
  }
}

template <int NCOL>
DI void row_rstd(const bfr* Ucol, int brow, float* rs) {
  const int r = tidx() >> 1, hf = tidx() & 1;
  const unsigned uoff = (unsigned)(brow + r) * (unsigned)INP + (unsigned)(hf * NCOL);
  const bfr* up = Ucol + uoff;
  float ss = 0.f;
  uint4 q[NCOL / 8];
#pragma unroll
  for (int c = 0; c < NCOL / 8; ++c) q[c] = *reinterpret_cast<const uint4*>(up + c * 8);
#pragma unroll
  for (int c = 0; c < NCOL / 8; ++c) {
    float f[8]; unpack8(q[c], f);
#pragma unroll
    for (int e = 0; e < 8; ++e) ss += f[e] * f[e];
  }
  ss += __shfl_xor(ss, 1);
  if (hf == 0) rs[r] = rsqrtf(ss / (float)(2 * NCOL) + 1e-6f);
  __syncthreads();
}

DI void phase_premix(const PX& P, int l, char* shm) {
  char* ws = P.ws;
  const bfr* U = (const bfr*)(ws + WS_U);
  const bfr* W = (const bfr*)(ws + WS_W) + (size_t)l * EW_LAYER;
  float* rs = (float*)(shm + 135168);
  const float2* rope = (const float2*)(ws + WS_ROPE);
#ifndef SKIP_Q
  {
    EpiQ epi{(bfr*)(ws + WS_Q), rs, rope};
#pragma unroll 1
    for (int it = blockIdx.x; it < 512; it += gridDim.x) {
      const int pn = it & 1, brow = (it >> 1) * 256;
      row_rstd<128>(U + OQ, brow, rs);
      gemm_unit<INP, 256>(U + OQ, W + WO_UQ, 256, brow, pn * 256, shm, epi);
    }
  }
#endif
#ifndef SKIP_KV
  {
    EpiKV epi{(bfr*)(ws + WS_K), (bfr*)(ws + WS_VT), rs};
#pragma unroll 1
    for (int it = blockIdx.x; it < 512; it += gridDim.x) {
      const int pn = it & 1, brow = (it >> 1) * 256;
      row_rstd<64>(U + OKV, brow, rs);
      gemm_unit<INP, 256>(U + OKV, W + WO_UKV, 256, brow, pn * 256, shm, epi);
    }
  }
#endif
  {
    bfr* Kf = (bfr*)(ws + WS_K);
    for (long e = (long)blockIdx.x * NTHREADS + tidx(); e < (long)NT * 16; e += (long)gridDim.x * NTHREADS) {
      const int jj = (int)(e & 15); const long row = e >> 4; const int b = (int)(row >> 11), t = (int)(row & (S - 1));
      const float x1 = bf2f(U[row * INP + OKR + jj]), x2 = bf2f(U[row * INP + OKR + 16 + jj]);
      const float2 cs = rope[t * 16 + jj];
      const bfr o1 = f2bf(x1 * cs.x - x2 * cs.y), o2 = f2bf(x2 * cs.x + x1 * cs.y);
#pragma unroll
      for (int hh = 0; hh < 4; ++hh) {
        bfr* kp = Kf + (((long)(b * 4 + hh)) * S + t) * 96 + 64 + jj;
        kp[0] = o1; kp[16] = o2;
      }
    }
  }
  {
    bfr* tile = (bfr*)shm;
    bfr* HYT = (bfr*)(ws + WS_HYT);
    const float* cw = P.in[9] + l * 3 * 768; const float* cbias = P.in[10] + l * 768;
    const int tid = tidx();
#pragma unroll 1
    for (int it = blockIdx.x; it < 1024; it += gridDim.x) {
      const int b = it >> 5, t0 = (it & 31) * 64;
      __syncthreads();
#pragma unroll 1
      for (int e0 = tid; e0 < 96 * 64; e0 += 4 * NTHREADS) {
        uint4 q0[4], qm[4], qp[4];
#pragma unroll
        for (int i = 0; i < 4; ++i) {
          const int e = e0 + i * NTHREADS, c8 = e % 96, tl = e / 96, t = t0 + tl;
          const bfr* ub = U + ((long)b * S + t) * INP + OHY + c8 * 8;
          q0[i] = *reinterpret_cast<const uint4*>(ub);
          qm[i] = make_uint4(0, 0, 0, 0); qp[i] = make_uint4(0, 0, 0, 0);
          if (t > 0) qm[i] = *reinterpret_cast<const uint4*>(ub - INP);
          if (t < S - 1) qp[i] = *reinterpret_cast<const uint4*>(ub + INP);
        }
#pragma unroll
        for (int i = 0; i < 4; ++i) {
          const int e = e0 + i * NTHREADS, c8 = e % 96, tl = e / 96, c = c8 * 8;
          float u0[8], um[8], up[8], w[8], a[8];
          unpack8(q0[i], u0); unpack8(qm[i], um); unpack8(qp[i], up);
          ld8f(cbias + c, a);
          ld8f(cw + c, w);
#pragma unroll
          for (int j = 0; j < 8; ++j) a[j] += w[j] * um[j];
          ld8f(cw + 768 + c, w);
#pragma unroll
          for (int j = 0; j < 8; ++j) a[j] += w[j] * u0[j];
          ld8f(cw + 1536 + c, w);
          const int tr = (tl + 2 * c8) & 63;
#pragma unroll
          for (int j = 0; j < 8; ++j) tile[(c + j) * 66 + tr] = f2bf(a[j] + w[j] * up[j]);
        }
      }
      __syncthreads();
#pragma unroll 1
      for (int e = tid; e < 768 * 8; e += NTHREADS) {
        const int c = e >> 3, ch = e & 7, rot = c >> 3;
        const unsigned* tp = reinterpret_cast<const unsigned*>(tile + c * 66);
        uint4 v; v.x = tp[(ch * 4 + rot) & 31]; v.y = tp[(ch * 4 + 1 + rot) & 31]; v.z = tp[(ch * 4 + 2 + rot) & 31]; v.w = tp[(ch * 4 + 3 + rot) & 31];
        *reinterpret_cast<uint4*>(HYT + ((long)(b * 768 + c)) * S + t0 + ch * 8) = v;
      }
    }
  }
  if (l == 0) {
    const int tid = tidx(), hw = tid >> 8, t = tid & 255;
    float2* X = (float2*)shm + hw * FFT_LDS; float2* TW = (float2*)(shm + 2 * FFT_LDS * 8);
    const float* kbuf = (const float*)(ws + WS_KBUF);
    float2* KF = (float2*)(ws + WS_KF);
    const float2* twg = (const float2*)(ws + WS_TW);
    for (int it0 = blockIdx.x * 2; it0 < 1024; it0 += gridDim.x * 2) {
      const int it = it0 + hw;
      __syncthreads();
      for (int e = tid; e < 2048; e += NTHREADS) TW[e] = twg[e];
      for (int e = t; e < 4096; e += 256) X[fpos(e)] = make_float2(kbuf[(size_t)it * 4096 + e], 0.f);
      __syncthreads();
      fft_fwd(X, TW, t);
      for (int e = t; e < 4096; e += 256) { const float2 v = X[fpos(e)]; KF[(size_t)it * 4096 + e] = make_float2(v.x * (1.f / 4096.f), v.y * (1.f / 4096.f)); }
    }
  }
}

DI void ssd_item(const PX& P, int l, int item, char* shm) {
  constexpr int ST = 136;
  const bfr* U = (const bfr*)(P.ws + WS_U);
  bfr* YS = (bfr*)(P.ws + WS_YSSD);
  const int b = item >> 3, dir = (item >> 2) & 1, hd = item & 3, g = hd >> 1;
  const int tid = tidx(), wid = tid >> 6, lane = tid & 63, r = lane & 31, h = lane >> 5;
  const float* cw = P.in[19] + l * 3 * 768; const float* cbias = P.in[20] + l * 768;
  const float dtb = P.in[21][l * 8 + dir * 4 + hd];
  const float Acoef = -__expf(P.in[22][l * 8 + dir * 4 + hd]);
  bfr* Cs = (bfr*)shm;
  bfr* Bs = Cs + 128 * ST;
  bfr* BTd = Bs + 128 * ST;
  bfr* XT = BTd + 128 * ST;
  bfr* Rb = XT + 64 * ST;
  float* acs = (float*)(Rb + 64 * ST);
  float* dts = acs + 128;
  f32x16 racc;
#pragma unroll
  for (int i = 0; i < 16; ++i) racc[i] = 0.f;
  for (int e = tid; e < 64 * ST / 2; e += NTHREADS) reinterpret_cast<unsigned*>(Rb)[e] = 0u;
  float xr_next[2] = {0.f, 0.f};
  if (wid == 0) {
#pragma unroll
    for (int q = 0; q < 2; ++q) {
      const int k = lane * 2 + q, t = dir == 0 ? k : S - 1 - k;
      xr_next[q] = bf2f(U[((long)b * S + t) * INP + ODT + dir * 4 + hd]);
    }
  }
#pragma unroll 1
  for (int ci = 0; ci < 16; ++ci) {
    __syncthreads();
    if (wid == 0) {
      float a2[2], d2[2];
#pragma unroll
      for (int q = 0; q < 2; ++q) {
        const float xr = xr_next[q] + dtb;
        d2[q] = xr > 20.f ? xr : log1pf(__expf(xr));
        a2[q] = d2[q] * Acoef;
      }
      if (ci + 1 < 16) {
#pragma unroll
        for (int q = 0; q < 2; ++q) {
          const int k = lane * 2 + q, step = (ci + 1) * 128 + k, t = dir == 0 ? step : S - 1 - step;
          xr_next[q] = bf2f(U[((long)b * S + t) * INP + ODT + dir * 4 + hd]);
        }
      }
      const float pairsum = a2[0] + a2[1];
      float sc = pairsum;
      int lane_o = lane; asm volatile("" : "+v"(lane_o));
#pragma unroll
      for (int o = 1; o < 64; o <<= 1) { const float v = __shfl_up(sc, o); sc += (lane_o >= o) ? v : 0.f; }
      acs[lane * 2] = sc - a2[1]; acs[lane * 2 + 1] = sc;
      dts[lane * 2] = d2[0]; dts[lane * 2 + 1] = d2[1];
    }
    __syncthreads();
    const float atot = acs[127];
#pragma unroll 1
    for (int i0 = 0; i0 < 10; i0 += 5) {
      uint4 q0[5], qm[5], qp[5];
#pragma unroll
      for (int i = 0; i < 5; ++i) {
        const int it = tid + (i0 + i) * NTHREADS, k = it / 40, cc8 = it % 40;
        const int step = ci * 128 + k, t = dir == 0 ? step : S - 1 - step;
        const int col = cc8 < 8 ? hd * 64 + cc8 * 8 : (cc8 < 24 ? 256 + g * 128 + (cc8 - 8) * 8 : 512 + g * 128 + (cc8 - 24) * 8);
        const bfr* ub = U + ((long)b * S + t) * INP + OXBC + col;
        q0[i] = *reinterpret_cast<const uint4*>(ub);
        qm[i] = make_uint4(0, 0, 0, 0); qp[i] = make_uint4(0, 0, 0, 0);
        if (t > 0) qm[i] = *reinterpret_cast<const uint4*>(ub - INP);
        if (t < S - 1) qp[i] = *reinterpret_cast<const uint4*>(ub + INP);
      }
#pragma unroll
      for (int i = 0; i < 5; ++i) {
        const int it = tid + (i0 + i) * NTHREADS, k = it / 40, cc8 = it % 40;
        const int col = cc8 < 8 ? hd * 64 + cc8 * 8 : (cc8 < 24 ? 256 + g * 128 + (cc8 - 8) * 8 : 512 + g * 128 + (cc8 - 24) * 8);
        float u0[8], um[8], up[8], w[8], a[8];
        unpack8(q0[i], u0); unpack8(qm[i], um); unpack8(qp[i], up);
        ld8f(cbias + col, a);
        ld8f(cw + col, w);
#pragma unroll
        for (int j = 0; j < 8; ++j) a[j] += w[j] * um[j];
        ld8f(cw + 768 + col, w);
#pragma unroll
        for (int j = 0; j < 8; ++j) a[j] += w[j] * u0[j];
        ld8f(cw + 1536 + col, w);
#pragma unroll
        for (int j = 0; j < 8; ++j) a[j] = silu(a[j] + w[j] * up[j]);
        if (cc8 < 8) {
          const float dtk = dts[k];
#pragma unroll
          for (int j = 0; j < 8; ++j) XT[(cc8 * 8 + j) * ST + k] = f2bf(a[j] * dtk);
        } else if (cc8 < 24) {
          const int n0 = (cc8 - 8) * 8;
          *reinterpret_cast<uint4*>(Bs + k * ST + n0) = pack8(a);
          const float dec = __expf(atot - acs[k]);
#pragma unroll
          for (int j = 0; j < 8; ++j) BTd[(n0 + j) * ST + k] = f2bf(a[j] * dec);
        } else {
          *reinterpret_cast<uint4*>(Cs + k * ST + (cc8 - 24) * 8) = pack8(a);
        }
      }
    }
    __syncthreads();
    const int ti = wid >> 1;
    f32x16 cb[2];
#pragma unroll
    for (int q = 0; q < 2; ++q) {
      const int si = (wid & 1) * 2 + q;
#pragma unroll
      for (int i = 0; i < 16; ++i) cb[q][i] = 0.f;
      if (si <= ti) {
#pragma unroll
        for (int kk = 0; kk < 8; ++kk) {
          const bf16x8 av = *reinterpret_cast<const bf16x8*>(Cs + (32 * ti + r) * ST + kk * 16 + h * 8);
          const bf16x8 bv = *reinterpret_cast<const bf16x8*>(Bs + (32 * si + r) * ST + kk * 16 + h * 8);
          cb[q] = MFMA32(av, bv, cb[q]);
        }
      }
    }
    __syncthreads();
#pragma unroll
    for (int q = 0; q < 2; ++q) {
      const int si = (wid & 1) * 2 + q; int s = 32 * si + r; asm volatile("" : "+v"(s));
      const float as = acs[s];
#pragma unroll
      for (int i = 0; i < 16; ++i) {
        const int t = 32 * ti + (i & 3) + 8 * (i >> 2) + 4 * h;
        const float v = (s <= t) ? cb[q][i] * __expf(acs[t] - as) : 0.f;
        Bs[t * ST + s] = f2bf(v);
      }
    }
    __syncthreads();
    {
      const int pi = wid & 1;
      f32x16 y1, y2;
#pragma unroll
      for (int i = 0; i < 16; ++i) { y1[i] = 0.f; y2[i] = 0.f; }
#pragma unroll
      for (int kk = 0; kk < 8; ++kk) {
        const bf16x8 xv = *reinterpret_cast<const bf16x8*>(XT + (32 * pi + r) * ST + kk * 16 + h * 8);
        if (kk * 16 < 32 * ti + 32) {
          const bf16x8 mv = *reinterpret_cast<const bf16x8*>(Bs + (32 * ti + r) * ST + kk * 16 + h * 8);
          y1 = MFMA32(mv, xv, y1);
        }
        const bf16x8 cv = *reinterpret_cast<const bf16x8*>(Cs + (32 * ti + r) * ST + kk * 16 + h * 8);
        const bf16x8 rv = *reinterpret_cast<const bf16x8*>(Rb + (32 * pi + r) * ST + kk * 16 + h * 8);
        y2 = MFMA32(cv, rv, y2);
      }
#pragma unroll
      for (int i = 0; i < 16; ++i) {
        const int k = 32 * ti + (i & 3) + 8 * (i >> 2) + 4 * h;
        const int step = ci * 128 + k, t = dir == 0 ? step : S - 1 - step;
        const float y = y1[i] + __expf(acs[k]) * y2[i];
        YS[((size_t)dir * NT + (size_t)b * S + t) * 256 + hd * 64 + 32 * pi + r] = f2bf(y);
      }
    }
    {
      const int pi = wid >> 2, ni = wid & 3;
      const float ed = __expf(atot);
#pragma unroll
      for (int i = 0; i < 16; ++i) racc[i] *= ed;
#pragma unroll
      for (int kk = 0; kk < 8; ++kk) {
        const bf16x8 xv = *reinterpret_cast<const bf16x8*>(XT + (32 * pi + r) * ST + kk * 16 + h * 8);
        const bf16x8 bv = *reinterpret_cast<const bf16x8*>(BTd + (32 * ni + r) * ST + kk * 16 + h * 8);
        racc = MFMA32(xv, bv, racc);
      }
      __syncthreads();
#pragma unroll
      for (int i = 0; i < 16; ++i) Rb[(32 * pi + (i & 3) + 8 * (i >> 2) + 4 * h) * ST + 32 * ni + r] = f2bf(racc[i]);
    }
  }
}

DI void hyena_item(const PX& P, int l, int item0, char* shm) {
  const int tid = tidx(), hw = tid >> 8, t = tid & 255;
  const int item = item0 + hw;
  const int c = item >> 4, bp = item & 15, b0 = bp * 2, b1 = b0 + 1;
  float2* X = (float2*)shm + hw * FFT_LDS;
  float2* TW = (float2*)(shm + 2 * FFT_LDS * 8);
  float2* Z1 = TW + 2048 + hw * 2048;
  const bfr* HYT = (const bfr*)(P.ws + WS_HYT);
  const float2* twg = (const float2*)(P.ws + WS_TW);
  const float2* KF0 = (const float2*)(P.ws + WS_KF) + ((size_t)((l * 2 + 0) * 256 + c)) * 4096;
  const float2* KF1 = (const float2*)(P.ws + WS_KF) + ((size_t)((l * 2 + 1) * 256 + c)) * 4096;
  const float bias0 = P.in[17][(l * 2 + 0) * 256 + c], bias1 = P.in[17][(l * 2 + 1) * 256 + c];
  const bfr* v0 = HYT + ((size_t)(b0 * 768 + c)) * S; const bfr* v1 = HYT + ((size_t)(b1 * 768 + c)) * S;
  const bfr* x10 = v0 + 256 * S; const bfr* x11 = v1 + 256 * S;
  const bfr* x20 = v0 + 512 * S; const bfr* x21 = v1 + 512 * S;
  bfr* yo0 = (bfr*)(P.ws + WS_YH) + ((size_t)(b0 * 256 + c)) * S; bfr* yo1 = (bfr*)(P.ws + WS_YH) + ((size_t)(b1 * 256 + c)) * S;
  __syncthreads();
  for (int e = tid; e < 2048; e += NTHREADS) TW[e] = twg[e];
  {
    float a[8], b[8];
    unpack8(*reinterpret_cast<const uint4*>(v0 + t * 8), a); unpack8(*reinterpret_cast<const uint4*>(v1 + t * 8), b);
#pragma unroll
    for (int k = 0; k < 8; ++k) { X[fpos(t * 8 + k)] = make_float2(a[k], b[k]); X[fpos(2048 + t * 8 + k)] = make_float2(0.f, 0.f); }
  }
  __syncthreads();
  fft_fwd(X, TW, t);
  { float2 kf[16];
#pragma unroll
    for (int i = 0; i < 16; ++i) kf[i] = KF0[t + i * 256];
#pragma unroll
    for (int i = 0; i < 16; ++i) { const int p = fpos(t + i * 256); X[p] = cmul(X[p], kf[i]); } }
  __syncthreads();
  fft_inv(X, TW, t);
  {
    float a[8], b[8], g0[8], g1[8];
    unpack8(*reinterpret_cast<const uint4*>(v0 + t * 8), a); unpack8(*reinterpret_cast<const uint4*>(v1 + t * 8), b);
    unpack8(*reinterpret_cast<const uint4*>(x10 + t * 8), g0); unpack8(*reinterpret_cast<const uint4*>(x11 + t * 8), g1);
    float2 z[8];
#pragma unroll
    for (int k = 0; k < 8; ++k) { const float2 y = X[fpos(t * 8 + k)]; z[k] = make_float2(g0[k] * (y.x + bias0 * a[k]), g1[k] * (y.y + bias0 * b[k])); }
    __syncthreads();
#pragma unroll
    for (int k = 0; k < 8; ++k) { Z1[t * 8 + k] = z[k]; X[fpos(t * 8 + k)] = z[k]; X[fpos(2048 + t * 8 + k)] = make_float2(0.f, 0.f); }
  }
  __syncthreads();
  fft_fwd(X, TW, t);
  { float2 kf[16];
#pragma unroll
    for (int i = 0; i < 16; ++i) kf[i] = KF1[t + i * 256];
#pragma unroll
    for (int i = 0; i < 16; ++i) { const int p = fpos(t + i * 256); X[p] = cmul(X[p], kf[i]); } }
  __syncthreads();
  fft_inv(X, TW, t);
  {
    float g0[8], g1[8], o0[8], o1[8];
    unpack8(*reinterpret_cast<const uint4*>(x20 + t * 8), g0); unpack8(*reinterpret_cast<const uint4*>(x21 + t * 8), g1);
#pragma unroll
    for (int k = 0; k < 8; ++k) { const float2 y = X[fpos(t * 8 + k)], z1 = Z1[t * 8 + k]; o0[k] = g0[k] * (y.x + bias1 * z1.x); o1[k] = g1[k] * (y.y + bias1 * z1.y); }
    *reinterpret_cast<uint4*>(yo0 + t * 8) = pack8(o0); *reinterpret_cast<uint4*>(yo1 + t * 8) = pack8(o1);
  }
}

DI void phase_mix(const PX& P, int l, char* shm) {
  char* ws = P.ws;
  for (int rep = 0; rep < ((PROBE_MIX & 1) ? 2 : 1); ++rep)
  for (int it = blockIdx.x; it < 256; it += gridDim.x) ssd_item(P, l, it, shm);
  {
    const float sc = 0.10206207261596575f * LOG2E;
    for (int it = blockIdx.x; it < 1024; it += gridDim.x) {
      const int qblk = it & 7, bh = it >> 3, b = bh >> 2, hh = bh & 3;
      const bfr* q = (const bfr*)(ws + WS_Q) + (size_t)bh * S * 96;
      const bfr* k = (const bfr*)(ws + WS_K) + (size_t)bh * S * 96;
      const bfr* vt = (const bfr*)(ws + WS_VT) + (size_t)bh * 64 * S;
      bfr* o = (bfr*)(ws + WS_Y) + (size_t)b * S * 512 + hh * 64;
      attn_item<96, false>(q, 96, k, 96, vt, S, qblk * 256, 0, S, sc, 0.f, 0.f, o, 512, shm);
    }
  }
  {
    const bfr* U = (const bfr*)(ws + WS_U);
    for (int it = blockIdx.x; it < 1024; it += gridDim.x) {
      const int qblk = it & 7, bh = it >> 3, b = bh >> 2, hh = bh & 3, kvh = hh >> 1;
      const bfr* q = U + (size_t)b * S * INP + OSQ + hh * 64;
      const bfr* k = U + (size_t)b * S * INP + OSK + kvh * 64;
      const bfr* v = U + (size_t)b * S * INP + OSV + kvh * 64;
      bfr* o = (bfr*)(ws + WS_Y) + (size_t)b * S * 512 + 256 + hh * 64;
      const int q0 = qblk * 256, klo = max(q0 - 128, 0), khi = min(q0 + 256 + 128, S);
      const float slope = exp2f(-2.f * (float)(hh + 1));
      attn_item<64, true>(q, INP, k, INP, v, INP, q0, klo, khi, 0.125f * LOG2E, slope * LOG2E, P.in[18][l * 4 + hh] * LOG2E, o, 512, shm);
    }
  }
  for (int rep = 0; rep < ((PROBE_MIX & 8) ? 2 : 1); ++rep)
  for (int it = blockIdx.x * 2; it < 4096; it += gridDim.x * 2) hyena_item(P, l, it, shm);
}

DI void norm_store(float* vals, bfr* op) {
  float ss = 0.f;
#pragma unroll
  for (int k = 0; k < 16; ++k) ss += vals[k] * vals[k];
  ss += swz_xor<1>(ss); ss += swz_xor<2>(ss); ss += swz_xor<4>(ss); ss += swz_xor<8>(ss);
  const float rstd = rsqrtf(ss * (1.f / 256.f) + 1e-6f);
#pragma unroll
  for (int k = 0; k < 16; ++k) vals[k] *= rstd;
  *reinterpret_cast<uint4*>(op) = pack8(vals); *reinterpret_cast<uint4*>(op + 8) = pack8(vals + 8);
}

DI void phase_norm(const PX& P, int l, char* shm) {
  char* ws = P.ws;
  const bfr* U = (const bfr*)(ws + WS_U);
  const bfr* Y = (const bfr*)(ws + WS_Y);
  const bfr* YH = (const bfr*)(ws + WS_YH);
  const bfr* YS = (const bfr*)(ws + WS_YSSD);
  bfr* YN = (bfr*)(ws + WS_YN);
  bfr* hy = (bfr*)shm;
  const float* cw = P.in[19] + l * 3 * 768; const float* cbias = P.in[20] + l * 768;
  const int tid = tidx(), wid = tid >> 6, lane = tid & 63;
  const int grp = wid & 3, tsub = (wid >> 2) * 32, tk = lane >> 4, c16 = (lane & 15) * 16;
#pragma unroll 1
  for (int it = blockIdx.x; it < 1024; it += gridDim.x) {
    const int b = it >> 5, t0 = (it & 31) * 64;
    __syncthreads();
    for (int e = tid; e < 2048; e += NTHREADS) {
      const int c = e >> 3, ch = e & 7, rot = c >> 4;
      const uint4 v = *reinterpret_cast<const uint4*>(YH + ((size_t)(b * 256 + c)) * S + t0 + ch * 8);
      unsigned* tp = reinterpret_cast<unsigned*>(hy + c * 66);
      tp[(ch * 4 + rot) & 31] = v.x; tp[(ch * 4 + 1 + rot) & 31] = v.y; tp[(ch * 4 + 2 + rot) & 31] = v.z; tp[(ch * 4 + 3 + rot) & 31] = v.w;
    }
    __syncthreads();
    if (grp == 0 || grp == 2) {
      uint4 qa[8], qb[8];
#pragma unroll
      for (int i = 0; i < 8; ++i) {
        const long row = (long)b * S + t0 + tsub + i * 4 + tk;
        const bfr* yp = Y + row * 512 + (grp == 0 ? 0 : 256) + c16;
        qa[i] = *reinterpret_cast<const uint4*>(yp); qb[i] = *reinterpret_cast<const uint4*>(yp + 8);
      }
#pragma unroll
      for (int i = 0; i < 8; ++i) {
        const long row = (long)b * S + t0 + tsub + i * 4 + tk;
        float vals[16];
        unpack8(qa[i], vals); unpack8(qb[i], vals + 8);
        norm_store(vals, YN + row * 1024 + grp * 256 + c16);
      }
    } else if (grp == 1) {
#pragma unroll 2
      for (int i = 0; i < 8; ++i) {
        const int tl = tsub + i * 4 + tk; const long row = (long)b * S + t0 + tl;
        const int tr = (tl + 2 * (lane & 15)) & 63;
        float vals[16];
#pragma unroll
        for (int k = 0; k < 16; ++k) vals[k] = bf2f(hy[(c16 + k) * 66 + tr]);
        norm_store(vals, YN + row * 1024 + 256 + c16);
      }
    } else {
      const int hd = c16 >> 6;
      const float dsum = P.in[23][l * 8 + hd] + P.in[23][l * 8 + 4 + hd];
#pragma unroll 1
      for (int i = 0; i < 8; ++i) {
        const int tl = tsub + i * 4 + tk, t = t0 + tl; const long row = (long)b * S + t;
        const bfr* ub = U + row * INP + OXBC + c16;
        uint4 q0[2], qm[2], qp[2], qf[2], qbk[2], qz[2];
#pragma unroll
        for (int hf = 0; hf < 2; ++hf) {
          q0[hf] = *reinterpret_cast<const uint4*>(ub + hf * 8);
          qm[hf] = make_uint4(0, 0, 0, 0); qp[hf] = make_uint4(0, 0, 0, 0);
          if (t > 0) qm[hf] = *reinterpret_cast<const uint4*>(ub - INP + hf * 8);
          if (t < S - 1) qp[hf] = *reinterpret_cast<const uint4*>(ub + INP + hf * 8);
          qf[hf] = *reinterpret_cast<const uint4*>(YS + (size_t)row * 256 + c16 + hf * 8);
          qbk[hf] = *reinterpret_cast<const uint4*>(YS + ((size_t)NT + row) * 256 + c16 + hf * 8);
          qz[hf] = *reinterpret_cast<const uint4*>(U + row * INP + OZ + c16 + hf * 8);
        }
        float vals[16];
#pragma unroll
        for (int hf = 0; hf < 2; ++hf) {
          float u0[8], um[8], up[8], w[8], a[8];
          unpack8(q0[hf], u0); unpack8(qm[hf], um); unpack8(qp[hf], up);
          ld8f(cbias + c16 + hf * 8, a);
          ld8f(cw + c16 + hf * 8, w);
#pragma unroll
          for (int k = 0; k < 8; ++k) a[k] += w[k] * um[k];
          ld8f(cw + 768 + c16 + hf * 8, w);
#pragma unroll
          for (int k = 0; k < 8; ++k) a[k] += w[k] * u0[k];
          ld8f(cw + 1536 + c16 + hf * 8, w);
#pragma unroll
          for (int k = 0; k < 8; ++k) a[k] += w[k] * up[k];
          unpack8(qf[hf], u0); unpack8(qbk[hf], um); unpack8(qz[hf], up);
#pragma unroll
          for (int k = 0; k < 8; ++k) vals[hf * 8 + k] = (u0[k] + um[k] + dsum * silu(a[k])) * silu(up[k]);
        }
        norm_store(vals, YN + row * 1024 + 768 + c16);
      }
    }
  }
}

DI void ln_panel(const bfr* pre, float* out, bfr* hb, const float* stats, int brow, const float* g, const float* bta, bool write_f32) {
  const int tid = tidx(), wid = tid >> 6, lane = tid & 63;
#pragma unroll 1
  for (int r4 = wid * 4; r4 < 256; r4 += 32) {
    uint4 q[4][2];
#pragma unroll
    for (int qq = 0; qq < 4; ++qq)
#pragma unroll
      for (int i = 0; i < 2; ++i) q[qq][i] = write_f32 ? make_uint4(0, 0, 0, 0) : *reinterpret_cast<const uint4*>(pre + (long)(brow + r4 + qq) * D + i * 512 + lane * 8);
#pragma unroll
    for (int qq = 0; qq < 4; ++qq) {
      const int row = brow + r4 + qq;
      const float2 st = reinterpret_cast<const float2*>(stats)[r4 + qq];
      const float mu = st.x * (1.f / D);
      const float rstd = rsqrtf(fmaxf(st.y * (1.f / D) - mu * mu, 0.f) + 1e-5f);
#pragma unroll
      for (int i = 0; i < 2; ++i) {
        const int c0 = i * 512 + lane * 8;
        float v[8], gg[8], bb[8];
        if (write_f32) ld8f(out + (long)row * D + c0, v); else unpack8(q[qq][i], v);
        ld8f(g + c0, gg); ld8f(bta + c0, bb);
#pragma unroll
        for (int k = 0; k < 8; ++k) v[k] = (v[k] - mu) * rstd * gg[k] + bb[k];
        if (write_f32) { float* op = out + (long)row * D + c0; *reinterpret_cast<float4*>(op) = make_float4(v[0], v[1], v[2], v[3]); *reinterpret_cast<float4*>(op + 4) = make_float4(v[4], v[5], v[6], v[7]); }
        *reinterpret_cast<uint4*>(hb + (long)row * D + c0) = pack8(v);
      }
    }
  }
}

template <int LDA, int LDB>
DI void phase_gemm_ln(const PX& P, const bfr* A, const bfr* Bt, int K, const float* g, const float* bta, char* shm) {
  float* stats = (float*)(shm + 136192);
  EpiResid epi{(bfr*)(P.ws + WS_PRE), (const bfr*)(P.ws + WS_HB), stats};
#pragma unroll 1
  for (int pm = blockIdx.x; pm < 256; pm += gridDim.x) {
    { const int t = tidx(); if (t < 512) stats[t] = 0.f; }
    __syncthreads();
#pragma unroll 1
    for (int pn = 0; pn < 4; ++pn) gemm_unit<LDA, LDB>(A, Bt, K, pm * 256, pn * 256, shm, epi);
    ln_panel((const bfr*)(P.ws + WS_PRE), P.out, (bfr*)(P.ws + WS_HB), stats, pm * 256, g, bta, false);
    __syncthreads();
  }
}

template <int LDA, int LDB, int K, class Epi>
DI void phase_gemm(const bfr* A, const bfr* Bt, int nN, char* shm, const Epi& epi) {
  for (int u = blockIdx.x; u < 256 * nN; u += gridDim.x) {
    int pm, pn; unit_to_tile(u, 256, nN, pm, pn);
    gemm_unit<LDA, LDB>(A, Bt, K, pm * 256, pn * 256, shm, epi);
  }
}

DI void phase_ple(const PX& P, int l, char* shm) {
  char* ws = P.ws;
  const bfr* W = (const bfr*)(ws + WS_W) + (size_t)l * EW_LAYER;
  bfr* E = (bfr*)(ws + WS_YN);
  float* stats = (float*)(shm + 136192);
  EpiStoreBf16 e1{E, 1024};
  EpiPle e2{(bfr*)(ws + WS_PRE), (l == NL - 1) ? P.out : nullptr, (const bfr*)(ws + WS_HB), E, P.in[37] + l * 1024, stats};
#pragma unroll 1
  for (int pm = blockIdx.x; pm < 256; pm += gridDim.x) {
    { const int t = tidx(); if (t < 512) stats[t] = 0.f; }
    __syncthreads();
#pragma unroll 1
    for (int pn = 0; pn < 4; ++pn) gemm_unit<256, 256>((const bfr*)(ws + WS_PB), W + WO_PP, 256, pm * 256, pn * 256, shm, e1);
#pragma unroll 1
    for (int pn = 0; pn < 4; ++pn) gemm_unit<1024, 1024>((const bfr*)(ws + WS_HB), W + WO_PG, 1024, pm * 256, pn * 256, shm, e2);
    ln_panel((const bfr*)(ws + WS_PRE), P.out, (bfr*)(ws + WS_HB), stats, pm * 256, P.in[38] + l * D, P.in[39] + l * D, l == NL - 1);
    __syncthreads();
  }
}

DI void convert_p(const PX& P, int l) {
  const float4* src = reinterpret_cast<const float4*>(P.in[1] + (size_t)l * NT * PLE);
  uint2* dst = reinterpret_cast<uint2*>(P.ws + WS_PB);
  for (size_t e = (size_t)blockIdx.x * NTHREADS + tidx(); e < (size_t)NT * PLE / 4; e += (size_t)gridDim.x * NTHREADS) {
    const float4 v = src[e]; uint2 pk; pk.x = pack2(v.x, v.y); pk.y = pack2(v.z, v.w); dst[e] = pk;
  }
}

constexpr int NPH_LAYER = 9;
constexpr int NPHASES = 1 + NL * NPH_LAYER;

DI void run_phase(const Params& P0, int ph, char* shm, int skip = 0) {
  PX P;
  int z = 0; asm volatile("" : "+v"(z)); z = __builtin_amdgcn_readfirstlane(z);
  P.in = (in_tab_t)(&P0.in[0]) + z; P.out = P0.out + z; P.ws = P0.ws + z;
  char* ws = P.ws;
  if (ph == 0) { phase_prep(P, shm); return; }
  const int l = (ph - 1) / NPH_LAYER, k = (ph - 1) % NPH_LAYER;
  const bfr* W = (const bfr*)(ws + WS_W) + (size_t)l * EW_LAYER;
  const bfr* HB = (const bfr*)(ws + WS_HB);
  switch (k) {
    case 0: phase_gemm_in(P, l, shm, skip); break;
    case 1: phase_premix(P, l, shm); break;
    case 2: phase_mix(P, l, shm); break;
    case 3: phase_norm(P, l, shm); break;
    case 4: phase_gemm_ln<1024, 1024>(P, (const bfr*)(ws + WS_YN), W + WO_OUT, 1024, P.in[26] + l * D, P.in[27] + l * D, shm); convert_p(P, l); break;
    case 5: { EpiGate e{(bfr*)(ws + WS_U), (bfr*)(ws + WS_HALO)}; phase_gemm<1024, 1024, 1024>(HB, W + WO_G, 11, shm, e); } break;
    case 6: { EpiUp e{(bfr*)(ws + WS_U), (const bfr*)(ws + WS_HALO), P.in[30] + (size_t)l * 3 * DFF, P.in[31] + (size_t)l * DFF};
              phase_gemm<1024, 1024, 1024>(HB, W + WO_U, 11, shm, e); } break;
    case 7: phase_gemm_ln<DFF, DFF>(P, (const bfr*)(ws + WS_U), W + WO_D, DFF, P.in[33] + l * D, P.in[34] + l * D, shm); break;
    case 8: phase_ple(P, l, shm); break;
  }
}

DI void grid_barrier(unsigned* bar, unsigned target) {
  __syncthreads();
  if (tidx() == 0) {
    __builtin_amdgcn_fence(__ATOMIC_RELEASE, "agent");
    __hip_atomic_fetch_add(bar, 1u, __ATOMIC_RELAXED, __HIP_MEMORY_SCOPE_AGENT);
    while (__hip_atomic_load(bar, __ATOMIC_RELAXED, __HIP_MEMORY_SCOPE_AGENT) < target) __builtin_amdgcn_s_sleep(1);
    __builtin_amdgcn_fence(__ATOMIC_ACQUIRE, "agent");
  }
  __syncthreads();
}

template <int PH>
DI void do_phase(const Params& P, int lo, int hi, char* shm) {
  if (PH >= lo && PH < hi) {
#if PROBE_DUP
    if (PH > 0 && ((PROBE_DUP >> ((PH - 1) % NPH_LAYER)) & 1)) { run_phase(P, PH, shm, 1); __syncthreads(); }
    if (PH == 0 && (PROBE_DUP & 0x8000)) { run_phase(P, PH, shm, 1); __syncthreads(); }
#endif
    run_phase(P, PH, shm);
    if (PH + 1 < hi) grid_barrier((unsigned*)(P.ws + WS_BAR), (unsigned)(PH + 1 - lo) * gridDim.x);
  }
}

__global__ __launch_bounds__(NTHREADS, 2) void mega(Params P, int ph_lo, int ph_hi) {
  extern __shared__ __attribute__((aligned(16))) char shm[];
  tid_init();
  if (ph_hi - ph_lo > 1) cg::this_grid().sync();
#ifdef DIAGPH
  run_phase(P, DIAGPH, shm);
#else
  do_phase<0>(P, ph_lo, ph_hi, shm);
  do_phase<1>(P, ph_lo, ph_hi, shm);
  do_phase<2>(P, ph_lo, ph_hi, shm);
  do_phase<3>(P, ph_lo, ph_hi, shm);
  do_phase<4>(P, ph_lo, ph_hi, shm);
  do_phase<5>(P, ph_lo, ph_hi, shm);
  do_phase<6>(P, ph_lo, ph_hi, shm);
  do_phase<7>(P, ph_lo, ph_hi, shm);
  do_phase<8>(P, ph_lo, ph_hi, shm);
  do_phase<9>(P, ph_lo, ph_hi, shm);
  do_phase<10>(P, ph_lo, ph_hi, shm);
  do_phase<11>(P, ph_lo, ph_hi, shm);
  do_phase<12>(P, ph_lo, ph_hi, shm);
  do_phase<13>(P, ph_lo, ph_hi, shm);
  do_phase<14>(P, ph_lo, ph_hi, shm);
  do_phase<15>(P, ph_lo, ph_hi, shm);
  do_phase<16>(P, ph_lo, ph_hi, shm);
  do_phase<17>(P, ph_lo, ph_hi, shm);
  do_phase<18>(P, ph_lo, ph_hi, shm);
#endif
}

extern "C" void kernel_launch(void* const* d_in, const int* in_sizes, int n_in, void* d_out, int out_size, void* d_ws,
                              size_t ws_size, hipStream_t stream) {
  static int grid = 0;
  if (grid == 0) {
    int dev = 0, cus = 0, per_cu = 0;
    hipGetDevice(&dev);
    hipDeviceGetAttribute(&cus, hipDeviceAttributeMultiprocessorCount, dev);
    hipFuncSetAttribute((const void*)mega, hipFuncAttributeMaxDynamicSharedMemorySize, LDS_BYTES);
    hipOccupancyMaxActiveBlocksPerMultiprocessor(&per_cu, (const void*)mega, NTHREADS, LDS_BYTES);
    if (per_cu < 1) per_cu = 1;
    grid = cus * per_cu;
    if (ws_size < WS_END) fprintf(stderr, "workspace too small: %zu < %zu\n", ws_size, (size_t)WS_END);
  }
  Params p{};
  for (int i = 0; i < 40; ++i) p.in[i] = (const float*)d_in[i];
  p.out = (float*)d_out; p.ws = (char*)d_ws;
#if COOP
  hipMemsetAsync((char*)d_ws + WS_BAR, 0, 256, stream);
  int lo = 0, hi = NPHASES;
  void* args[] = {&p, &lo, &hi};
  hipError_t e = hipLaunchCooperativeKernel((const void*)mega, dim3(grid), dim3(NTHREADS), args, LDS_BYTES, stream);
  if (e != hipSuccess) fprintf(stderr, "cooperative launch failed: %s (grid %d)\n", hipGetErrorString(e), grid);
#else
  for (int ph = 0; ph < NPHASES; ++ph) hipLaunchKernelGGL(mega, dim3(grid), dim3(NTHREADS), LDS_BYTES, stream, p, ph, ph + 1);
#endif
}
```

```cpp
#include <hip/hip_runtime.h>
#include <hip/hip_bf16.h>
#include <hip/hip_cooperative_groups.h>
#include <cstdio>
namespace cg = cooperative_groups;

#ifndef PROBE_DUP
#define PROBE_DUP 0
#define PROBE_MIX 0
#define PROBE_GEMM 0
#endif
#ifndef COOP
#define COOP 1
#endif

typedef unsigned short bfr;
using bf16x8 = __attribute__((ext_vector_type(8))) short;
using s16x4  = __attribute__((ext_vector_type(4))) short;
using f32x4  = __attribute__((ext_vector_type(4))) float;
using f32x16 = __attribute__((ext_vector_type(16))) float;
#define DI __device__ __forceinline__

constexpr int NB = 32, S = 2048, D = 1024, NT = NB * S, NL = 2;
constexpr int INW = 2728, INP = 2816, DFF = 2816, PLE = 256;
constexpr int OQ = 0, OKV = 256, OKR = 384, OHY = 416, OSQ = 1184, OSK = 1440, OSV = 1568, OZ = 1696, OXBC = 1952, ODT = 2720;
constexpr float ALPHA = 1.4142135623730951f;
constexpr float LOG2E = 1.4426950408889634f;

constexpr size_t EW_IN = 2816ull * 1024, EW_UQ = 512ull * 256, EW_UKV = 512ull * 256, EW_OUT = 1024ull * 1024,
                 EW_G = 2816ull * 1024, EW_U = 2816ull * 1024, EW_D = 1024ull * 2816, EW_PP = 1024ull * 256, EW_PG = 1024ull * 1024;
constexpr size_t WO_IN = 0, WO_UQ = WO_IN + EW_IN, WO_UKV = WO_UQ + EW_UQ, WO_OUT = WO_UKV + EW_UKV, WO_G = WO_OUT + EW_OUT,
                 WO_U = WO_G + EW_G, WO_D = WO_U + EW_U, WO_PP = WO_D + EW_D, WO_PG = WO_PP + EW_PP, EW_LAYER = WO_PG + EW_PG;
constexpr size_t WS_W = 0;
constexpr size_t WS_KBUF = WS_W + NL * EW_LAYER * 2;
constexpr size_t WS_KF = WS_KBUF + 2ull * 2 * 256 * 4096 * 4;
constexpr size_t WS_ROPE = WS_KF + 2ull * 2 * 256 * 4096 * 8;
constexpr size_t WS_TW = WS_ROPE + 2048ull * 16 * 8;
constexpr size_t WS_HALO = WS_TW + 2048ull * 8;
constexpr size_t WS_HB = WS_HALO + 512ull * 2 * 2816 * 2;
constexpr size_t WS_U = WS_HB + (size_t)NT * 1024 * 2;
constexpr size_t WS_Y = WS_U + (size_t)NT * 2816 * 2;
constexpr size_t WS_Q = WS_Y + (size_t)NT * 512 * 2;
constexpr size_t WS_K = WS_Q + (size_t)NT * 384 * 2;
constexpr size_t WS_VT = WS_K + (size_t)NT * 384 * 2;
constexpr size_t WS_YN = WS_Q;
constexpr size_t WS_HYT = WS_VT + (size_t)NT * 256 * 2;
constexpr size_t WS_PB = WS_HYT;
constexpr size_t WS_PRE = WS_HYT + (size_t)NT * 256 * 2;
constexpr size_t WS_YSSD = WS_HYT + (size_t)NT * 768 * 2;
constexpr size_t WS_YH = WS_YSSD + 2ull * NT * 256 * 2;
constexpr size_t WS_BAR = WS_YH + (size_t)NT * 256 * 2;
constexpr size_t WS_END = WS_BAR + 256;

constexpr int LDS_BYTES = 147456;
constexpr int NTHREADS = 512;

struct Params {
  const float* in[40];
  float* out;
  char* ws;
};

typedef const float* const __attribute__((address_space(4)))* in_tab_t;
struct PX {
  in_tab_t in;
  float* out;
  char* ws;
};
__shared__ int s_wave_tab[64];
DI int hw_slot() { return (int)(__builtin_amdgcn_s_getreg((5 << 11) | (0 << 6) | 4) & 63u); }
DI void tid_init() {
  const int t = threadIdx.x;
  if ((t & 63) == 0) s_wave_tab[hw_slot()] = t >> 6;
  __syncthreads();
}
DI int tidx() {
  int w = s_wave_tab[hw_slot()];
  asm volatile("" : "+v"(w));
  w = __builtin_amdgcn_readfirstlane(w);
  int t = (w << 6) | (int)__builtin_amdgcn_mbcnt_hi(~0u, __builtin_amdgcn_mbcnt_lo(~0u, 0u));
  asm volatile("" : "+v"(t));
  return t;
}
DI const char* uni_ptr(const char* p) {
  const unsigned long long v = (unsigned long long)p;
  const unsigned lo = __builtin_amdgcn_readfirstlane((unsigned)v), hi = __builtin_amdgcn_readfirstlane((unsigned)(v >> 32));
  return (const char*)(((unsigned long long)hi << 32) | lo);
}
template <int M> DI float swz_xor(float v) { return __int_as_float(__builtin_amdgcn_ds_swizzle(__float_as_int(v), (M << 10) | 0x1f)); }
typedef __bf16 bf16x2_t __attribute__((ext_vector_type(2)));
DI bfr f2bf(float x) { return __builtin_bit_cast(bfr, (__bf16)x); }
DI float bf2f(bfr v) { return __uint_as_float(((unsigned)v) << 16); }
DI unsigned pack2(float a, float b) { bf16x2_t v = {(__bf16)a, (__bf16)b}; return __builtin_bit_cast(unsigned, v); }
DI float silu(float x) { return x * __builtin_amdgcn_rcpf(1.f + __expf(-x)); }
DI float sigmoidf(float x) { return __builtin_amdgcn_rcpf(1.f + __expf(-x)); }

constexpr int BM = 256, BK = 64, HALF = 128, HT = HALF * BK;
DI int lds_byte(int r, int c) {
  int st = (r >> 4) * 2 + (c >> 5), rr = r & 15, cc = c & 31, ob = rr * 64 + cc * 2;
  return st * 1024 + (ob ^ (((ob >> 9) & 1) << 5));
}
DI void stage_rc(int b, int& R, int& C) {
  int st = b / 1024, sb = b % 1024, swz = sb ^ (((sb >> 9) & 1) << 5);
  R = (st >> 1) * 16 + swz / 64; C = (st & 1) * 32 + (swz % 64) / 2;
}

typedef f32x4 acc_t[2][2][4][2];
constexpr int TST = 260;

template <int LDA, int LDB, class Epi, int SKIP = 0>
DI void gemm_unit(const bfr* __restrict__ A, const bfr* __restrict__ Bt, int K, int brow, int bcol, char* shmc, const Epi& epi) {
  bfr* shm = (bfr*)shmc;
#define SA(b, h) (shm + ((b) * 2 + (h)) * HT)
#define SB(b, h) (shm + (4 + (b) * 2 + (h)) * HT)
#define GL_LDS(gp, lp) __builtin_amdgcn_global_load_lds((const unsigned*)(gp), (__attribute__((address_space(3))) unsigned*)(lp), 16, 0, 0)
#define STAGE(P, BASE, LD, br, kt) do { const char* _sb = (const char*)(BASE) + ((long)(br) * (LD) + (kt) * BK) * 2; \
    const char* _sb2 = uni_ptr(_sb + 64 * (LD) * 2); \
    GL_LDS(_sb + voff_##LD, (char*)(P) + woff); \
    GL_LDS(_sb2 + voff_##LD, (char*)(P) + woff + 8192); } while (0)
#define LDA_(dst, b, h) for (int m = 0; m < 4; ++m) for (int k = 0; k < 2; ++k) \
    dst[m][k] = *reinterpret_cast<const bf16x8*>((char*)SA(b, h) + lds_byte(wr * 64 + m * 16 + fr, k * 32 + fq * 8))
#define LDB_(dst, b, h) for (int n = 0; n < 2; ++n) for (int k = 0; k < 2; ++k) \
    dst[n][k] = *reinterpret_cast<const bf16x8*>((char*)SB(b, h) + lds_byte(wc * 32 + n * 16 + fr, k * 32 + fq * 8))
#define MMA(ai, bj, At, Bt_) do { __builtin_amdgcn_s_setprio(1); \
    for (int m = 0; m < 4; ++m) for (int n = 0; n < 2; ++n) for (int k = 0; k < 2; ++k) \
      acc[ai][bj][m][n] = __builtin_amdgcn_mfma_f32_16x16x32_bf16(At[m][k], Bt_[n][k], acc[ai][bj][m][n], 0, 0, 0); \
    __builtin_amdgcn_s_setprio(0); } while (0)
#define WAIT_V(n) asm volatile("s_waitcnt vmcnt(" #n ")" ::: "memory")
#define WAIT_L(n) asm volatile("s_waitcnt lgkmcnt(" #n ")" ::: "memory")
#define BAR __builtin_amdgcn_s_barrier()
#define SCHED __builtin_amdgcn_sched_barrier(0)

  const int tid_u = tidx();
  const int wid = tid_u >> 6, lane = tid_u & 63, wr = wid >> 2, wc = wid & 3, fr = lane & 15, fq = lane >> 4;
  unsigned voff_LDA, voff_LDB;
  { int r_, c_; stage_rc(tid_u * 16, r_, c_); voff_LDA = (unsigned)(r_ * LDA + c_) * 2u; voff_LDB = (unsigned)(r_ * LDB + c_) * 2u; }
  const int woff = __builtin_amdgcn_readfirstlane(wid * 1024);
  acc_t acc = {};
  bf16x8 At[4][2], B0[2][2], B1[2][2];
  int nt = K / BK; asm volatile("" : "+s"(nt));
  STAGE(SB(0, 0), Bt, LDB, bcol, 0); STAGE(SA(0, 0), A, LDA, brow, 0);
  STAGE(SB(0, 1), Bt, LDB, bcol + HALF, 0); STAGE(SA(0, 1), A, LDA, brow + HALF, 0);
  if (wr == 1) BAR;
  WAIT_V(4); BAR;
  STAGE(SB(1, 0), Bt, LDB, bcol, 1); STAGE(SA(1, 0), A, LDA, brow, 1); STAGE(SB(1, 1), Bt, LDB, bcol + HALF, 1);
  WAIT_V(6); BAR;
#pragma unroll 1
  for (int t = 0; t < nt - 2; t += 2) {
    LDB_(B0, 0, 0); SCHED; LDA_(At, 0, 0); STAGE(SA(1, 1), A, LDA, brow + HALF, t + 1);
    WAIT_L(8); BAR; WAIT_L(0); MMA(0, 0, At, B0); BAR; SCHED;
    LDB_(B1, 0, 1); STAGE(SB(0, 0), Bt, LDB, bcol, t + 2);
    BAR; WAIT_L(0); MMA(0, 1, At, B1); BAR;
    LDA_(At, 0, 1); STAGE(SA(0, 0), A, LDA, brow, t + 2);
    BAR; WAIT_L(0); MMA(1, 0, At, B0); BAR; SCHED;
    STAGE(SB(0, 1), Bt, LDB, bcol + HALF, t + 2);
    WAIT_V(6); BAR; MMA(1, 1, At, B1); BAR;
    LDB_(B0, 1, 0); SCHED; LDA_(At, 1, 0); STAGE(SA(0, 1), A, LDA, brow + HALF, t + 2);
    WAIT_L(8); BAR; WAIT_L(0); MMA(0, 0, At, B0); BAR; SCHED;
    LDB_(B1, 1, 1); STAGE(SB(1, 0), Bt, LDB, bcol, t + 3);
    BAR; WAIT_L(0); MMA(0, 1, At, B1); BAR;
    LDA_(At, 1, 1); STAGE(SA(1, 0), A, LDA, brow, t + 3);
    BAR; WAIT_L(0); MMA(1, 0, At, B0); BAR; SCHED;
    STAGE(SB(1, 1), Bt, LDB, bcol + HALF, t + 3);
    WAIT_V(6); BAR; MMA(1, 1, At, B1); BAR;
  }
  { LDB_(B0, 0, 0); LDA_(At, 0, 0); STAGE(SA(1, 1), A, LDA, brow + HALF, nt - 1);
    BAR; WAIT_L(0); MMA(0, 0, At, B0); BAR;
    LDB_(B1, 0, 1); BAR; WAIT_L(0); MMA(0, 1, At, B1); BAR;
    LDA_(At, 0, 1); WAIT_V(4); BAR; WAIT_L(0); MMA(1, 0, At, B0); MMA(1, 1, At, B1); BAR; }
  { LDB_(B0, 1, 0); LDA_(At, 1, 0); WAIT_V(2); BAR; WAIT_L(0); MMA(0, 0, At, B0); BAR;
    LDB_(B1, 1, 1); WAIT_V(0); BAR; WAIT_L(0); MMA(0, 1, At, B1); BAR;
    LDA_(At, 1, 1); BAR; WAIT_L(0); MMA(1, 0, At, B0); MMA(1, 1, At, B1); BAR; }
  if (wr == 0) BAR;
  if (SKIP == 2) {
    float s = 0.f;
#pragma unroll
    for (int ai = 0; ai < 2; ++ai)
#pragma unroll
      for (int bj = 0; bj < 2; ++bj)
#pragma unroll
        for (int m = 0; m < 4; ++m)
#pragma unroll
          for (int n = 0; n < 2; ++n) s += acc[ai][bj][m][n][0] + acc[ai][bj][m][n][1] + acc[ai][bj][m][n][2] + acc[ai][bj][m][n][3];
    if (s == 123.456f) ((float*)shmc)[0] = s;
    __syncthreads();
    return;
  }
  float* tile = (float*)shmc;
  {
    int t2 = tid_u; asm volatile("" : "+v"(t2));
    const int lane2 = t2 & 63, wid2 = t2 >> 6;
    tile += ((wid2 >> 2) * 64 + (lane2 >> 4) * 4) * TST + (wid2 & 3) * 32 + (lane2 & 15);
  }
#pragma unroll
  for (int ai = 0; ai < 2; ++ai) {
    if (ai) __syncthreads();
#pragma unroll
    for (int bj = 0; bj < 2; ++bj)
#pragma unroll
      for (int m = 0; m < 4; ++m)
#pragma unroll
        for (int n = 0; n < 2; ++n)
#pragma unroll
          for (int j = 0; j < 4; ++j)
            tile[(m * 16 + j) * TST + bj * 128 + n * 16] = acc[ai][bj][m][n][j];
    __syncthreads();
    if (SKIP == 0) epi((float*)shmc, brow + ai * 128, bcol);
  }
  __syncthreads();
}

DI void unit_to_tile(int u, int nM, int nN, int& pm, int& pn) {
  const int nig = 8 * nN, gid = u / nig, fm = gid * 8, gsz = min(nM - fm, 8);
  pm = fm + ((u % nig) % gsz); pn = (u % nig) / gsz;
}

#define FOR_CHUNKS(ci) const int tid_e##ci = tidx(); _Pragma("unroll 1") for (int ci = 0; ci < 8; ++ci)
#define CHUNK_SETUP(ci) int tx_ = tid_e##ci; asm volatile("" : "+v"(tx_)); const int idx_ = ci * 512 + tx_; const int lr = idx_ >> 5, lc = (idx_ & 31) * 8; \
    const int row = r0 + lr, col = bcol + lc; float v[8]; \
    { const float4 a_ = *reinterpret_cast<const float4*>(tile + lr * TST + lc), b_ = *reinterpret_cast<const float4*>(tile + lr * TST + lc + 4); \
      v[0] = a_.x; v[1] = a_.y; v[2] = a_.z; v[3] = a_.w; v[4] = b_.x; v[5] = b_.y; v[6] = b_.z; v[7] = b_.w; }
DI uint4 pack8(const float* v) { uint4 o; o.x = pack2(v[0], v[1]); o.y = pack2(v[2], v[3]); o.z = pack2(v[4], v[5]); o.w = pack2(v[6], v[7]); return o; }
DI void unpack8(const uint4& u, float* f) {
  f[0] = __uint_as_float(u.x << 16); f[1] = __uint_as_float(u.x & 0xffff0000u); f[2] = __uint_as_float(u.y << 16); f[3] = __uint_as_float(u.y & 0xffff0000u);
  f[4] = __uint_as_float(u.z << 16); f[5] = __uint_as_float(u.z & 0xffff0000u); f[6] = __uint_as_float(u.w << 16); f[7] = __uint_as_float(u.w & 0xffff0000u);
}
DI void ld8f(const float* p, float* f) { const float4 a = *reinterpret_cast<const float4*>(p), b = *reinterpret_cast<const float4*>(p + 4);
  f[0] = a.x; f[1] = a.y; f[2] = a.z; f[3] = a.w; f[4] = b.x; f[5] = b.y; f[6] = b.z; f[7] = b.w; }

struct EpiStoreBf16 {
  bfr* C; int ldc;
  DI void operator()(float* tile, int r0, int bcol) const {
    FOR_CHUNKS(ci) { CHUNK_SETUP(ci); *reinterpret_cast<uint4*>(C + (long)row * ldc + col) = pack8(v); }
  }
};
struct EpiGate {
  bfr* G; bfr* halo;
  DI void operator()(float* tile, int r0, int bcol) const {
    FOR_CHUNKS(ci) { CHUNK_SETUP(ci); const uint4 pk = pack8(v);
      *reinterpret_cast<uint4*>(G + (long)row * DFF + col) = pk;
      if (lr == 0) *reinterpret_cast<uint4*>(halo + ((long)(row >> 7) * 2 + 0) * DFF + col) = pk;
      if (lr == 127) *reinterpret_cast<uint4*>(halo + ((long)(row >> 7) * 2 + 1) * DFF + col) = pk;
    }
  }
};
#define CH_LR(ci, tx) (((ci) * 512 + (tx)) >> 5)
#define CH_LC(ci, tx) ((((ci) * 512 + (tx)) & 31) * 8)
struct EpiUp {
  bfr* G; const bfr* halo; const float* cw; const float* cb;
  DI void operator()(float* tile, int r0, int bcol) const {
    const int tx = tidx();
    const int lc = (tx & 31) * 8, col = bcol + lc;
    float wm[8], wc[8], wp[8], wb[8];
    ld8f(cw + col, wm); ld8f(cw + DFF + col, wc); ld8f(cw + 2 * DFF + col, wp); ld8f(cb + col, wb);
#pragma unroll
    for (int c0 = 0; c0 < 8; c0 += 4) {
      uint4 q0[4], qm[4], qp[4];
#pragma unroll
      for (int k4 = 0; k4 < 4; ++k4) {
        const int lr = CH_LR(c0 + k4, tx), row = r0 + lr;
        const long idx = (long)row * DFF + col; const int t = row & (S - 1), hb = row >> 7;
        q0[k4] = *reinterpret_cast<const uint4*>(G + idx);
        qm[k4] = make_uint4(0, 0, 0, 0); qp[k4] = make_uint4(0, 0, 0, 0);
        if (t != 0) qm[k4] = lr == 0 ? *reinterpret_cast<const uint4*>(halo + ((long)(hb - 1) * 2 + 1) * DFF + col) : *reinterpret_cast<const uint4*>(G + idx - DFF);
        if (t != S - 1) qp[k4] = lr == 127 ? *reinterpret_cast<const uint4*>(halo + ((long)(hb + 1) * 2 + 0) * DFF + col) : *reinterpret_cast<const uint4*>(G + idx + DFF);
      }
#pragma unroll
      for (int k4 = 0; k4 < 4; ++k4) {
        const int lr = CH_LR(c0 + k4, tx);
        float v[8], g0[8], gm[8], gp[8];
        ld8f(tile + lr * TST + lc, v);
        unpack8(q0[k4], g0); unpack8(qm[k4], gm); unpack8(qp[k4], gp);
#pragma unroll
        for (int k = 0; k < 8; ++k) v[k] = silu(wb[k] + wm[k] * gm[k] + wc[k] * g0[k] + wp[k] * gp[k]) * v[k];
        *reinterpret_cast<uint4*>(tile + lr * TST + lc) = pack8(v);
      }
    }
    __syncthreads();
#pragma unroll
    for (int ci = 0; ci < 8; ++ci) {
      const int lr = CH_LR(ci, tx);
      *reinterpret_cast<uint4*>(G + (long)(r0 + lr) * DFF + col) = *reinterpret_cast<const uint4*>(tile + lr * TST + lc);
    }
  }
};
DI void row_stats_add(float* stats, int row, const float* v, int tx) {
  float s1 = 0.f, s2 = 0.f;
#pragma unroll
  for (int k = 0; k < 8; ++k) { s1 += v[k]; s2 += v[k] * v[k]; }
  s1 += swz_xor<16>(s1); s2 += swz_xor<16>(s2); s1 += swz_xor<8>(s1); s2 += swz_xor<8>(s2); s1 += swz_xor<4>(s1); s2 += swz_xor<4>(s2);
  s1 += swz_xor<2>(s1); s2 += swz_xor<2>(s2); s1 += swz_xor<1>(s1); s2 += swz_xor<1>(s2);
  if ((tx & 31) == 0) { float2* sp = reinterpret_cast<float2*>(stats) + (row & 255); float2 s = *sp; s.x += s1; s.y += s2; *sp = s; }
}
struct EpiResid {
  bfr* out; const bfr* hb; float* stats;
  DI void operator()(float* tile, int r0, int bcol) const {
    const int tx = tidx();
#pragma unroll
    for (int c0 = 0; c0 < 8; c0 += 4) {
      uint4 hq[4];
#pragma unroll
      for (int k4 = 0; k4 < 4; ++k4) hq[k4] = *reinterpret_cast<const uint4*>(hb + (long)(r0 + CH_LR(c0 + k4, tx)) * D + bcol + CH_LC(c0 + k4, tx));
#pragma unroll
      for (int k4 = 0; k4 < 4; ++k4) {
        const int lr = CH_LR(c0 + k4, tx), lc = CH_LC(c0 + k4, tx), row = r0 + lr;
        bfr* op = out + (long)row * D + bcol + lc;
        float v[8], o[8];
        ld8f(tile + lr * TST + lc, v); unpack8(hq[k4], o);
#pragma unroll
        for (int k = 0; k < 8; ++k) o[k] = ALPHA * o[k] + v[k];
        *reinterpret_cast<uint4*>(op) = pack8(o);
        row_stats_add(stats, row, o, tx);
      }
    }
  }
};
struct EpiPle {
  bfr* out; float* out32; const bfr* hb; const bfr* E; const float* bg; float* stats;
  DI void operator()(float* tile, int r0, int bcol) const {
    const int tx = tidx();
#pragma unroll
    for (int c0 = 0; c0 < 8; c0 += 4) {
      uint4 hq[4], eq[4];
#pragma unroll
      for (int k4 = 0; k4 < 4; ++k4) {
        const long idx = (long)(r0 + CH_LR(c0 + k4, tx)) * D + bcol + CH_LC(c0 + k4, tx);
        hq[k4] = *reinterpret_cast<const uint4*>(hb + idx);
        eq[k4] = *reinterpret_cast<const uint4*>(E + idx);
      }
#pragma unroll
      for (int k4 = 0; k4 < 4; ++k4) {
        const int lr = CH_LR(c0 + k4, tx), lc = CH_LC(c0 + k4, tx), row = r0 + lr, col = bcol + lc;
        bfr* op = out + (long)row * D + col;
        float v[8], o[8], e[8], bgv[8];
        ld8f(tile + lr * TST + lc, v); ld8f(bg + col, bgv); unpack8(eq[k4], e); unpack8(hq[k4], o);
#pragma unroll
        for (int k = 0; k < 8; ++k) o[k] = ALPHA * o[k] + e[k] * sigmoidf(v[k] + bgv[k]);
        if (out32) { float* o32 = out32 + (long)row * D + col; *reinterpret_cast<float4*>(o32) = make_float4(o[0], o[1], o[2], o[3]); *reinterpret_cast<float4*>(o32 + 4) = make_float4(o[4], o[5], o[6], o[7]); }
        else *reinterpret_cast<uint4*>(op) = pack8(o);
        row_stats_add(stats, row, o, tx);
      }
    }
  }
};
struct EpiQ {
  bfr* Q; const float* rs; const float2* rope;
  DI void operator()(float* tile, int r0, int bcol) const {
    FOR_CHUNKS(ci) { CHUNK_SETUP(ci);
      if (col < 384) {
        const int head = col / 96, d0 = col % 96; const float rstd = rs[row & 255]; const int b = row >> 11, t = row & (S - 1);
        if (d0 >= 64) {
          const bool lo = d0 < 80; const int jj = (d0 - (lo ? 64 : 80));
          float pw[8]; ld8f(tile + lr * TST + lc + (lo ? 16 : -16), pw);
#pragma unroll
          for (int k = 0; k < 8; ++k) { const float2 cs = rope[t * 16 + jj + k];
            v[k] = lo ? (v[k] * cs.x - pw[k] * cs.y) : (v[k] * cs.x + pw[k] * cs.y); }
        }
#pragma unroll
        for (int k = 0; k < 8; ++k) v[k] *= rstd;
        *reinterpret_cast<uint4*>(Q + (((long)(b * 4 + head)) * S + t) * 96 + d0) = pack8(v);
      }
    }
  }
};
struct EpiKV {
  bfr* Kf; bfr* VT; const float* rs;
  DI void operator()(float* tile, int r0, int bcol) const {
    FOR_CHUNKS(ci) { CHUNK_SETUP(ci);
      if ((col & 127) < 64) {
        const int head = col >> 7, d0 = col & 127; const float rstd = rs[row & 255]; const int b = row >> 11, t = row & (S - 1);
#pragma unroll
        for (int k = 0; k < 8; ++k) v[k] *= rstd;
        *reinterpret_cast<uint4*>(Kf + (((long)(b * 4 + head)) * S + t) * 96 + d0) = pack8(v);
      }
    }
    const int b = r0 >> 11, t0 = r0 & (S - 1);
#pragma unroll 1
    for (int it = tidx(); it < 2048; it += NTHREADS) {
      const int vc = it & 127, rc = it >> 7, lcol = (vc >> 6) * 128 + 64 + (vc & 63), lr0 = rc * 8;
      const int head = (bcol + lcol) >> 7, dd = vc & 63;
      float v[8];
#pragma unroll
      for (int k = 0; k < 8; ++k) v[k] = tile[(lr0 + k) * TST + lcol] * rs[(r0 + lr0 + k) & 255];
      *reinterpret_cast<uint4*>(VT + (((long)(b * 4 + head)) * 64 + dd) * S + t0 + lr0) = pack8(v);
    }
  }
};

#define MFMA32(a, b, c) __builtin_amdgcn_mfma_f32_32x32x16_bf16((a), (b), (c), 0, 0, 0)
template <int DQK, bool SWA>
DI void attn_item(const bfr* __restrict__ qb, long q_ld, const bfr* __restrict__ kb, long k_ld, const bfr* __restrict__ vb, long v_ld,
                  int q0, int key_lo, int key_hi, float scale_l2e, float slope_l2e, float sink_l2e,
                  bfr* __restrict__ outp, long out_ld, char* shm) {
  constexpr int KST = DQK + 8;
  constexpr int VST = 72;
  constexpr int NKK = DQK / 16;
  bfr* Ks = (bfr*)shm;
  bfr* Vt = Ks + 64 * KST;
  const int tid = tidx(), wid = tid >> 6, lane = tid & 63, r = lane & 31, h = lane >> 5;
  const int qrow = q0 + wid * 32 + r;
  bf16x8 qf[NKK];
#pragma unroll
  for (int kk = 0; kk < NKK; ++kk) qf[kk] = *reinterpret_cast<const bf16x8*>(qb + (long)qrow * q_ld + kk * 16 + h * 8);
  f32x16 o[2];
#pragma unroll
  for (int i = 0; i < 16; ++i) { o[0][i] = 0.f; o[1][i] = 0.f; }
  float mrun = SWA ? sink_l2e : -1e30f, lrun = SWA ? 1.f : 0.f;
  constexpr int KCH = DQK / 8;
  constexpr bool K2 = (64 * KCH > NTHREADS);
  uint4 pk0, pk1 = make_uint4(0, 0, 0, 0), pvv;
  const int vrow = tid >> 3, vch = tid & 7;
  const int kr0 = tid / KCH, kc0 = (tid % KCH) * 8, kr1 = (tid + NTHREADS) / KCH, kc1 = ((tid + NTHREADS) % KCH) * 8;
  const bool has1 = K2 && (tid + NTHREADS < 64 * KCH);
#define ATT_LOAD(kt_) do { \
    pk0 = *reinterpret_cast<const uint4*>(kb + (long)((kt_) + kr0) * k_ld + kc0); \
    if (has1) pk1 = *reinterpret_cast<const uint4*>(kb + (long)((kt_) + kr1) * k_ld + kc1); \
    pvv = SWA ? *reinterpret_cast<const uint4*>(vb + (long)((kt_) + vrow) * v_ld + vch * 8) \
              : *reinterpret_cast<const uint4*>(vb + (long)vrow * v_ld + (kt_) + vch * 8); } while (0)
  ATT_LOAD(key_lo);
  for (int kt = key_lo; kt < key_hi; kt += 64) {
    __syncthreads();
    *reinterpret_cast<uint4*>(Ks + kr0 * KST + kc0) = pk0;
    if (has1) *reinterpret_cast<uint4*>(Ks + kr1 * KST + kc1) = pk1;
    if (SWA) {
      bfr* vp = Vt + (vch * 8) * VST + vrow;
      vp[0 * VST] = (bfr)(pvv.x & 0xffffu); vp[1 * VST] = (bfr)(pvv.x >> 16);
      vp[2 * VST] = (bfr)(pvv.y & 0xffffu); vp[3 * VST] = (bfr)(pvv.y >> 16);
      vp[4 * VST] = (bfr)(pvv.z & 0xffffu); vp[5 * VST] = (bfr)(pvv.z >> 16);
      vp[6 * VST] = (bfr)(pvv.w & 0xffffu); vp[7 * VST] = (bfr)(pvv.w >> 16);
    } else {
      *reinterpret_cast<uint4*>(Vt + vrow * VST + vch * 8) = pvv;
    }
    if (kt + 64 < key_hi) ATT_LOAD(kt + 64);
    __syncthreads();
    const bool tile_live = !SWA || ((kt + 63 >= q0 + wid * 32 - 128) && (kt <= q0 + wid * 32 + 31 + 128));
    if (tile_live) {
    f32x16 s[2];
#pragma unroll
    for (int kh = 0; kh < 2; ++kh) {
#pragma unroll
      for (int i = 0; i < 16; ++i) s[kh][i] = 0.f;
#pragma unroll
      for (int kk = 0; kk < NKK; ++kk) {
        const bf16x8 a = *reinterpret_cast<const bf16x8*>(Ks + (kh * 32 + r) * KST + kk * 16 + h * 8);
        s[kh] = MFMA32(a, qf[kk], s[kh]);
      }
    }
    float mx = -1e30f;
    if (SWA) {
#pragma unroll
      for (int kh = 0; kh < 2; ++kh)
#pragma unroll
        for (int i = 0; i < 16; ++i) {
          const int kpos = kt + kh * 32 + (i & 3) + 8 * (i >> 2) + 4 * h;
          const int dist = abs(qrow - kpos);
          const float v = (dist <= 128) ? s[kh][i] * scale_l2e - slope_l2e * (float)dist : -1e30f;
          s[kh][i] = v; mx = fmaxf(mx, v);
        }
    } else {
#pragma unroll
      for (int kh = 0; kh < 2; ++kh)
#pragma unroll
        for (int i = 0; i < 16; ++i) mx = fmaxf(mx, s[kh][i]);
      mx *= scale_l2e;
    }
    mx = fmaxf(mx, __shfl_xor(mx, 32));
    const float mnew = fmaxf(mrun, mx);
    float ps = 0.f;
    if (SWA) {
#pragma unroll
      for (int kh = 0; kh < 2; ++kh)
#pragma unroll
        for (int i = 0; i < 16; ++i) { const float p = __builtin_amdgcn_exp2f(s[kh][i] - mnew); s[kh][i] = p; ps += p; }
    } else {
#pragma unroll
      for (int kh = 0; kh < 2; ++kh)
#pragma unroll
        for (int i = 0; i < 16; ++i) { const float p = __builtin_amdgcn_exp2f(fmaf(s[kh][i], scale_l2e, -mnew)); s[kh][i] = p; ps += p; }
    }
    ps += __shfl_xor(ps, 32);
    if (__any(mnew > mrun)) {
      const float corr = __builtin_amdgcn_exp2f(mrun - mnew);
      lrun *= corr;
#pragma unroll
      for (int i = 0; i < 16; ++i) { o[0][i] *= corr; o[1][i] *= corr; }
    }
    lrun += ps; mrun = mnew;
#pragma unroll
    for (int kh = 0; kh < 2; ++kh)
#pragma unroll
      for (int s2 = 0; s2 < 2; ++s2) {
        uint4 pbu;
        pbu.x = pack2(s[kh][8 * s2 + 0], s[kh][8 * s2 + 1]); pbu.y = pack2(s[kh][8 * s2 + 2], s[kh][8 * s2 + 3]);
        pbu.z = pack2(s[kh][8 * s2 + 4], s[kh][8 * s2 + 5]); pbu.w = pack2(s[kh][8 * s2 + 6], s[kh][8 * s2 + 7]);
        const bf16x8 pb = __builtin_bit_cast(bf16x8, pbu);
#pragma unroll
        for (int dt = 0; dt < 2; ++dt) {
          const bfr* vp = Vt + (dt * 32 + r) * VST + kh * 32 + 16 * s2 + 4 * h;
          const s16x4 lo = *reinterpret_cast<const s16x4*>(vp);
          const s16x4 hi = *reinterpret_cast<const s16x4*>(vp + 8);
          const bf16x8 a = __builtin_shufflevector(lo, hi, 0, 1, 2, 3, 4, 5, 6, 7);
          o[dt] = MFMA32(a, pb, o[dt]);
        }
      }
    }
  }
  const float inv = 1.f / lrun;
#pragma unroll
  for (int dt = 0; dt < 2; ++dt)
#pragma unroll
    for (int g = 0; g < 4; ++g) {
      uint2 pk; pk.x = pack2(o[dt][4 * g] * inv, o[dt][4 * g + 1] * inv); pk.y = pack2(o[dt][4 * g + 2] * inv, o[dt][4 * g + 3] * inv);
      *reinterpret_cast<uint2*>(outp + (long)qrow * out_ld + dt * 32 + 8 * g + 4 * h) = pk;
    }
}

DI float2 cmul(float2 a, float2 b) { return make_float2(a.x * b.x - a.y * b.y, a.x * b.y + a.y * b.x); }
DI float2 cmulc(float2 a, float2 b) { return make_float2(a.x * b.x + a.y * b.y, a.y * b.x - a.x * b.y); }
constexpr int FST_A = 272, FST_B = 17, FFT_LDS = 16 * FST_A;
DI int fpos(int n) { return (n >> 8) * FST_A + ((n >> 4) & 15) * FST_B + (n & 15); }
DI float2 twid(const float2* TW, int m) {
  const float2 w = TW[m & 2047];
  return (m & 2048) ? make_float2(-w.x, -w.y) : w;
}
DI void dft16_fwd(float2* v) {
  const float C8 = 0.92387953251128674f, S8 = 0.38268343236508977f, R2 = 0.70710678118654752f;
  const float2 w16[8] = {{1.f, 0.f}, {C8, -S8}, {R2, -R2}, {S8, -C8}, {0.f, -1.f}, {-S8, -C8}, {-R2, -R2}, {-C8, -S8}};
#pragma unroll
  for (int s = 0; s < 4; ++s) {
    const int half = 8 >> s;
#pragma unroll
    for (int j = 0; j < 8; ++j) {
      const int pos = j & (half - 1), i0 = ((j - pos) << 1) + pos, i1 = i0 + half;
      const float2 a = v[i0], b = v[i1];
      v[i0] = make_float2(a.x + b.x, a.y + b.y);
      v[i1] = cmul(make_float2(a.x - b.x, a.y - b.y), w16[pos << s]);
    }
  }
}
DI void dft16_inv(float2* v) {
  const float C8 = 0.92387953251128674f, S8 = 0.38268343236508977f, R2 = 0.70710678118654752f;
  const float2 w16[8] = {{1.f, 0.f}, {C8, -S8}, {R2, -R2}, {S8, -C8}, {0.f, -1.f}, {-S8, -C8}, {-R2, -R2}, {-C8, -S8}};
#pragma unroll
  for (int s = 3; s >= 0; --s) {
    const int half = 8 >> s;
#pragma unroll
    for (int j = 0; j < 8; ++j) {
      const int pos = j & (half - 1), i0 = ((j - pos) << 1) + pos, i1 = i0 + half;
      const float2 a = v[i0], b = cmulc(v[i1], w16[pos << s]);
      v[i0] = make_float2(a.x + b.x, a.y + b.y);
      v[i1] = make_float2(a.x - b.x, a.y - b.y);
    }
  }
}
DI int brev4(int i) { return ((i & 1) << 3) | ((i & 2) << 1) | ((i & 4) >> 1) | ((i & 8) >> 3); }
DI void fft_fwd(float2* X, const float2* TW, const int t) {
  float2 v[16];
  const int hi = t >> 4, lo = t & 15;
  {
    float2* p = X + hi * FST_B + lo;
#pragma unroll
    for (int i = 0; i < 16; ++i) v[i] = p[i * FST_A];
    dft16_fwd(v);
#pragma unroll
    for (int i = 0; i < 16; ++i) p[i * FST_A] = cmul(v[i], twid(TW, t * brev4(i)));
  }
  __syncthreads();
  {
    float2* p = X + hi * FST_A + lo;
#pragma unroll
    for (int i = 0; i < 16; ++i) v[i] = p[i * FST_B];
    dft16_fwd(v);
#pragma unroll
    for (int i = 0; i < 16; ++i) p[i * FST_B] = cmul(v[i], twid(TW, 16 * lo * brev4(i)));
  }
  __syncthreads();
  {
    float2* p = X + hi * FST_A + lo * FST_B;
#pragma unroll
    for (int i = 0; i < 16; ++i) v[i] = p[i];
    dft16_fwd(v);
#pragma unroll
    for (int i = 0; i < 16; ++i) p[i] = v[i];
  }
  __syncthreads();
}
DI void fft_inv(float2* X, const float2* TW, const int t) {
  float2 v[16];
  const int hi = t >> 4, lo = t & 15;
  {
    float2* p = X + hi * FST_A + lo * FST_B;
#pragma unroll
    for (int i = 0; i < 16; ++i) v[i] = p[i];
    dft16_inv(v);
#pragma unroll
    for (int i = 0; i < 16; ++i) p[i] = v[i];
  }
  __syncthreads();
  {
    float2* p = X + hi * FST_A + lo;
#pragma unroll
    for (int i = 0; i < 16; ++i) v[i] = cmulc(p[i * FST_B], twid(TW, 16 * lo * brev4(i)));
    dft16_inv(v);
#pragma unroll
    for (int i = 0; i < 16; ++i) p[i * FST_B] = v[i];
  }
  __syncthreads();
  {
    float2* p = X + hi * FST_B + lo;
#pragma unroll
    for (int i = 0; i < 16; ++i) v[i] = cmulc(p[i * FST_A], twid(TW, t * brev4(i)));
    dft16_inv(v);
#pragma unroll
    for (int i = 0; i < 16; ++i) p[i * FST_A] = v[i];
  }
  __syncthreads();
}

DI void transpose_convert(const float* src, int K, int N, bfr* dst, int Kp, int Np, const float* kscale, char* shm) {
  float* tile = (float*)shm;
  const int tk = Kp / 64, tn = Np / 64;
  const int tid = tidx();
#pragma unroll 1
  for (int it = blockIdx.x; it < tk * tn; it += gridDim.x) {
    const int k0 = (it % tk) * 64, n0 = (it / tk) * 64;
    __syncthreads();
    float4 v[2];
#pragma unroll
    for (int q = 0; q < 2; ++q) {
      const int idx = tid + q * NTHREADS, kk = idx >> 4, n4 = (idx & 15) * 4, k = k0 + kk, n = n0 + n4;
      v[q] = make_float4(0.f, 0.f, 0.f, 0.f);
      if (k < K && n < N) { v[q] = *reinterpret_cast<const float4*>(src + (long)k * N + n); if (kscale) { const float sc = kscale[k]; v[q].x *= sc; v[q].y *= sc; v[q].z *= sc; v[q].w *= sc; } }
    }
#pragma unroll
    for (int q = 0; q < 2; ++q) { const int idx = tid + q * NTHREADS; *reinterpret_cast<float4*>(tile + (idx >> 4) * 68 + (idx & 15) * 4) = v[q]; }
    __syncthreads();
#pragma unroll
    for (int q = 0; q < 2; ++q) {
      const int idx = tid + q * NTHREADS, nn = idx >> 4, k4 = (idx & 15) * 4;
      uint2 pk; pk.x = pack2(tile[k4 * 68 + nn], tile[(k4 + 1) * 68 + nn]); pk.y = pack2(tile[(k4 + 2) * 68 + nn], tile[(k4 + 3) * 68 + nn]);
      *reinterpret_cast<uint2*>(dst + (long)(n0 + nn) * Kp + k0 + k4) = pk;
    }
  }
}

DI void ln_rows(const float* src, float* dst32, bfr* dstb, const float* g, const float* bta) {
  const int wid = tidx() >> 6, lane = tidx() & 63;
#pragma unroll 1
  for (int row0 = (blockIdx.x * 8 + wid) * 2; row0 < NT; row0 += gridDim.x * 16) {
    float4 v[2][4];
#pragma unroll
    for (int q = 0; q < 2; ++q)
#pragma unroll
      for (int i = 0; i < 4; ++i) v[q][i] = reinterpret_cast<const float4*>(src + (long)(row0 + q) * D)[i * 64 + lane];
#pragma unroll
    for (int q = 0; q < 2; ++q) {
      const int row = row0 + q;
      float sum = 0.f;
#pragma unroll
      for (int i = 0; i < 4; ++i) sum += v[q][i].x + v[q][i].y + v[q][i].z + v[q][i].w;
#pragma unroll
      for (int o = 32; o >= 1; o >>= 1) sum += __shfl_xor(sum, o);
      const float mu = sum * (1.f / D);
      float sq = 0.f;
#pragma unroll
      for (int i = 0; i < 4; ++i) { v[q][i].x -= mu; v[q][i].y -= mu; v[q][i].z -= mu; v[q][i].w -= mu; sq += v[q][i].x * v[q][i].x + v[q][i].y * v[q][i].y + v[q][i].z * v[q][i].z + v[q][i].w * v[q][i].w; }
#pragma unroll
      for (int o = 32; o >= 1; o >>= 1) sq += __shfl_xor(sq, o);
      const float rstd = rsqrtf(sq * (1.f / D) + 1e-5f);
#pragma unroll
      for (int i = 0; i < 4; ++i) {
        const int c4 = i * 64 + lane;
        const float4 gg = reinterpret_cast<const float4*>(g)[c4], bb = reinterpret_cast<const float4*>(bta)[c4];
        float4 y; y.x = v[q][i].x * rstd * gg.x + bb.x; y.y = v[q][i].y * rstd * gg.y + bb.y; y.z = v[q][i].z * rstd * gg.z + bb.z; y.w = v[q][i].w * rstd * gg.w + bb.w;
        if (dst32) reinterpret_cast<float4*>(dst32 + (long)row * D)[c4] = y;
        uint2 pk; pk.x = pack2(y.x, y.y); pk.y = pack2(y.z, y.w);
        reinterpret_cast<uint2*>(dstb + (long)row * D)[c4] = pk;
      }
    }
  }
}

DI void phase_prep(const PX& P, char* shm) {
  char* ws = P.ws;
  for (int l = 0; l < NL; ++l) {
    bfr* W = (bfr*)(ws + WS_W) + (size_t)l * EW_LAYER;
    transpose_convert(P.in[4] + (size_t)l * 1024 * INW, 1024, INW, W + WO_IN, 1024, 2816, nullptr, shm);
    transpose_convert(P.in[7] + (size_t)l * 256 * 384, 256, 384, W + WO_UQ, 256, 512, P.in[5] + l * 256, shm);
    transpose_convert(P.in[8] + (size_t)l * 128 * 512, 128, 512, W + WO_UKV, 256, 512, P.in[6] + l * 128, shm);
    transpose_convert(P.in[25] + (size_t)l * 1024 * 1024, 1024, 1024, W + WO_OUT, 1024, 1024, P.in[24] + l * 1024, shm);
    transpose_convert(P.in[28] + (size_t)l * 1024 * DFF, 1024, DFF, W + WO_G, 1024, DFF, nullptr, shm);
    transpose_convert(P.in[29] + (size_t)l * 1024 * DFF, 1024, DFF, W + WO_U, 1024, DFF, nullptr, shm);
    transpose_convert(P.in[32] + (size_t)l * DFF * 1024, DFF, 1024, W + WO_D, DFF, 1024, nullptr, shm);
    transpose_convert(P.in[35] + (size_t)l * 256 * 1024, 256, 1024, W + WO_PP, 256, 1024, nullptr, shm);
    transpose_convert(P.in[36] + (size_t)l * 1024 * 1024, 1024, 1024, W + WO_PG, 1024, 1024, nullptr, shm);
  }
  __syncthreads();
  {
    float2* rope = (float2*)(ws + WS_ROPE);
    float2* tw = (float2*)(ws + WS_TW);
    for (int e = blockIdx.x * NTHREADS + tidx(); e < 2048 * 16 + 2048; e += gridDim.x * NTHREADS) {
      if (e < 2048 * 16) {
        const int t = e >> 4, j = e & 15;
        const float invf = exp2f(-(float)j * (13.287712379549449f / 16.0f));
        const float ang = (float)t * invf;
        float sn, cs; sincosf(ang, &sn, &cs);
        rope[e] = make_float2(cs, sn);
      } else {
        const int k = e - 2048 * 16;
        float sn, cs; sincospif((float)k * (1.0f / 2048.0f), &sn, &cs);
        tw[k] = make_float2(cs, -sn);
      }
    }
  }
  {
    float* sm = (float*)shm;
    float* kbuf = (float*)(ws + WS_KBUF);
    const int tid = tidx();
#pragma unroll 1
    for (int it = blockIdx.x; it < NL * (S / 4); it += gridDim.x) {
      const int l = it / (S / 4), tb = (it % (S / 4)) * 4;
      const float* w1 = P.in[11] + l * 33 * 64; const float* b1 = P.in[12] + l * 64; const float* fq = P.in[13] + l * 64;
      const float* w2 = P.in[14] + l * 64 * 64; const float* b2 = P.in[15] + l * 64; const float* w3 = P.in[16] + (size_t)l * 64 * 1024;
      __syncthreads();
      if (tid < 4 * 33) {
        const int q = tid / 33, i = tid % 33, t = tb + q;
        float f;
        if (i == 0) f = (float)t / 2047.0f;
        else {
          const int bi = (i - 1) & 15;
          const float band = 1e-4f + (float)bi * ((15.0f - 1e-4f) / 15.0f);
          const float ang = 6.283185307179586f * (float)t / 2048.0f;
          const float a = band * ang;
          f = (i <= 16) ? cosf(a) : -sinf(a);
        }
        sm[q * 64 + i] = f;
      }
      __syncthreads();
      if (tid < 256) {
        const int q = tid >> 6, j = tid & 63; float a = b1[j];
        for (int i = 0; i < 33; ++i) a += sm[q * 64 + i] * w1[i * 64 + j];
        sm[256 + q * 64 + j] = sinf(fq[j] * a);
      }
      __syncthreads();
      if (tid < 256) {
        const int q = tid >> 6, j = tid & 63; float a = b2[j];
        for (int i = 0; i < 64; ++i) a += sm[256 + q * 64 + i] * w2[i * 64 + j];
        sm[512 + q * 64 + j] = sinf(fq[j] * a);
      }
      __syncthreads();
#pragma unroll 1
      for (int oc = tid; oc < 1024; oc += NTHREADS) {
        float a0 = 0.f, a1 = 0.f, a2 = 0.f, a3 = 0.f;
#pragma unroll 8
        for (int i = 0; i < 64; ++i) { const float w = w3[i * 1024 + oc]; a0 += sm[512 + i] * w; a1 += sm[576 + i] * w; a2 += sm[640 + i] * w; a3 += sm[704 + i] * w; }
        const int o = oc >> 9, dir = (oc >> 8) & 1, c = oc & 255;
        const float mind = -3.0701134573253945f, maxd = -15.350567286626973f;
        const float delta = fabsf(mind + (float)c * ((maxd - mind) / 255.0f));
        float* kb = kbuf + ((size_t)((l * 2 + o) * 256 + c)) * 4096;
        const float av[4] = {a0, a1, a2, a3};
#pragma unroll
        for (int q = 0; q < 4; ++q) {
          const int t = tb + q;
          const float a = av[q] * expf(-((float)t / 2047.0f) * delta);
          if (dir == 0) kb[t] = a;
          else { if (t == 0) kb[2048] = 0.f; else kb[4096 - t] = a; }
        }
      }
    }
  }
  ln_rows(P.in[0], nullptr, (bfr*)(ws + WS_HB), P.in[2], P.in[3]);
}

DI void phase_gemm_in(const PX& P, int l, char* shm, int skip = 0) {
  const bfr* A = (const bfr*)(P.ws + WS_HB);
  const bfr* Bt = (const bfr*)(P.ws + WS_W) + (size_t)l * EW_LAYER + WO_IN;
  EpiStoreBf16 epi{(bfr*)(P.ws + WS_U), INP};
  for (int u = blockIdx.x; u < 256 * 11; u += gridDim.x) {
    int pm, pn; unit_to_tile(u, 256, 11, pm, pn);
#if PROBE_GEMM
    if (skip) gemm_unit<1024, 1024, EpiStoreBf16, PROBE_GEMM>(A, Bt, 1024, pm * 256, pn * 256, shm, epi);
    else
#endif
    gemm_unit<1024, 1024>(A, Bt, 1024, pm * 256, pn * 256, shm, epi);
  }
}

template <int NCOL>
DI void row_rstd(const bfr* Ucol, int brow, float* rs) {
  const int r = tidx() >> 1, hf = tidx() & 1;
  const unsigned uoff = (unsigned)(brow + r) * (unsigned)INP + (unsigned)(hf * NCOL);
  const bfr* up = Ucol + uoff;
  float ss = 0.f;
  uint4 q[NCOL / 8];
#pragma unroll
  for (int c = 0; c < NCOL / 8; ++c) q[c] = *reinterpret_cast<const uint4*>(up + c * 8);
#pragma unroll
  for (int c = 0; c < NCOL / 8; ++c) {
    float f[8]; unpack8(q[c], f);
#pragma unroll
    for (int e = 0; e < 8; ++e) ss += f[e] * f[e];
  }
  ss += __shfl_xor(ss, 1);
  if (hf == 0) rs[r] = rsqrtf(ss / (float)(2 * NCOL) + 1e-6f);
  __syncthreads();
}

DI void phase_premix(const PX& P, int l, char* shm) {
  char* ws = P.ws;
  const bfr* U = (const bfr*)(ws + WS_U);
  const bfr* W = (const bfr*)(ws + WS_W) + (size_t)l * EW_LAYER;
  float* rs = (float*)(shm + 135168);
  const float2* rope = (const float2*)(ws + WS_ROPE);
#ifndef SKIP_Q
  {
    EpiQ epi{(bfr*)(ws + WS_Q), rs, rope};
#pragma unroll 1
    for (int it = blockIdx.x; it < 512; it += gridDim.x) {
      const int pn = it & 1, brow = (it >> 1) * 256;
      row_rstd<128>(U + OQ, brow, rs);
      gemm_unit<INP, 256>(U + OQ, W + WO_UQ, 256, brow, pn * 256, shm, epi);
    }
  }
#endif
#ifndef SKIP_KV
  {
    EpiKV epi{(bfr*)(ws + WS_K), (bfr*)(ws + WS_VT), rs};
#pragma unroll 1
    for (int it = blockIdx.x; it < 512; it += gridDim.x) {
      const int pn = it & 1, brow = (it >> 1) * 256;
      row_rstd<64>(U + OKV, brow, rs);
      gemm_unit<INP, 256>(U + OKV, W + WO_UKV, 256, brow, pn * 256, shm, epi);
    }
  }
#endif
  {
    bfr* Kf = (bfr*)(ws + WS_K);
    for (long e = (long)blockIdx.x * NTHREADS + tidx(); e < (long)NT * 16; e += (long)gridDim.x * NTHREADS) {
      const int jj = (int)(e & 15); const long row = e >> 4; const int b = (int)(row >> 11), t = (int)(row & (S - 1));
      const float x1 = bf2f(U[row * INP + OKR + jj]), x2 = bf2f(U[row * INP + OKR + 16 + jj]);
      const float2 cs = rope[t * 16 + jj];
      const bfr o1 = f2bf(x1 * cs.x - x2 * cs.y), o2 = f2bf(x2 * cs.x + x1 * cs.y);
#pragma unroll
      for (int hh = 0; hh < 4; ++hh) {
        bfr* kp = Kf + (((long)(b * 4 + hh)) * S + t) * 96 + 64 + jj;
        kp[0] = o1; kp[16] = o2;
      }
    }
  }
  {
    bfr* tile = (bfr*)shm;
    bfr* HYT = (bfr*)(ws + WS_HYT);
    const float* cw = P.in[9] + l * 3 * 768; const float* cbias = P.in[10] + l * 768;
    const int tid = tidx();
#pragma unroll 1
    for (int it = blockIdx.x; it < 1024; it += gridDim.x) {
      const int b = it >> 5, t0 = (it & 31) * 64;
      __syncthreads();
#pragma unroll 1
      for (int e0 = tid; e0 < 96 * 64; e0 += 4 * NTHREADS) {
        uint4 q0[4], qm[4], qp[4];
#pragma unroll
        for (int i = 0; i < 4; ++i) {
          const int e = e0 + i * NTHREADS, c8 = e % 96, tl = e / 96, t = t0 + tl;
          const bfr* ub = U + ((long)b * S + t) * INP + OHY + c8 * 8;
          q0[i] = *reinterpret_cast<const uint4*>(ub);
          qm[i] = make_uint4(0, 0, 0, 0); qp[i] = make_uint4(0, 0, 0, 0);
          if (t > 0) qm[i] = *reinterpret_cast<const uint4*>(ub - INP);
          if (t < S - 1) qp[i] = *reinterpret_cast<const uint4*>(ub + INP);
        }
#pragma unroll
        for (int i = 0; i < 4; ++i) {
          const int e = e0 + i * NTHREADS, c8 = e % 96, tl = e / 96, c = c8 * 8;
          float u0[8], um[8], up[8], w[8], a[8];
          unpack8(q0[i], u0); unpack8(qm[i], um); unpack8(qp[i], up);
          ld8f(cbias + c, a);
          ld8f(cw + c, w);
#pragma unroll
          for (int j = 0; j < 8; ++j) a[j] += w[j] * um[j];
          ld8f(cw + 768 + c, w);
#pragma unroll
          for (int j = 0; j < 8; ++j) a[j] += w[j] * u0[j];
          ld8f(cw + 1536 + c, w);
          const int tr = (tl + 2 * c8) & 63;
#pragma unroll
          for (int j = 0; j < 8; ++j) tile[(c + j) * 66 + tr] = f2bf(a[j] + w[j] * up[j]);
        }
      }
      __syncthreads();
#pragma unroll 1
      for (int e = tid; e < 768 * 8; e += NTHREADS) {
        const int c = e >> 3, ch = e & 7, rot = c >> 3;
        const unsigned* tp = reinterpret_cast<const unsigned*>(tile + c * 66);
        uint4 v; v.x = tp[(ch * 4 + rot) & 31]; v.y = tp[(ch * 4 + 1 + rot) & 31]; v.z = tp[(ch * 4 + 2 + rot) & 31]; v.w = tp[(ch * 4 + 3 + rot) & 31];
        *reinterpret_cast<uint4*>(HYT + ((long)(b * 768 + c)) * S + t0 + ch * 8) = v;
      }
    }
  }
  if (l == 0) {
    const int tid = tidx(), hw = tid >> 8, t = tid & 255;
    float2* X = (float2*)shm + hw * FFT_LDS; float2* TW = (float2*)(shm + 2 * FFT_LDS * 8);
    const float* kbuf = (const float*)(ws + WS_KBUF);
    float2* KF = (float2*)(ws + WS_KF);
    const float2* twg = (const float2*)(ws + WS_TW);
    for (int it0 = blockIdx.x * 2; it0 < 1024; it0 += gridDim.x * 2) {
      const int it = it0 + hw;
      __syncthreads();
      for (int e = tid; e < 2048; e += NTHREADS) TW[e] = twg[e];
      for (int e = t; e < 4096; e += 256) X[fpos(e)] = make_float2(kbuf[(size_t)it * 4096 + e], 0.f);
      __syncthreads();
      fft_fwd(X, TW, t);
      for (int e = t; e < 4096; e += 256) { const float2 v = X[fpos(e)]; KF[(size_t)it * 4096 + e] = make_float2(v.x * (1.f / 4096.f), v.y * (1.f / 4096.f)); }
    }
  }
}

DI void ssd_item(const PX& P, int l, int item, char* shm) {
  constexpr int ST = 136;
  const bfr* U = (const bfr*)(P.ws + WS_U);
  bfr* YS = (bfr*)(P.ws + WS_YSSD);
  const int b = item >> 3, dir = (item >> 2) & 1, hd = item & 3, g = hd >> 1;
  const int tid = tidx(), wid = tid >> 6, lane = tid & 63, r = lane & 31, h = lane >> 5;
  const float* cw = P.in[19] + l * 3 * 768; const float* cbias = P.in[20] + l * 768;
  const float dtb = P.in[21][l * 8 + dir * 4 + hd];
  const float Acoef = -__expf(P.in[22][l * 8 + dir * 4 + hd]);
  bfr* Cs = (bfr*)shm;
  bfr* Bs = Cs + 128 * ST;
  bfr* BTd = Bs + 128 * ST;
  bfr* XT = BTd + 128 * ST;
  bfr* Rb = XT + 64 * ST;
  float* acs = (float*)(Rb + 64 * ST);
  float* dts = acs + 128;
  f32x16 racc;
#pragma unroll
  for (int i = 0; i < 16; ++i) racc[i] = 0.f;
  for (int e = tid; e < 64 * ST / 2; e += NTHREADS) reinterpret_cast<unsigned*>(Rb)[e] = 0u;
  float xr_next[2] = {0.f, 0.f};
  if (wid == 0) {
#pragma unroll
    for (int q = 0; q < 2; ++q) {
      const int k = lane * 2 + q, t = dir == 0 ? k : S - 1 - k;
      xr_next[q] = bf2f(U[((long)b * S + t) * INP + ODT + dir * 4 + hd]);
    }
  }
#pragma unroll 1
  for (int ci = 0; ci < 16; ++ci) {
    __syncthreads();
    if (wid == 0) {
      float a2[2], d2[2];
#pragma unroll
      for (int q = 0; q < 2; ++q) {
        const float xr = xr_next[q] + dtb;
        d2[q] = xr > 20.f ? xr : log1pf(__expf(xr));
        a2[q] = d2[q] * Acoef;
      }
      if (ci + 1 < 16) {
#pragma unroll
        for (int q = 0; q < 2; ++q) {
          const int k = lane * 2 + q, step = (ci + 1) * 128 + k, t = dir == 0 ? step : S - 1 - step;
          xr_next[q] = bf2f(U[((long)b * S + t) * INP + ODT + dir * 4 + hd]);
        }
      }
      const float pairsum = a2[0] + a2[1];
      float sc = pairsum;
      int lane_o = lane; asm volatile("" : "+v"(lane_o));
#pragma unroll
      for (int o = 1; o < 64; o <<= 1) { const float v = __shfl_up(sc, o); sc += (lane_o >= o) ? v : 0.f; }
      acs[lane * 2] = sc - a2[1]; acs[lane * 2 + 1] = sc;
      dts[lane * 2] = d2[0]; dts[lane * 2 + 1] = d2[1];
    }
    __syncthreads();
    const float atot = acs[127];
#pragma unroll 1
    for (int i0 = 0; i0 < 10; i0 += 5) {
      uint4 q0[5], qm[5], qp[5];
#pragma unroll
      for (int i = 0; i < 5; ++i) {
        const int it = tid + (i0 + i) * NTHREADS, k = it / 40, cc8 = it % 40;
        const int step = ci * 128 + k, t = dir == 0 ? step : S - 1 - step;
        const int col = cc8 < 8 ? hd * 64 + cc8 * 8 : (cc8 < 24 ? 256 + g * 128 + (cc8 - 8) * 8 : 512 + g * 128 + (cc8 - 24) * 8);
        const bfr* ub = U + ((long)b * S + t) * INP + OXBC + col;
        q0[i] = *reinterpret_cast<const uint4*>(ub);
        qm[i] = make_uint4(0, 0, 0, 0); qp[i] = make_uint4(0, 0, 0, 0);
        if (t > 0) qm[i] = *reinterpret_cast<const uint4*>(ub - INP);
        if (t < S - 1) qp[i] = *reinterpret_cast<const uint4*>(ub + INP);
      }
#pragma unroll
      for (int i = 0; i < 5; ++i) {
        const int it = tid + (i0 + i) * NTHREADS, k = it / 40, cc8 = it % 40;
        const int col = cc8 < 8 ? hd * 64 + cc8 * 8 : (cc8 < 24 ? 256 + g * 128 + (cc8 - 8) * 8 : 512 + g * 128 + (cc8 - 24) * 8);
        float u0[8], um[8], up[8], w[8], a[8];
        unpack8(q0[i], u0); unpack8(qm[i], um); unpack8(qp[i], up);
        ld8f(cbias + col, a);
        ld8f(cw + col, w);
#pragma unroll
        for (int j = 0; j < 8; ++j) a[j] += w[j] * um[j];
        ld8f(cw + 768 + col, w);
#pragma unroll
        for (int j = 0; j < 8; ++j) a[j] += w[j] * u0[j];
        ld8f(cw + 1536 + col, w);
#pragma unroll
        for (int j = 0; j < 8; ++j) a[j] = silu(a[j] + w[j] * up[j]);
        if (cc8 < 8) {
          const float dtk = dts[k];
#pragma unroll
          for (int j = 0; j < 8; ++j) XT[(cc8 * 8 + j) * ST + ((((k >> 3) ^ cc8) << 3) | (k & 7))] = f2bf(a[j] * dtk);
        } else if (cc8 < 24) {
          const int n0 = (cc8 - 8) * 8;
          *reinterpret_cast<uint4*>(Bs + k * ST + n0) = pack8(a);
          const float dec = __expf(atot - acs[k]);
#pragma unroll
          for (int j = 0; j < 8; ++j) BTd[(n0 + j) * ST + ((((k >> 3) ^ (cc8 - 8)) << 3) | (k & 7))] = f2bf(a[j] * dec);
        } else {
          *reinterpret_cast<uint4*>(Cs + k * ST + (cc8 - 24) * 8) = pack8(a);
        }
      }
    }
    __syncthreads();
    const int ti = wid >> 1;
    f32x16 cb[2];
#pragma unroll
    for (int q = 0; q < 2; ++q) {
      const int si = (wid & 1) * 2 + q;
#pragma unroll
      for (int i = 0; i < 16; ++i) cb[q][i] = 0.f;
      if (si <= ti) {
#pragma unroll
        for (int kk = 0; kk < 8; ++kk) {
          const bf16x8 av = *reinterpret_cast<const bf16x8*>(Cs + (32 * ti + r) * ST + kk * 16 + h * 8);
          const bf16x8 bv = *reinterpret_cast<const bf16x8*>(Bs + (32 * si + r) * ST + kk * 16 + h * 8);
          cb[q] = MFMA32(av, bv, cb[q]);
        }
      }
    }
    __syncthreads();
#pragma unroll
    for (int q = 0; q < 2; ++q) {
      const int si = (wid & 1) * 2 + q; int s = 32 * si + r; asm volatile("" : "+v"(s));
      const float as = acs[s];
#pragma unroll
      for (int i = 0; i < 16; ++i) {
        const int t = 32 * ti + (i & 3) + 8 * (i >> 2) + 4 * h;
        const float v = (s <= t) ? cb[q][i] * __expf(acs[t] - as) : 0.f;
        Bs[t * ST + s] = f2bf(v);
      }
    }
    __syncthreads();
    {
      const int pi = wid & 1;
      f32x16 y1, y2;
#pragma unroll
      for (int i = 0; i < 16; ++i) { y1[i] = 0.f; y2[i] = 0.f; }
#pragma unroll
      for (int kk = 0; kk < 8; ++kk) {
        const bf16x8 xv = *reinterpret_cast<const bf16x8*>(XT + (32 * pi + r) * ST + (((kk * 2 + h) ^ (((32 * pi + r) >> 3) & 7)) << 3));
        if (kk * 16 < 32 * ti + 32) {
          const bf16x8 mv = *reinterpret_cast<const bf16x8*>(Bs + (32 * ti + r) * ST + kk * 16 + h * 8);
          y1 = MFMA32(mv, xv, y1);
        }
        const bf16x8 cv = *reinterpret_cast<const bf16x8*>(Cs + (32 * ti + r) * ST + kk * 16 + h * 8);
        const bf16x8 rv = *reinterpret_cast<const bf16x8*>(Rb + (32 * pi + r) * ST + kk * 16 + h * 8);
        y2 = MFMA32(cv, rv, y2);
      }
#pragma unroll
      for (int i = 0; i < 16; ++i) {
        const int k = 32 * ti + (i & 3) + 8 * (i >> 2) + 4 * h;
        const int step = ci * 128 + k, t = dir == 0 ? step : S - 1 - step;
        const float y = y1[i] + __expf(acs[k]) * y2[i];
        YS[((size_t)dir * NT + (size_t)b * S + t) * 256 + hd * 64 + 32 * pi + r] = f2bf(y);
      }
    }
    {
      const int pi = wid >> 2, ni = wid & 3;
      const float ed = __expf(atot);
#pragma unroll
      for (int i = 0; i < 16; ++i) racc[i] *= ed;
#pragma unroll
      for (int kk = 0; kk < 8; ++kk) {
        const bf16x8 xv = *reinterpret_cast<const bf16x8*>(XT + (32 * pi + r) * ST + (((kk * 2 + h) ^ (((32 * pi + r) >> 3) & 7)) << 3));
        const bf16x8 bv = *reinterpret_cast<const bf16x8*>(BTd + (32 * ni + r) * ST + (((kk * 2 + h) ^ (((32 * ni + r) >> 3) & 15)) << 3));
        racc = MFMA32(xv, bv, racc);
      }
      __syncthreads();
#pragma unroll
      for (int i = 0; i < 16; ++i) Rb[(32 * pi + (i & 3) + 8 * (i >> 2) + 4 * h) * ST + 32 * ni + r] = f2bf(racc[i]);
    }
  }
}

DI void hyena_item(const PX& P, int l, int item0, char* shm) {
  const int tid = tidx(), hw = tid >> 8, t = tid & 255;
  const int item = item0 + hw;
  const int c = item >> 4, bp = item & 15, b0 = bp * 2, b1 = b0 + 1;
  float2* X = (float2*)shm + hw * FFT_LDS;
  float2* TW = (float2*)(shm + 2 * FFT_LDS * 8);
  float2* Z1 = TW + 2048 + hw * 2048;
  const bfr* HYT = (const bfr*)(P.ws + WS_HYT);
  const float2* twg = (const float2*)(P.ws + WS_TW);
  const float2* KF0 = (const float2*)(P.ws + WS_KF) + ((size_t)((l * 2 + 0) * 256 + c)) * 4096;
  const float2* KF1 = (const float2*)(P.ws + WS_KF) + ((size_t)((l * 2 + 1) * 256 + c)) * 4096;
  const float bias0 = P.in[17][(l * 2 + 0) * 256 + c], bias1 = P.in[17][(l * 2 + 1) * 256 + c];
  const bfr* v0 = HYT + ((size_t)(b0 * 768 + c)) * S; const bfr* v1 = HYT + ((size_t)(b1 * 768 + c)) * S;
  const bfr* x10 = v0 + 256 * S; const bfr* x11 = v1 + 256 * S;
  const bfr* x20 = v0 + 512 * S; const bfr* x21 = v1 + 512 * S;
  bfr* yo0 = (bfr*)(P.ws + WS_YH) + ((size_t)(b0 * 256 + c)) * S; bfr* yo1 = (bfr*)(P.ws + WS_YH) + ((size_t)(b1 * 256 + c)) * S;
  __syncthreads();
  for (int e = tid; e < 2048; e += NTHREADS) TW[e] = twg[e];
  {
    float a[8], b[8];
    unpack8(*reinterpret_cast<const uint4*>(v0 + t * 8), a); unpack8(*reinterpret_cast<const uint4*>(v1 + t * 8), b);
#pragma unroll
    for (int k = 0; k < 8; ++k) { X[fpos(t * 8 + k)] = make_float2(a[k], b[k]); X[fpos(2048 + t * 8 + k)] = make_float2(0.f, 0.f); }
  }
  __syncthreads();
  fft_fwd(X, TW, t);
  { float2 kf[16];
#pragma unroll
    for (int i = 0; i < 16; ++i) kf[i] = KF0[t + i * 256];
#pragma unroll
    for (int i = 0; i < 16; ++i) { const int p = fpos(t + i * 256); X[p] = cmul(X[p], kf[i]); } }
  __syncthreads();
  fft_inv(X, TW, t);
  {
    float a[8], b[8], g0[8], g1[8];
    unpack8(*reinterpret_cast<const uint4*>(v0 + t * 8), a); unpack8(*reinterpret_cast<const uint4*>(v1 + t * 8), b);
    unpack8(*reinterpret_cast<const uint4*>(x10 + t * 8), g0); unpack8(*reinterpret_cast<const uint4*>(x11 + t * 8), g1);
    float2 z[8];
#pragma unroll
    for (int k = 0; k < 8; ++k) { const float2 y = X[fpos(t * 8 + k)]; z[k] = make_float2(g0[k] * (y.x + bias0 * a[k]), g1[k] * (y.y + bias0 * b[k])); }
    __syncthreads();
#pragma unroll
    for (int k = 0; k < 8; ++k) { Z1[t * 8 + k] = z[k]; X[fpos(t * 8 + k)] = z[k]; X[fpos(2048 + t * 8 + k)] = make_float2(0.f, 0.f); }
  }
  __syncthreads();
  fft_fwd(X, TW, t);
  { float2 kf[16];
#pragma unroll
    for (int i = 0; i < 16; ++i) kf[i] = KF1[t + i * 256];
#pragma unroll
    for (int i = 0; i < 16; ++i) { const int p = fpos(t + i * 256); X[p] = cmul(X[p], kf[i]); } }
  __syncthreads();
  fft_inv(X, TW, t);
  {
    float g0[8], g1[8], o0[8], o1[8];
    unpack8(*reinterpret_cast<const uint4*>(x20 + t * 8), g0); unpack8(*reinterpret_cast<const uint4*>(x21 + t * 8), g1);
#pragma unroll
    for (int k = 0; k < 8; ++k) { const float2 y = X[fpos(t * 8 + k)], z1 = Z1[t * 8 + k]; o0[k] = g0[k] * (y.x + bias1 * z1.x); o1[k] = g1[k] * (y.y + bias1 * z1.y); }
    *reinterpret_cast<uint4*>(yo0 + t * 8) = pack8(o0); *reinterpret_cast<uint4*>(yo1 + t * 8) = pack8(o1);
  }
}

DI void phase_mix(const PX& P, int l, char* shm) {
  char* ws = P.ws;
  for (int rep = 0; rep < ((PROBE_MIX & 1) ? 2 : 1); ++rep)
  for (int it = blockIdx.x; it < 256; it += gridDim.x) ssd_item(P, l, it, shm);
  {
    const float sc = 0.10206207261596575f * LOG2E;
    for (int it = blockIdx.x; it < 1024; it += gridDim.x) {
      const int qblk = it & 7, bh = it >> 3, b = bh >> 2, hh = bh & 3;
      const bfr* q = (const bfr*)(ws + WS_Q) + (size_t)bh * S * 96;
      const bfr* k = (const bfr*)(ws + WS_K) + (size_t)bh * S * 96;
      const bfr* vt = (const bfr*)(ws + WS_VT) + (size_t)bh * 64 * S;
      bfr* o = (bfr*)(ws + WS_Y) + (size_t)b * S * 512 + hh * 64;
      attn_item<96, false>(q, 96, k, 96, vt, S, qblk * 256, 0, S, sc, 0.f, 0.f, o, 512, shm);
    }
  }
  {
    const bfr* U = (const bfr*)(ws + WS_U);
    for (int it = blockIdx.x; it < 1024; it += gridDim.x) {
      const int qblk = it & 7, bh = it >> 3, b = bh >> 2, hh = bh & 3, kvh = hh >> 1;
      const bfr* q = U + (size_t)b * S * INP + OSQ + hh * 64;
      const bfr* k = U + (size_t)b * S * INP + OSK + kvh * 64;
      const bfr* v = U + (size_t)b * S * INP + OSV + kvh * 64;
      bfr* o = (bfr*)(ws + WS_Y) + (size_t)b * S * 512 + 256 + hh * 64;
      const int q0 = qblk * 256, klo = max(q0 - 128, 0), khi = min(q0 + 256 + 128, S);
      const float slope = exp2f(-2.f * (float)(hh + 1));
      attn_item<64, true>(q, INP, k, INP, v, INP, q0, klo, khi, 0.125f * LOG2E, slope * LOG2E, P.in[18][l * 4 + hh] * LOG2E, o, 512, shm);
    }
  }
  for (int rep = 0; rep < ((PROBE_MIX & 8) ? 2 : 1); ++rep)
  for (int it = blockIdx.x * 2; it < 4096; it += gridDim.x * 2) hyena_item(P, l, it, shm);
}

DI void norm_store(float* vals, bfr* op) {
  float ss = 0.f;
#pragma unroll
  for (int k = 0; k < 16; ++k) ss += vals[k] * vals[k];
  ss += swz_xor<1>(ss); ss += swz_xor<2>(ss); ss += swz_xor<4>(ss); ss += swz_xor<8>(ss);
  const float rstd = rsqrtf(ss * (1.f / 256.f) + 1e-6f);
#pragma unroll
  for (int k = 0; k < 16; ++k) vals[k] *= rstd;
  *reinterpret_cast<uint4*>(op) = pack8(vals); *reinterpret_cast<uint4*>(op + 8) = pack8(vals + 8);
}

DI void phase_norm(const PX& P, int l, char* shm) {
  char* ws = P.ws;
  const bfr* U = (const bfr*)(ws + WS_U);
  const bfr* Y = (const bfr*)(ws + WS_Y);
  const bfr* YH = (const bfr*)(ws + WS_YH);
  const bfr* YS = (const bfr*)(ws + WS_YSSD);
  bfr* YN = (bfr*)(ws + WS_YN);
  bfr* hy = (bfr*)shm;
  const float* cw = P.in[19] + l * 3 * 768; const float* cbias = P.in[20] + l * 768;
  const int tid = tidx(), wid = tid >> 6, lane = tid & 63;
  const int grp = wid & 3, tsub = (wid >> 2) * 32, tk = lane >> 4, c16 = (lane & 15) * 16;
#pragma unroll 1
  for (int it = blockIdx.x; it < 1024; it += gridDim.x) {
    const int b = it >> 5, t0 = (it & 31) * 64;
    __syncthreads();
    for (int e = tid; e < 2048; e += NTHREADS) {
      const int c = e >> 3, ch = e & 7, rot = c >> 4;
      const uint4 v = *reinterpret_cast<const uint4*>(YH + ((size_t)(b * 256 + c)) * S + t0 + ch * 8);
      unsigned* tp = reinterpret_cast<unsigned*>(hy + c * 66);
      tp[(ch * 4 + rot) & 31] = v.x; tp[(ch * 4 + 1 + rot) & 31] = v.y; tp[(ch * 4 + 2 + rot) & 31] = v.z; tp[(ch * 4 + 3 + rot) & 31] = v.w;
    }
    __syncthreads();
    if (grp == 0 || grp == 2) {
      uint4 qa[8], qb[8];
#pragma unroll
      for (int i = 0; i < 8; ++i) {
        const long row = (long)b * S + t0 + tsub + i * 4 + tk;
        const bfr* yp = Y + row * 512 + (grp == 0 ? 0 : 256) + c16;
        qa[i] = *reinterpret_cast<const uint4*>(yp); qb[i] = *reinterpret_cast<const uint4*>(yp + 8);
      }
#pragma unroll
      for (int i = 0; i < 8; ++i) {
        const long row = (long)b * S + t0 + tsub + i * 4 + tk;
        float vals[16];
        unpack8(qa[i], vals); unpack8(qb[i], vals + 8);
        norm_store(vals, YN + row * 1024 + grp * 256 + c16);
      }
    } else if (grp == 1) {
#pragma unroll 2
      for (int i = 0; i < 8; ++i) {
        const int tl = tsub + i * 4 + tk; const long row = (long)b * S + t0 + tl;
        const int tr = (tl + 2 * (lane & 15)) & 63;
        float vals[16];
#pragma unroll
        for (int k = 0; k < 16; ++k) vals[k] = bf2f(hy[(c16 + k) * 66 + tr]);
        norm_store(vals, YN + row * 1024 + 256 + c16);
      }
    } else {
      const int hd = c16 >> 6;
      const float dsum = P.in[23][l * 8 + hd] + P.in[23][l * 8 + 4 + hd];
#pragma unroll 1
      for (int i = 0; i < 8; ++i) {
        const int tl = tsub + i * 4 + tk, t = t0 + tl; const long row = (long)b * S + t;
        const bfr* ub = U + row * INP + OXBC + c16;
        uint4 q0[2], qm[2], qp[2], qf[2], qbk[2], qz[2];
#pragma unroll
        for (int hf = 0; hf < 2; ++hf) {
          q0[hf] = *reinterpret_cast<const uint4*>(ub + hf * 8);
          qm[hf] = make_uint4(0, 0, 0, 0); qp[hf] = make_uint4(0, 0, 0, 0);
          if (t > 0) qm[hf] = *reinterpret_cast<const uint4*>(ub - INP + hf * 8);
          if (t < S - 1) qp[hf] = *reinterpret_cast<const uint4*>(ub + INP + hf * 8);
          qf[hf] = *reinterpret_cast<const uint4*>(YS + (size_t)row * 256 + c16 + hf * 8);
          qbk[hf] = *reinterpret_cast<const uint4*>(YS + ((size_t)NT + row) * 256 + c16 + hf * 8);
          qz[hf] = *reinterpret_cast<const uint4*>(U + row * INP + OZ + c16 + hf * 8);
        }
        float vals[16];
#pragma unroll
        for (int hf = 0; hf < 2; ++hf) {
          float u0[8], um[8], up[8], w[8], a[8];
          unpack8(q0[hf], u0); unpack8(qm[hf], um); unpack8(qp[hf], up);
          ld8f(cbias + c16 + hf * 8, a);
          ld8f(cw + c16 + hf * 8, w);
#pragma unroll
          for (int k = 0; k < 8; ++k) a[k] += w[k] * um[k];
          ld8f(cw + 768 + c16 + hf * 8, w);
#pragma unroll
          for (int k = 0; k < 8; ++k) a[k] += w[k] * u0[k];
          ld8f(cw + 1536 + c16 + hf * 8, w);
#pragma unroll
          for (int k = 0; k < 8; ++k) a[k] += w[k] * up[k];
          unpack8(qf[hf], u0); unpack8(qbk[hf], um); unpack8(qz[hf], up);
#pragma unroll
          for (int k = 0; k < 8; ++k) vals[hf * 8 + k] = (u0[k] + um[k] + dsum * silu(a[k])) * silu(up[k]);
        }
        norm_store(vals, YN + row * 1024 + 768 + c16);
      }
    }
  }
}

DI void ln_panel(const bfr* pre, float* out, bfr* hb, const float* stats, int brow, const float* g, const float* bta, bool write_f32) {
  const int tid = tidx(), wid = tid >> 6, lane = tid & 63;
#pragma unroll 1
  for (int r4 = wid * 4; r4 < 256; r4 += 32) {
    uint4 q[4][2];
#pragma unroll
    for (int qq = 0; qq < 4; ++qq)
#pragma unroll
      for (int i = 0; i < 2; ++i) q[qq][i] = write_f32 ? make_uint4(0, 0, 0, 0) : *reinterpret_cast<const uint4*>(pre + (long)(brow + r4 + qq) * D + i * 512 + lane * 8);
#pragma unroll
    for (int qq = 0; qq < 4; ++qq) {
      const int row = brow + r4 + qq;
      const float2 st = reinterpret_cast<const float2*>(stats)[r4 + qq];
      const float mu = st.x * (1.f / D);
      const float rstd = rsqrtf(fmaxf(st.y * (1.f / D) - mu * mu, 0.f) + 1e-5f);
#pragma unroll
      for (int i = 0; i < 2; ++i) {
        const int c0 = i * 512 + lane * 8;
        float v[8], gg[8], bb[8];
        if (write_f32) ld8f(out + (long)row * D + c0, v); else unpack8(q[qq][i], v);
        ld8f(g + c0, gg); ld8f(bta + c0, bb);
#pragma unroll
        for (int k = 0; k < 8; ++k) v[k] = (v[k] - mu) * rstd * gg[k] + bb[k];
        if (write_f32) { float* op = out + (long)row * D + c0; *reinterpret_cast<float4*>(op) = make_float4(v[0], v[1], v[2], v[3]); *reinterpret_cast<float4*>(op + 4) = make_float4(v[4], v[5], v[6], v[7]); }
        *reinterpret_cast<uint4*>(hb + (long)row * D + c0) = pack8(v);
      }
    }
  }
}

template <int LDA, int LDB>
DI void phase_gemm_ln(const PX& P, const bfr* A, const bfr* Bt, int K, const float* g, const float* bta, char* shm) {
  float* stats = (float*)(shm + 136192);
  EpiResid epi{(bfr*)(P.ws + WS_PRE), (const bfr*)(P.ws + WS_HB), stats};
#pragma unroll 1
  for (int pm = blockIdx.x; pm < 256; pm += gridDim.x) {
    { const int t = tidx(); if (t < 512) stats[t] = 0.f; }
    __syncthreads();
#pragma unroll 1
    for (int pn = 0; pn < 4; ++pn) gemm_unit<LDA, LDB>(A, Bt, K, pm * 256, pn * 256, shm, epi);
    ln_panel((const bfr*)(P.ws + WS_PRE), P.out, (bfr*)(P.ws + WS_HB), stats, pm * 256, g, bta, false);
    __syncthreads();
  }
}

template <int LDA, int LDB, int K, class Epi>
DI void phase_gemm(const bfr* A, const bfr* Bt, int nN, char* shm, const Epi& epi) {
  for (int u = blockIdx.x; u < 256 * nN; u += gridDim.x) {
    int pm, pn; unit_to_tile(u, 256, nN, pm, pn);
    gemm_unit<LDA, LDB>(A, Bt, K, pm * 256, pn * 256, shm, epi);
  }
}

DI void phase_ple(const PX& P, int l, char* shm) {
  char* ws = P.ws;
  const bfr* W = (const bfr*)(ws + WS_W) + (size_t)l * EW_LAYER;
  bfr* E = (bfr*)(ws + WS_YN);
  float* stats = (float*)(shm + 136192);
  EpiStoreBf16 e1{E, 1024};
  EpiPle e2{(bfr*)(ws + WS_PRE), (l == NL - 1) ? P.out : nullptr, (const bfr*)(ws + WS_HB), E, P.in[37] + l * 1024, stats};
#pragma unroll 1
  for (int pm = blockIdx.x; pm < 256; pm += gridDim.x) {
    { const int t = tidx(); if (t < 512) stats[t] = 0.f; }
    __syncthreads();
#pragma unroll 1
    for (int pn = 0; pn < 4; ++pn) gemm_unit<256, 256>((const bfr*)(ws + WS_PB), W + WO_PP, 256, pm * 256, pn * 256, shm, e1);
#pragma unroll 1
    for (int pn = 0; pn < 4; ++pn) gemm_unit<1024, 1024>((const bfr*)(ws + WS_HB), W + WO_PG, 1024, pm * 256, pn * 256, shm, e2);
    ln_panel((const bfr*)(ws + WS_PRE), P.out, (bfr*)(ws + WS_HB), stats, pm * 256, P.in[38] + l * D, P.in[39] + l * D, l == NL - 1);
    __syncthreads();
  }
}

DI void convert_p(const PX& P, int l) {
  const float4* src = reinterpret_cast<const float4*>(P.in[1] + (size_t)l * NT * PLE);
  uint2* dst = reinterpret_cast<uint2*>(P.ws + WS_PB);
  for (size_t e = (size_t)blockIdx.x * NTHREADS + tidx(); e < (size_t)NT * PLE / 4; e += (size_t)gridDim.x * NTHREADS) {
    const float4 v = src[e]; uint2 pk; pk.x = pack2(v.x, v.y); pk.y = pack2(v.z, v.w); dst[e] = pk;
  }
}

constexpr int NPH_LAYER = 9;
constexpr int NPHASES = 1 + NL * NPH_LAYER;

DI void run_phase(const Params& P0, int ph, char* shm, int skip = 0) {
  PX P;
  int z = 0; asm volatile("" : "+v"(z)); z = __builtin_amdgcn_readfirstlane(z);
  P.in = (in_tab_t)(&P0.in[0]) + z; P.out = P0.out + z; P.ws = P0.ws + z;
  char* ws = P.ws;
  if (ph == 0) { phase_prep(P, shm); return; }
  const int l = (ph - 1) / NPH_LAYER, k = (ph - 1) % NPH_LAYER;
  const bfr* W = (const bfr*)(ws + WS_W) + (size_t)l * EW_LAYER;
  const bfr* HB = (const bfr*)(ws + WS_HB);
  switch (k) {
    case 0: phase_gemm_in(P, l, shm, skip); break;
    case 1: phase_premix(P, l, shm); break;
    case 2: phase_mix(P, l, shm); break;
    case 3: phase_norm(P, l, shm); break;
    case 4: phase_gemm_ln<1024, 1024>(P, (const bfr*)(ws + WS_YN), W + WO_OUT, 1024, P.in[26] + l * D, P.in[27] + l * D, shm); convert_p(P, l); break;
    case 5: { EpiGate e{(bfr*)(ws + WS_U), (bfr*)(ws + WS_HALO)}; phase_gemm<1024, 1024, 1024>(HB, W + WO_G, 11, shm, e); } break;
    case 6: { EpiUp e{(bfr*)(ws + WS_U), (const bfr*)(ws + WS_HALO), P.in[30] + (size_t)l * 3 * DFF, P.in[31] + (size_t)l * DFF};
              phase_gemm<1024, 1024, 1024>(HB, W + WO_U, 11, shm, e); } break;
    case 7: phase_gemm_ln<DFF, DFF>(P, (const bfr*)(ws + WS_U), W + WO_D, DFF, P.in[33] + l * D, P.in[34] + l * D, shm); break;
    case 8: phase_ple(P, l, shm); break;
  }
}

DI void grid_barrier(unsigned* bar, unsigned target) {
  __syncthreads();
  if (tidx() == 0) {
    __builtin_amdgcn_fence(__ATOMIC_RELEASE, "agent");
    __hip_atomic_fetch_add(bar, 1u, __ATOMIC_RELAXED, __HIP_MEMORY_SCOPE_AGENT);
    while (__hip_atomic_load(bar, __ATOMIC_RELAXED, __HIP_MEMORY_SCOPE_AGENT) < target) __builtin_amdgcn_s_sleep(1);
    __builtin_amdgcn_fence(__ATOMIC_ACQUIRE, "agent");
  }
  __syncthreads();
}

template <int PH>
DI void do_phase(const Params& P, int lo, int hi, char* shm) {
  if (PH >= lo && PH < hi) {
#if PROBE_DUP
    if (PH > 0 && ((PROBE_DUP >> ((PH - 1) % NPH_LAYER)) & 1)) { run_phase(P, PH, shm, 1); __syncthreads(); }
    if (PH == 0 && (PROBE_DUP & 0x8000)) { run_phase(P, PH, shm, 1); __syncthreads(); }
#endif
    run_phase(P, PH, shm);
    if (PH + 1 < hi) grid_barrier((unsigned*)(P.ws + WS_BAR), (unsigned)(PH + 1 - lo) * gridDim.x);
  }
}

__global__ __launch_bounds__(NTHREADS, 2) void mega(Params P, int ph_lo, int ph_hi) {
  extern __shared__ __attribute__((aligned(16))) char shm[];
  tid_init();
  if (ph_hi - ph_lo > 1) cg::this_grid().sync();
#ifdef DIAGPH
  run_phase(P, DIAGPH, shm);
#else
  do_phase<0>(P, ph_lo, ph_hi, shm);
  do_phase<1>(P, ph_lo, ph_hi, shm);
  do_phase<2>(P, ph_lo, ph_hi, shm);
  do_phase<3>(P, ph_lo, ph_hi, shm);
  do_phase<4>(P, ph_lo, ph_hi, shm);
  do_phase<5>(P, ph_lo, ph_hi, shm);
  do_phase<6>(P, ph_lo, ph_hi, shm);
  do_phase<7>(P, ph_lo, ph_hi, shm);
  do_phase<8>(P, ph_lo, ph_hi, shm);
  do_phase<9>(P, ph_lo, ph_hi, shm);
  do_phase<10>(P, ph_lo, ph_hi, shm);
  do_phase<11>(P, ph_lo, ph_hi, shm);
  do_phase<12>(P, ph_lo, ph_hi, shm);
  do_phase<13>(P, ph_lo, ph_hi, shm);
  do_phase<14>(P, ph_lo, ph_hi, shm);
  do_phase<15>(P, ph_lo, ph_hi, shm);
  do_phase<16>(P, ph_lo, ph_hi, shm);
  do_phase<17>(P, ph_lo, ph_hi, shm);
  do_phase<18>(P, ph_lo, ph_hi, shm);
#endif
}

extern "C" void kernel_launch(void* const* d_in, const int* in_sizes, int n_in, void* d_out, int out_size, void* d_ws,
                              size_t ws_size, hipStream_t stream) {
  static int grid = 0;
  if (grid == 0) {
    int dev = 0, cus = 0, per_cu = 0;
    hipGetDevice(&dev);
    hipDeviceGetAttribute(&cus, hipDeviceAttributeMultiprocessorCount, dev);
    hipFuncSetAttribute((const void*)mega, hipFuncAttributeMaxDynamicSharedMemorySize, LDS_BYTES);
    hipOccupancyMaxActiveBlocksPerMultiprocessor(&per_cu, (const void*)mega, NTHREADS, LDS_BYTES);
    if (per_cu < 1) per_cu = 1;
    grid = cus * per_cu;
    if (ws_size < WS_END) fprintf(stderr, "workspace too small: %zu < %zu\n", ws_size, (size_t)WS_END);
  }
  Params p{};
  for (int i = 0; i < 40; ++i) p.in[i] = (const float*)d_in[i];
  p.out = (float*)d_out; p.ws = (char*)d_ws;
#if COOP
  hipMemsetAsync((char*)d_ws + WS_BAR, 0, 256, stream);
  int lo = 0, hi = NPHASES;
  void* args[] = {&p, &lo, &hi};
  hipError_t e = hipLaunchCooperativeKernel((const void*)mega, dim3(grid), dim3(NTHREADS), args, LDS_BYTES, stream);
  if (e != hipSuccess) fprintf(stderr, "cooperative launch failed: %s (grid %d)\n", hipGetErrorString(e), grid);
#else
  for (int ph = 0; ph < NPHASES; ++ph) hipLaunchKernelGGL(mega, dim3(grid), dim3(NTHREADS), LDS_BYTES, stream, p, ph, ph + 1);
#endif
}
```

```cpp
#include <hip/hip_runtime.h>
#include <hip/hip_bf16.h>
#include <hip/hip_cooperative_groups.h>
#include <cstdio>
namespace cg = cooperative_groups;

#ifndef PROBE_DUP
#define PROBE_DUP 0
#define PROBE_MIX 0
#define PROBE_GEMM 0
#endif
#ifndef COOP
#define COOP 1
#endif

typedef unsigned short bfr;
using bf16x8 = __attribute__((ext_vector_type(8))) short;
using s16x4  = __attribute__((ext_vector_type(4))) short;
using f32x4  = __attribute__((ext_vector_type(4))) float;
using f32x16 = __attribute__((ext_vector_type(16))) float;
#define DI __device__ __forceinline__

constexpr int NB = 32, S = 2048, D = 1024, NT = NB * S, NL = 2;
constexpr int INW = 2728, INP = 2816, DFF = 2816, PLE = 256;
constexpr int OQ = 0, OKV = 256, OKR = 384, OHY = 416, OSQ = 1184, OSK = 1440, OSV = 1568, OZ = 1696, OXBC = 1952, ODT = 2720;
constexpr float ALPHA = 1.4142135623730951f;
constexpr float LOG2E = 1.4426950408889634f;

constexpr size_t EW_IN = 2816ull * 1024, EW_UQ = 512ull * 256, EW_UKV = 512ull * 256, EW_OUT = 1024ull * 1024,
                 EW_G = 2816ull * 1024, EW_U = 2816ull * 1024, EW_D = 1024ull * 2816, EW_PP = 1024ull * 256, EW_PG = 1024ull * 1024;
constexpr size_t WO_IN = 0, WO_UQ = WO_IN + EW_IN, WO_UKV = WO_UQ + EW_UQ, WO_OUT = WO_UKV + EW_UKV, WO_G = WO_OUT + EW_OUT,
                 WO_U = WO_G + EW_G, WO_D = WO_U + EW_U, WO_PP = WO_D + EW_D, WO_PG = WO_PP + EW_PP, EW_LAYER = WO_PG + EW_PG;
constexpr size_t WS_W = 0;
constexpr size_t WS_KBUF = WS_W + NL * EW_LAYER * 2;
constexpr size_t WS_KF = WS_KBUF + 2ull * 2 * 256 * 4096 * 4;
constexpr size_t WS_ROPE = WS_KF + 2ull * 2 * 256 * 4096 * 8;
constexpr size_t WS_TW = WS_ROPE + 2048ull * 16 * 8;
constexpr size_t WS_HALO = WS_TW + 2048ull * 8;
constexpr size_t WS_HB = WS_HALO + 512ull * 2 * 2816 * 2;
constexpr size_t WS_U = WS_HB + (size_t)NT * 1024 * 2;
constexpr size_t WS_Y = WS_U + (size_t)NT * 2816 * 2;
constexpr size_t WS_Q = WS_Y + (size_t)NT * 512 * 2;
constexpr size_t WS_K = WS_Q + (size_t)NT * 384 * 2;
constexpr size_t WS_VT = WS_K + (size_t)NT * 384 * 2;
constexpr size_t WS_YN = WS_Q;
constexpr size_t WS_HYT = WS_VT + (size_t)NT * 256 * 2;
constexpr size_t WS_PB = WS_HYT;
constexpr size_t WS_PRE = WS_HYT + (size_t)NT * 256 * 2;
constexpr size_t WS_YSSD = WS_HYT + (size_t)NT * 768 * 2;
constexpr size_t WS_YH = WS_YSSD + 2ull * NT * 256 * 2;
constexpr size_t WS_BAR = WS_YH + (size_t)NT * 256 * 2;
constexpr size_t WS_END = WS_BAR + 256;

constexpr int LDS_BYTES = 147456;
constexpr int NTHREADS = 512;

struct Params {
  const float* in[40];
  float* out;
  char* ws;
};

typedef const float* const __attribute__((address_space(4)))* in_tab_t;
struct PX {
  in_tab_t in;
  float* out;
  char* ws;
};
__shared__ int s_wave_tab[64];
DI int hw_slot() { return (int)(__builtin_amdgcn_s_getreg((5 << 11) | (0 << 6) | 4) & 63u); }
DI void tid_init() {
  const int t = threadIdx.x;
  if ((t & 63) == 0) s_wave_tab[hw_slot()] = t >> 6;
  __syncthreads();
}
DI int tidx() {
  int w = s_wave_tab[hw_slot()];
  asm volatile("" : "+v"(w));
  w = __builtin_amdgcn_readfirstlane(w);
  int t = (w << 6) | (int)__builtin_amdgcn_mbcnt_hi(~0u, __builtin_amdgcn_mbcnt_lo(~0u, 0u));
  asm volatile("" : "+v"(t));
  return t;
}
DI const char* uni_ptr(const char* p) {
  const unsigned long long v = (unsigned long long)p;
  const unsigned lo = __builtin_amdgcn_readfirstlane((unsigned)v), hi = __builtin_amdgcn_readfirstlane((unsigned)(v >> 32));
  return (const char*)(((unsigned long long)hi << 32) | lo);
}
template <int M> DI float swz_xor(float v) { return __int_as_float(__builtin_amdgcn_ds_swizzle(__float_as_int(v), (M << 10) | 0x1f)); }
typedef __bf16 bf16x2_t __attribute__((ext_vector_type(2)));
DI bfr f2bf(float x) { return __builtin_bit_cast(bfr, (__bf16)x); }
DI float bf2f(bfr v) { return __uint_as_float(((unsigned)v) << 16); }
DI unsigned pack2(float a, float b) { bf16x2_t v = {(__bf16)a, (__bf16)b}; return __builtin_bit_cast(unsigned, v); }
DI float silu(float x) { return x * __builtin_amdgcn_rcpf(1.f + __expf(-x)); }
DI float sigmoidf(float x) { return __builtin_amdgcn_rcpf(1.f + __expf(-x)); }

constexpr int BM = 256, BK = 64, HALF = 128, HT = HALF * BK;
DI int lds_byte(int r, int c) {
  int st = (r >> 4) * 2 + (c >> 5), rr = r & 15, cc = c & 31, ob = rr * 64 + cc * 2;
  return st * 1024 + (ob ^ (((ob >> 9) & 1) << 5));
}
DI void stage_rc(int b, int& R, int& C) {
  int st = b / 1024, sb = b % 1024, swz = sb ^ (((sb >> 9) & 1) << 5);
  R = (st >> 1) * 16 + swz / 64; C = (st & 1) * 32 + (swz % 64) / 2;
}

typedef f32x4 acc_t[2][2][4][2];
constexpr int TST = 260;

template <int LDA, int LDB, class Epi, int SKIP = 0>
DI void gemm_unit(const bfr* __restrict__ A, const bfr* __restrict__ Bt, int K, int brow, int bcol, char* shmc, const Epi& epi) {
  bfr* shm = (bfr*)shmc;
#define SA(b, h) (shm + ((b) * 2 + (h)) * HT)
#define SB(b, h) (shm + (4 + (b) * 2 + (h)) * HT)
#define GL_LDS(gp, lp) __builtin_amdgcn_global_load_lds((const unsigned*)(gp), (__attribute__((address_space(3))) unsigned*)(lp), 16, 0, 0)
#define STAGE(P, BASE, LD, br, kt) do { const char* _sb = (const char*)(BASE) + ((long)(br) * (LD) + (kt) * BK) * 2; \
    const char* _sb2 = uni_ptr(_sb + 64 * (LD) * 2); \
    GL_LDS(_sb + voff_##LD, (char*)(P) + woff); \
    GL_LDS(_sb2 + voff_##LD, (char*)(P) + woff + 8192); } while (0)
#define LDA_(dst, b, h) for (int m = 0; m < 4; ++m) for (int k = 0; k < 2; ++k) \
    dst[m][k] = *reinterpret_cast<const bf16x8*>((char*)SA(b, h) + lds_byte(wr * 64 + m * 16 + fr, k * 32 + fq * 8))
#define LDB_(dst, b, h) for (int n = 0; n < 2; ++n) for (int k = 0; k < 2; ++k) \
    dst[n][k] = *reinterpret_cast<const bf16x8*>((char*)SB(b, h) + lds_byte(wc * 32 + n * 16 + fr, k * 32 + fq * 8))
#define MMA(ai, bj, At, Bt_) do { __builtin_amdgcn_s_setprio(1); \
    for (int m = 0; m < 4; ++m) for (int n = 0; n < 2; ++n) for (int k = 0; k < 2; ++k) \
      acc[ai][bj][m][n] = __builtin_amdgcn_mfma_f32_16x16x32_bf16(At[m][k], Bt_[n][k], acc[ai][bj][m][n], 0, 0, 0); \
    __builtin_amdgcn_s_setprio(0); } while (0)
#define WAIT_V(n) asm volatile("s_waitcnt vmcnt(" #n ")" ::: "memory")
#define WAIT_L(n) asm volatile("s_waitcnt lgkmcnt(" #n ")" ::: "memory")
#define BAR __builtin_amdgcn_s_barrier()
#define SCHED __builtin_amdgcn_sched_barrier(0)

  const int tid_u = tidx();
  const int wid = tid_u >> 6, lane = tid_u & 63, wr = wid >> 2, wc = wid & 3, fr = lane & 15, fq = lane >> 4;
  unsigned voff_LDA, voff_LDB;
  { int r_, c_; stage_rc(tid_u * 16, r_, c_); voff_LDA = (unsigned)(r_ * LDA + c_) * 2u; voff_LDB = (unsigned)(r_ * LDB + c_) * 2u; }
  const int woff = __builtin_amdgcn_readfirstlane(wid * 1024);
  acc_t acc = {};
  bf16x8 At[4][2], B0[2][2], B1[2][2];
  int nt = K / BK; asm volatile("" : "+s"(nt));
  STAGE(SB(0, 0), Bt, LDB, bcol, 0); STAGE(SA(0, 0), A, LDA, brow, 0);
  STAGE(SB(0, 1), Bt, LDB, bcol + HALF, 0); STAGE(SA(0, 1), A, LDA, brow + HALF, 0);
  if (wr == 1) BAR;
  WAIT_V(4); BAR;
  STAGE(SB(1, 0), Bt, LDB, bcol, 1); STAGE(SA(1, 0), A, LDA, brow, 1); STAGE(SB(1, 1), Bt, LDB, bcol + HALF, 1);
  WAIT_V(6); BAR;
#pragma unroll 1
  for (int t = 0; t < nt - 2; t += 2) {
    LDB_(B0, 0, 0); SCHED; LDA_(At, 0, 0); STAGE(SA(1, 1), A, LDA, brow + HALF, t + 1);
    WAIT_L(8); BAR; WAIT_L(0); MMA(0, 0, At, B0); BAR; SCHED;
    LDB_(B1, 0, 1); STAGE(SB(0, 0), Bt, LDB, bcol, t + 2);
    BAR; WAIT_L(0); MMA(0, 1, At, B1); BAR;
    LDA_(At, 0, 1); STAGE(SA(0, 0), A, LDA, brow, t + 2);
    BAR; WAIT_L(0); MMA(1, 0, At, B0); BAR; SCHED;
    STAGE(SB(0, 1), Bt, LDB, bcol + HALF, t + 2);
    WAIT_V(6); BAR; MMA(1, 1, At, B1); BAR;
    LDB_(B0, 1, 0); SCHED; LDA_(At, 1, 0); STAGE(SA(0, 1), A, LDA, brow + HALF, t + 2);
    WAIT_L(8); BAR; WAIT_L(0); MMA(0, 0, At, B0); BAR; SCHED;
    LDB_(B1, 1, 1); STAGE(SB(1, 0), Bt, LDB, bcol, t + 3);
    BAR; WAIT_L(0); MMA(0, 1, At, B1); BAR;
    LDA_(At, 1, 1); STAGE(SA(1, 0), A, LDA, brow, t + 3);
    BAR; WAIT_L(0); MMA(1, 0, At, B0); BAR; SCHED;
    STAGE(SB(1, 1), Bt, LDB, bcol + HALF, t + 3);
    WAIT_V(6); BAR; MMA(1, 1, At, B1); BAR;
  }
  { LDB_(B0, 0, 0); LDA_(At, 0, 0); STAGE(SA(1, 1), A, LDA, brow + HALF, nt - 1);
    BAR; WAIT_L(0); MMA(0, 0, At, B0); BAR;
    LDB_(B1, 0, 1); BAR; WAIT_L(0); MMA(0, 1, At, B1); BAR;
    LDA_(At, 0, 1); WAIT_V(4); BAR; WAIT_L(0); MMA(1, 0, At, B0); MMA(1, 1, At, B1); BAR; }
  { LDB_(B0, 1, 0); LDA_(At, 1, 0); WAIT_V(2); BAR; WAIT_L(0); MMA(0, 0, At, B0); BAR;
    LDB_(B1, 1, 1); WAIT_V(0); BAR; WAIT_L(0); MMA(0, 1, At, B1); BAR;
    LDA_(At, 1, 1); BAR; WAIT_L(0); MMA(1, 0, At, B0); MMA(1, 1, At, B1); BAR; }
  if (wr == 0) BAR;
  if (SKIP == 2) {
    float s = 0.f;
#pragma unroll
    for (int ai = 0; ai < 2; ++ai)
#pragma unroll
      for (int bj = 0; bj < 2; ++bj)
#pragma unroll
        for (int m = 0; m < 4; ++m)
#pragma unroll
          for (int n = 0; n < 2; ++n) s += acc[ai][bj][m][n][0] + acc[ai][bj][m][n][1] + acc[ai][bj][m][n][2] + acc[ai][bj][m][n][3];
    if (s == 123.456f) ((float*)shmc)[0] = s;
    __syncthreads();
    return;
  }
  float* tile = (float*)shmc;
  {
    int t2 = tid_u; asm volatile("" : "+v"(t2));
    const int lane2 = t2 & 63, wid2 = t2 >> 6;
    tile += ((wid2 >> 2) * 64 + (lane2 >> 4) * 4) * TST + (wid2 & 3) * 32 + (lane2 & 15);
  }
#pragma unroll
  for (int ai = 0; ai < 2; ++ai) {
    if (ai) __syncthreads();
#pragma unroll
    for (int bj = 0; bj < 2; ++bj)
#pragma unroll
      for (int m = 0; m < 4; ++m)
#pragma unroll
        for (int n = 0; n < 2; ++n)
#pragma unroll
          for (int j = 0; j < 4; ++j)
            tile[(m * 16 + j) * TST + bj * 128 + n * 16] = acc[ai][bj][m][n][j];
    __syncthreads();
    if (SKIP == 0) epi((float*)shmc, brow + ai * 128, bcol);
  }
  __syncthreads();
}

DI void unit_to_tile(int u, int nM, int nN, int& pm, int& pn) {
  const int nig = 8 * nN, gid = u / nig, fm = gid * 8, gsz = min(nM - fm, 8);
  pm = fm + ((u % nig) % gsz); pn = (u % nig) / gsz;
}

#define FOR_CHUNKS(ci) const int tid_e##ci = tidx(); _Pragma("unroll 1") for (int ci = 0; ci < 8; ++ci)
#define CHUNK_SETUP(ci) int tx_ = tid_e##ci; asm volatile("" : "+v"(tx_)); const int idx_ = ci * 512 + tx_; const int lr = idx_ >> 5, lc = (idx_ & 31) * 8; \
    const int row = r0 + lr, col = bcol + lc; float v[8]; \
    { const float4 a_ = *reinterpret_cast<const float4*>(tile + lr * TST + lc), b_ = *reinterpret_cast<const float4*>(tile + lr * TST + lc + 4); \
      v[0] = a_.x; v[1] = a_.y; v[2] = a_.z; v[3] = a_.w; v[4] = b_.x; v[5] = b_.y; v[6] = b_.z; v[7] = b_.w; }
DI uint4 pack8(const float* v) { uint4 o; o.x = pack2(v[0], v[1]); o.y = pack2(v[2], v[3]); o.z = pack2(v[4], v[5]); o.w = pack2(v[6], v[7]); return o; }
DI void unpack8(const uint4& u, float* f) {
  f[0] = __uint_as_float(u.x << 16); f[1] = __uint_as_float(u.x & 0xffff0000u); f[2] = __uint_as_float(u.y << 16); f[3] = __uint_as_float(u.y & 0xffff0000u);
  f[4] = __uint_as_float(u.z << 16); f[5] = __uint_as_float(u.z & 0xffff0000u); f[6] = __uint_as_float(u.w << 16); f[7] = __uint_as_float(u.w & 0xffff0000u);
}
DI void ld8f(const float* p, float* f) { const float4 a = *reinterpret_cast<const float4*>(p), b = *reinterpret_cast<const float4*>(p + 4);
  f[0] = a.x; f[1] = a.y; f[2] = a.z; f[3] = a.w; f[4] = b.x; f[5] = b.y; f[6] = b.z; f[7] = b.w; }

struct EpiStoreBf16 {
  bfr* C; int ldc;
  DI void operator()(float* tile, int r0, int bcol) const {
    FOR_CHUNKS(ci) { CHUNK_SETUP(ci); *reinterpret_cast<uint4*>(C + (long)row * ldc + col) = pack8(v); }
  }
};
struct EpiGate {
  bfr* G; bfr* halo;
  DI void operator()(float* tile, int r0, int bcol) const {
    FOR_CHUNKS(ci) { CHUNK_SETUP(ci); const uint4 pk = pack8(v);
      *reinterpret_cast<uint4*>(G + (long)row * DFF + col) = pk;
      if (lr == 0) *reinterpret_cast<uint4*>(halo + ((long)(row >> 7) * 2 + 0) * DFF + col) = pk;
      if (lr == 127) *reinterpret_cast<uint4*>(halo + ((long)(row >> 7) * 2 + 1) * DFF + col) = pk;
    }
  }
};
#define CH_LR(ci, tx) (((ci) * 512 + (tx)) >> 5)
#define CH_LC(ci, tx) ((((ci) * 512 + (tx)) & 31) * 8)
struct EpiUp {
  bfr* G; const bfr* halo; const float* cw; const float* cb;
  DI void operator()(float* tile, int r0, int bcol) const {
    const int tx = tidx();
    const int lc = (tx & 31) * 8, col = bcol + lc;
    float wm[8], wc[8], wp[8], wb[8];
    ld8f(cw + col, wm); ld8f(cw + DFF + col, wc); ld8f(cw + 2 * DFF + col, wp); ld8f(cb + col, wb);
#pragma unroll
    for (int c0 = 0; c0 < 8; c0 += 4) {
      uint4 q0[4], qm[4], qp[4];
#pragma unroll
      for (int k4 = 0; k4 < 4; ++k4) {
        const int lr = CH_LR(c0 + k4, tx), row = r0 + lr;
        const long idx = (long)row * DFF + col; const int t = row & (S - 1), hb = row >> 7;
        q0[k4] = *reinterpret_cast<const uint4*>(G + idx);
        qm[k4] = make_uint4(0, 0, 0, 0); qp[k4] = make_uint4(0, 0, 0, 0);
        if (t != 0) qm[k4] = lr == 0 ? *reinterpret_cast<const uint4*>(halo + ((long)(hb - 1) * 2 + 1) * DFF + col) : *reinterpret_cast<const uint4*>(G + idx - DFF);
        if (t != S - 1) qp[k4] = lr == 127 ? *reinterpret_cast<const uint4*>(halo + ((long)(hb + 1) * 2 + 0) * DFF + col) : *reinterpret_cast<const uint4*>(G + idx + DFF);
      }
#pragma unroll
      for (int k4 = 0; k4 < 4; ++k4) {
        const int lr = CH_LR(c0 + k4, tx);
        float v[8], g0[8], gm[8], gp[8];
        ld8f(tile + lr * TST + lc, v);
        unpack8(q0[k4], g0); unpack8(qm[k4], gm); unpack8(qp[k4], gp);
#pragma unroll
        for (int k = 0; k < 8; ++k) v[k] = silu(wb[k] + wm[k] * gm[k] + wc[k] * g0[k] + wp[k] * gp[k]) * v[k];
        *reinterpret_cast<uint4*>(tile + lr * TST + lc) = pack8(v);
      }
    }
    __syncthreads();
#pragma unroll
    for (int ci = 0; ci < 8; ++ci) {
      const int lr = CH_LR(ci, tx);
      *reinterpret_cast<uint4*>(G + (long)(r0 + lr) * DFF + col) = *reinterpret_cast<const uint4*>(tile + lr * TST + lc);
    }
  }
};
DI void row_stats_add(float* stats, int row, const float* v, int tx) {
  float s1 = 0.f, s2 = 0.f;
#pragma unroll
  for (int k = 0; k < 8; ++k) { s1 += v[k]; s2 += v[k] * v[k]; }
  s1 += swz_xor<16>(s1); s2 += swz_xor<16>(s2); s1 += swz_xor<8>(s1); s2 += swz_xor<8>(s2); s1 += swz_xor<4>(s1); s2 += swz_xor<4>(s2);
  s1 += swz_xor<2>(s1); s2 += swz_xor<2>(s2); s1 += swz_xor<1>(s1); s2 += swz_xor<1>(s2);
  if ((tx & 31) == 0) { float2* sp = reinterpret_cast<float2*>(stats) + (row & 255); float2 s = *sp; s.x += s1; s.y += s2; *sp = s; }
}
struct EpiResid {
  bfr* out; const bfr* hb; float* stats;
  DI void operator()(float* tile, int r0, int bcol) const {
    const int tx = tidx();
#pragma unroll
    for (int c0 = 0; c0 < 8; c0 += 4) {
      uint4 hq[4];
#pragma unroll
      for (int k4 = 0; k4 < 4; ++k4) hq[k4] = *reinterpret_cast<const uint4*>(hb + (long)(r0 + CH_LR(c0 + k4, tx)) * D + bcol + CH_LC(c0 + k4, tx));
#pragma unroll
      for (int k4 = 0; k4 < 4; ++k4) {
        const int lr = CH_LR(c0 + k4, tx), lc = CH_LC(c0 + k4, tx), row = r0 + lr;
        bfr* op = out + (long)row * D + bcol + lc;
        float v[8], o[8];
        ld8f(tile + lr * TST + lc, v); unpack8(hq[k4], o);
#pragma unroll
        for (int k = 0; k < 8; ++k) o[k] = ALPHA * o[k] + v[k];
        *reinterpret_cast<uint4*>(op) = pack8(o);
        row_stats_add(stats, row, o, tx);
      }
    }
  }
};
struct EpiPle {
  bfr* out; float* out32; const bfr* hb; const bfr* E; const float* bg; float* stats;
  DI void operator()(float* tile, int r0, int bcol) const {
    const int tx = tidx();
#pragma unroll
    for (int c0 = 0; c0 < 8; c0 += 4) {
      uint4 hq[4], eq[4];
#pragma unroll
      for (int k4 = 0; k4 < 4; ++k4) {
        const long idx = (long)(r0 + CH_LR(c0 + k4, tx)) * D + bcol + CH_LC(c0 + k4, tx);
        hq[k4] = *reinterpret_cast<const uint4*>(hb + idx);
        eq[k4] = *reinterpret_cast<const uint4*>(E + idx);
      }
#pragma unroll
      for (int k4 = 0; k4 < 4; ++k4) {
        const int lr = CH_LR(c0 + k4, tx), lc = CH_LC(c0 + k4, tx), row = r0 + lr, col = bcol + lc;
        bfr* op = out + (long)row * D + col;
        float v[8], o[8], e[8], bgv[8];
        ld8f(tile + lr * TST + lc, v); ld8f(bg + col, bgv); unpack8(eq[k4], e); unpack8(hq[k4], o);
#pragma unroll
        for (int k = 0; k < 8; ++k) o[k] = ALPHA * o[k] + e[k] * sigmoidf(v[k] + bgv[k]);
        if (out32) { float* o32 = out32 + (long)row * D + col; *reinterpret_cast<float4*>(o32) = make_float4(o[0], o[1], o[2], o[3]); *reinterpret_cast<float4*>(o32 + 4) = make_float4(o[4], o[5], o[6], o[7]); }
        else *reinterpret_cast<uint4*>(op) = pack8(o);
        row_stats_add(stats, row, o, tx);
      }
    }
  }
};
struct EpiQ {
  bfr* Q; const float* rs; const float2* rope;
  DI void operator()(float* tile, int r0, int bcol) const {
    FOR_CHUNKS(ci) { CHUNK_SETUP(ci);
      if (col < 384) {
        const int head = col / 96, d0 = col % 96; const float rstd = rs[row & 255]; const int b = row >> 11, t = row & (S - 1);
        if (d0 >= 64) {
          const bool lo = d0 < 80; const int jj = (d0 - (lo ? 64 : 80));
          float pw[8]; ld8f(tile + lr * TST + lc + (lo ? 16 : -16), pw);
#pragma unroll
          for (int k = 0; k < 8; ++k) { const float2 cs = rope[t * 16 + jj + k];
            v[k] = lo ? (v[k] * cs.x - pw[k] * cs.y) : (v[k] * cs.x + pw[k] * cs.y); }
        }
#pragma unroll
        for (int k = 0; k < 8; ++k) v[k] *= rstd;
        *reinterpret_cast<uint4*>(Q + (((long)(b * 4 + head)) * S + t) * 96 + d0) = pack8(v);
      }
    }
  }
};
struct EpiKV {
  bfr* Kf; bfr* VT; const float* rs;
  DI void operator()(float* tile, int r0, int bcol) const {
    FOR_CHUNKS(ci) { CHUNK_SETUP(ci);
      if ((col & 127) < 64) {
        const int head = col >> 7, d0 = col & 127; const float rstd = rs[row & 255]; const int b = row >> 11, t = row & (S - 1);
#pragma unroll
        for (int k = 0; k < 8; ++k) v[k] *= rstd;
        *reinterpret_cast<uint4*>(Kf + (((long)(b * 4 + head)) * S + t) * 96 + d0) = pack8(v);
      }
    }
    const int b = r0 >> 11, t0 = r0 & (S - 1);
#pragma unroll 1
    for (int it = tidx(); it < 2048; it += NTHREADS) {
      const int vc = it & 127, rc = it >> 7, lcol = (vc >> 6) * 128 + 64 + (vc & 63), lr0 = rc * 8;
      const int head = (bcol + lcol) >> 7, dd = vc & 63;
      float v[8];
#pragma unroll
      for (int k = 0; k < 8; ++k) v[k] = tile[(lr0 + k) * TST + lcol] * rs[(r0 + lr0 + k) & 255];
      *reinterpret_cast<uint4*>(VT + (((long)(b * 4 + head)) * 64 + dd) * S + t0 + lr0) = pack8(v);
    }
  }
};

#define MFMA32(a, b, c) __builtin_amdgcn_mfma_f32_32x32x16_bf16((a), (b), (c), 0, 0, 0)
template <int DQK, bool SWA>
DI void attn_item(const bfr* __restrict__ qb, long q_ld, const bfr* __restrict__ kb, long k_ld, const bfr* __restrict__ vb, long v_ld,
                  int q0, int key_lo, int key_hi, float scale_l2e, float slope_l2e, float sink_l2e,
                  bfr* __restrict__ outp, long out_ld, char* shm) {
  constexpr int KST = DQK + 8;
  constexpr int VST = 72;
  constexpr int NKK = DQK / 16;
  bfr* Ks = (bfr*)shm;
  bfr* Vt = Ks + 64 * KST;
  const int tid = tidx(), wid = tid >> 6, lane = tid & 63, r = lane & 31, h = lane >> 5;
  const int qrow = q0 + wid * 32 + r;
  bf16x8 qf[NKK];
#pragma unroll
  for (int kk = 0; kk < NKK; ++kk) qf[kk] = *reinterpret_cast<const bf16x8*>(qb + (long)qrow * q_ld + kk * 16 + h * 8);
  f32x16 o[2];
#pragma unroll
  for (int i = 0; i < 16; ++i) { o[0][i] = 0.f; o[1][i] = 0.f; }
  float mrun = SWA ? sink_l2e : -1e30f, lrun = SWA ? 1.f : 0.f;
  constexpr int KCH = DQK / 8;
  constexpr bool K2 = (64 * KCH > NTHREADS);
  uint4 pk0, pk1 = make_uint4(0, 0, 0, 0), pvv;
  const int vrow = tid >> 3, vch = tid & 7;
  const int kr0 = tid / KCH, kc0 = (tid % KCH) * 8, kr1 = (tid + NTHREADS) / KCH, kc1 = ((tid + NTHREADS) % KCH) * 8;
  const bool has1 = K2 && (tid + NTHREADS < 64 * KCH);
#define ATT_LOAD(kt_) do { \
    pk0 = *reinterpret_cast<const uint4*>(kb + (long)((kt_) + kr0) * k_ld + kc0); \
    if (has1) pk1 = *reinterpret_cast<const uint4*>(kb + (long)((kt_) + kr1) * k_ld + kc1); \
    pvv = SWA ? *reinterpret_cast<const uint4*>(vb + (long)((kt_) + vrow) * v_ld + vch * 8) \
              : *reinterpret_cast<const uint4*>(vb + (long)vrow * v_ld + (kt_) + vch * 8); } while (0)
  ATT_LOAD(key_lo);
  for (int kt = key_lo; kt < key_hi; kt += 64) {
    __syncthreads();
    *reinterpret_cast<uint4*>(Ks + kr0 * KST + kc0) = pk0;
    if (has1) *reinterpret_cast<uint4*>(Ks + kr1 * KST + kc1) = pk1;
    if (SWA) {
      bfr* vp = Vt + (vch * 8) * VST + vrow;
      vp[0 * VST] = (bfr)(pvv.x & 0xffffu); vp[1 * VST] = (bfr)(pvv.x >> 16);
      vp[2 * VST] = (bfr)(pvv.y & 0xffffu); vp[3 * VST] = (bfr)(pvv.y >> 16);
      vp[4 * VST] = (bfr)(pvv.z & 0xffffu); vp[5 * VST] = (bfr)(pvv.z >> 16);
      vp[6 * VST] = (bfr)(pvv.w & 0xffffu); vp[7 * VST] = (bfr)(pvv.w >> 16);
    } else {
      *reinterpret_cast<uint4*>(Vt + vrow * VST + vch * 8) = pvv;
    }
    if (kt + 64 < key_hi) ATT_LOAD(kt + 64);
    __syncthreads();
    const bool tile_live = !SWA || ((kt + 63 >= q0 + wid * 32 - 128) && (kt <= q0 + wid * 32 + 31 + 128));
    if (tile_live) {
    f32x16 s[2];
#pragma unroll
    for (int kh = 0; kh < 2; ++kh) {
#pragma unroll
      for (int i = 0; i < 16; ++i) s[kh][i] = 0.f;
#pragma unroll
      for (int kk = 0; kk < NKK; ++kk) {
        const bf16x8 a = *reinterpret_cast<const bf16x8*>(Ks + (kh * 32 + r) * KST + kk * 16 + h * 8);
        s[kh] = MFMA32(a, qf[kk], s[kh]);
      }
    }
    float mx = -1e30f;
    if (SWA) {
#pragma unroll
      for (int kh = 0; kh < 2; ++kh)
#pragma unroll
        for (int i = 0; i < 16; ++i) {
          const int kpos = kt + kh * 32 + (i & 3) + 8 * (i >> 2) + 4 * h;
          const int dist = abs(qrow - kpos);
          const float v = (dist <= 128) ? s[kh][i] * scale_l2e - slope_l2e * (float)dist : -1e30f;
          s[kh][i] = v; mx = fmaxf(mx, v);
        }
    } else {
#pragma unroll
      for (int kh = 0; kh < 2; ++kh)
#pragma unroll
        for (int i = 0; i < 16; ++i) mx = fmaxf(mx, s[kh][i]);
      mx *= scale_l2e;
    }
    { const auto sw_ = __builtin_amdgcn_permlane32_swap(__float_as_uint(mx), __float_as_uint(mx), false, false); mx = fmaxf(__uint_as_float(sw_[0]), __uint_as_float(sw_[1])); }
    const float mnew = fmaxf(mrun, mx);
    float ps = 0.f;
    if (SWA) {
#pragma unroll
      for (int kh = 0; kh < 2; ++kh)
#pragma unroll
        for (int i = 0; i < 16; ++i) { const float p = __builtin_amdgcn_exp2f(s[kh][i] - mnew); s[kh][i] = p; ps += p; }
    } else {
#pragma unroll
      for (int kh = 0; kh < 2; ++kh)
#pragma unroll
        for (int i = 0; i < 16; ++i) { const float p = __builtin_amdgcn_exp2f(fmaf(s[kh][i], scale_l2e, -mnew)); s[kh][i] = p; ps += p; }
    }
    { const auto sw_ = __builtin_amdgcn_permlane32_swap(__float_as_uint(ps), __float_as_uint(ps), false, false); ps = __uint_as_float(sw_[0]) + __uint_as_float(sw_[1]); }
    if (__any(mnew > mrun)) {
      const float corr = __builtin_amdgcn_exp2f(mrun - mnew);
      lrun *= corr;
#pragma unroll
      for (int i = 0; i < 16; ++i) { o[0][i] *= corr; o[1][i] *= corr; }
    }
    lrun += ps; mrun = mnew;
#pragma unroll
    for (int kh = 0; kh < 2; ++kh)
#pragma unroll
      for (int s2 = 0; s2 < 2; ++s2) {
        uint4 pbu;
        pbu.x = pack2(s[kh][8 * s2 + 0], s[kh][8 * s2 + 1]); pbu.y = pack2(s[kh][8 * s2 + 2], s[kh][8 * s2 + 3]);
        pbu.z = pack2(s[kh][8 * s2 + 4], s[kh][8 * s2 + 5]); pbu.w = pack2(s[kh][8 * s2 + 6], s[kh][8 * s2 + 7]);
        const bf16x8 pb = __builtin_bit_cast(bf16x8, pbu);
#pragma unroll
        for (int dt = 0; dt < 2; ++dt) {
          const bfr* vp = Vt + (dt * 32 + r) * VST + kh * 32 + 16 * s2 + 4 * h;
          const s16x4 lo = *reinterpret_cast<const s16x4*>(vp);
          const s16x4 hi = *reinterpret_cast<const s16x4*>(vp + 8);
          const bf16x8 a = __builtin_shufflevector(lo, hi, 0, 1, 2, 3, 4, 5, 6, 7);
          o[dt] = MFMA32(a, pb, o[dt]);
        }
      }
    }
  }
  const float inv = 1.f / lrun;
#pragma unroll
  for (int dt = 0; dt < 2; ++dt)
#pragma unroll
    for (int g = 0; g < 4; ++g) {
      uint2 pk; pk.x = pack2(o[dt][4 * g] * inv, o[dt][4 * g + 1] * inv); pk.y = pack2(o[dt][4 * g + 2] * inv, o[dt][4 * g + 3] * inv);
      *reinterpret_cast<uint2*>(outp + (long)qrow * out_ld + dt * 32 + 8 * g + 4 * h) = pk;
    }
}

DI float2 cmul(float2 a, float2 b) { return make_float2(a.x * b.x - a.y * b.y, a.x * b.y + a.y * b.x); }
DI float2 cmulc(float2 a, float2 b) { return make_float2(a.x * b.x + a.y * b.y, a.y * b.x - a.x * b.y); }
constexpr int FST_A = 272, FST_B = 17, FFT_LDS = 16 * FST_A;
DI int fpos(int n) { return (n >> 8) * FST_A + ((n >> 4) & 15) * FST_B + (n & 15); }
DI float2 twid(const float2* TW, int m) {
  const float2 w = TW[m & 2047];
  return (m & 2048) ? make_float2(-w.x, -w.y) : w;
}
DI void dft16_fwd(float2* v) {
  const float C8 = 0.92387953251128674f, S8 = 0.38268343236508977f, R2 = 0.70710678118654752f;
  const float2 w16[8] = {{1.f, 0.f}, {C8, -S8}, {R2, -R2}, {S8, -C8}, {0.f, -1.f}, {-S8, -C8}, {-R2, -R2}, {-C8, -S8}};
#pragma unroll
  for (int s = 0; s < 4; ++s) {
    const int half = 8 >> s;
#pragma unroll
    for (int j = 0; j < 8; ++j) {
      const int pos = j & (half - 1), i0 = ((j - pos) << 1) + pos, i1 = i0 + half;
      const float2 a = v[i0], b = v[i1];
      v[i0] = make_float2(a.x + b.x, a.y + b.y);
      v[i1] = cmul(make_float2(a.x - b.x, a.y - b.y), w16[pos << s]);
    }
  }
}
DI void dft16_inv(float2* v) {
  const float C8 = 0.92387953251128674f, S8 = 0.38268343236508977f, R2 = 0.70710678118654752f;
  const float2 w16[8] = {{1.f, 0.f}, {C8, -S8}, {R2, -R2}, {S8, -C8}, {0.f, -1.f}, {-S8, -C8}, {-R2, -R2}, {-C8, -S8}};
#pragma unroll
  for (int s = 3; s >= 0; --s) {
    const int half = 8 >> s;
#pragma unroll
    for (int j = 0; j < 8; ++j) {
      const int pos = j & (half - 1), i0 = ((j - pos) << 1) + pos, i1 = i0 + half;
      const float2 a = v[i0], b = cmulc(v[i1], w16[pos << s]);
      v[i0] = make_float2(a.x + b.x, a.y + b.y);
      v[i1] = make_float2(a.x - b.x, a.y - b.y);
    }
  }
}
DI int brev4(int i) { return ((i & 1) << 3) | ((i & 2) << 1) | ((i & 4) >> 1) | ((i & 8) >> 3); }
DI void fft_fwd(float2* X, const float2* TW, const int t) {
  float2 v[16];
  const int hi = t >> 4, lo = t & 15;
  {
    float2* p = X + hi * FST_B + lo;
#pragma unroll
    for (int i = 0; i < 16; ++i) v[i] = p[i * FST_A];
    dft16_fwd(v);
#pragma unroll
    for (int i = 0; i < 16; ++i) p[i * FST_A] = cmul(v[i], twid(TW, t * brev4(i)));
  }
  __syncthreads();
  {
    float2* p = X + hi * FST_A + lo;
#pragma unroll
    for (int i = 0; i < 16; ++i) v[i] = p[i * FST_B];
    dft16_fwd(v);
#pragma unroll
    for (int i = 0; i < 16; ++i) p[i * FST_B] = cmul(v[i], twid(TW, 16 * lo * brev4(i)));
  }
  __syncthreads();
  {
    float2* p = X + hi * FST_A + lo * FST_B;
#pragma unroll
    for (int i = 0; i < 16; ++i) v[i] = p[i];
    dft16_fwd(v);
#pragma unroll
    for (int i = 0; i < 16; ++i) p[i] = v[i];
  }
  __syncthreads();
}
DI void fft_inv(float2* X, const float2* TW, const int t) {
  float2 v[16];
  const int hi = t >> 4, lo = t & 15;
  {
    float2* p = X + hi * FST_A + lo * FST_B;
#pragma unroll
    for (int i = 0; i < 16; ++i) v[i] = p[i];
    dft16_inv(v);
#pragma unroll
    for (int i = 0; i < 16; ++i) p[i] = v[i];
  }
  __syncthreads();
  {
    float2* p = X + hi * FST_A + lo;
#pragma unroll
    for (int i = 0; i < 16; ++i) v[i] = cmulc(p[i * FST_B], twid(TW, 16 * lo * brev4(i)));
    dft16_inv(v);
#pragma unroll
    for (int i = 0; i < 16; ++i) p[i * FST_B] = v[i];
  }
  __syncthreads();
  {
    float2* p = X + hi * FST_B + lo;
#pragma unroll
    for (int i = 0; i < 16; ++i) v[i] = cmulc(p[i * FST_A], twid(TW, t * brev4(i)));
    dft16_inv(v);
#pragma unroll
    for (int i = 0; i < 16; ++i) p[i * FST_A] = v[i];
  }
  __syncthreads();
}

DI void transpose_convert(const float* src, int K, int N, bfr* dst, int Kp, int Np, const float* kscale, char* shm) {
  float* tile = (float*)shm;
  const int tk = Kp / 64, tn = Np / 64;
  const int tid = tidx();
#pragma unroll 1
  for (int it = blockIdx.x; it < tk * tn; it += gridDim.x) {
    const int k0 = (it % tk) * 64, n0 = (it / tk) * 64;
    __syncthreads();
    float4 v[2];
#pragma unroll
    for (int q = 0; q < 2; ++q) {
      const int idx = tid + q * NTHREADS, kk = idx >> 4, n4 = (idx & 15) * 4, k = k0 + kk, n = n0 + n4;
      v[q] = make_float4(0.f, 0.f, 0.f, 0.f);
      if (k < K && n < N) { v[q] = *reinterpret_cast<const float4*>(src + (long)k * N + n); if (kscale) { const float sc = kscale[k]; v[q].x *= sc; v[q].y *= sc; v[q].z *= sc; v[q].w *= sc; } }
    }
#pragma unroll
    for (int q = 0; q < 2; ++q) { const int idx = tid + q * NTHREADS; *reinterpret_cast<float4*>(tile + (idx >> 4) * 68 + (idx & 15) * 4) = v[q]; }
    __syncthreads();
#pragma unroll
    for (int q = 0; q < 2; ++q) {
      const int idx = tid + q * NTHREADS, nn = idx >> 4, k4 = (idx & 15) * 4;
      uint2 pk; pk.x = pack2(tile[k4 * 68 + nn], tile[(k4 + 1) * 68 + nn]); pk.y = pack2(tile[(k4 + 2) * 68 + nn], tile[(k4 + 3) * 68 + nn]);
      *reinterpret_cast<uint2*>(dst + (long)(n0 + nn) * Kp + k0 + k4) = pk;
    }
  }
}

DI void ln_rows(const float* src, float* dst32, bfr* dstb, const float* g, const float* bta) {
  const int wid = tidx() >> 6, lane = tidx() & 63;
#pragma unroll 1
  for (int row0 = (blockIdx.x * 8 + wid) * 2; row0 < NT; row0 += gridDim.x * 16) {
    float4 v[2][4];
#pragma unroll
    for (int q = 0; q < 2; ++q)
#pragma unroll
      for (int i = 0; i < 4; ++i) v[q][i] = reinterpret_cast<const float4*>(src + (long)(row0 + q) * D)[i * 64 + lane];
#pragma unroll
    for (int q = 0; q < 2; ++q) {
      const int row = row0 + q;
      float sum = 0.f;
#pragma unroll
      for (int i = 0; i < 4; ++i) sum += v[q][i].x + v[q][i].y + v[q][i].z + v[q][i].w;
#pragma unroll
      for (int o = 32; o >= 1; o >>= 1) sum += __shfl_xor(sum, o);
      const float mu = sum * (1.f / D);
      float sq = 0.f;
#pragma unroll
      for (int i = 0; i < 4; ++i) { v[q][i].x -= mu; v[q][i].y -= mu; v[q][i].z -= mu; v[q][i].w -= mu; sq += v[q][i].x * v[q][i].x + v[q][i].y * v[q][i].y + v[q][i].z * v[q][i].z + v[q][i].w * v[q][i].w; }
#pragma unroll
      for (int o = 32; o >= 1; o >>= 1) sq += __shfl_xor(sq, o);
      const float rstd = rsqrtf(sq * (1.f / D) + 1e-5f);
#pragma unroll
      for (int i = 0; i < 4; ++i) {
        const int c4 = i * 64 + lane;
        const float4 gg = reinterpret_cast<const float4*>(g)[c4], bb = reinterpret_cast<const float4*>(bta)[c4];
        float4 y; y.x = v[q][i].x * rstd * gg.x + bb.x; y.y = v[q][i].y * rstd * gg.y + bb.y; y.z = v[q][i].z * rstd * gg.z + bb.z; y.w = v[q][i].w * rstd * gg.w + bb.w;
        if (dst32) reinterpret_cast<float4*>(dst32 + (long)row * D)[c4] = y;
        uint2 pk; pk.x = pack2(y.x, y.y); pk.y = pack2(y.z, y.w);
        reinterpret_cast<uint2*>(dstb + (long)row * D)[c4] = pk;
      }
    }
  }
}

DI void phase_prep(const PX& P, char* shm) {
  char* ws = P.ws;
  for (int l = 0; l < NL; ++l) {
    bfr* W = (bfr*)(ws + WS_W) + (size_t)l * EW_LAYER;
    transpose_convert(P.in[4] + (size_t)l * 1024 * INW, 1024, INW, W + WO_IN, 1024, 2816, nullptr, shm);
    transpose_convert(P.in[7] + (size_t)l * 256 * 384, 256, 384, W + WO_UQ, 256, 512, P.in[5] + l * 256, shm);
    transpose_convert(P.in[8] + (size_t)l * 128 * 512, 128, 512, W + WO_UKV, 256, 512, P.in[6] + l * 128, shm);
    transpose_convert(P.in[25] + (size_t)l * 1024 * 1024, 1024, 1024, W + WO_OUT, 1024, 1024, P.in[24] + l * 1024, shm);
    transpose_convert(P.in[28] + (size_t)l * 1024 * DFF, 1024, DFF, W + WO_G, 1024, DFF, nullptr, shm);
    transpose_convert(P.in[29] + (size_t)l * 1024 * DFF, 1024, DFF, W + WO_U, 1024, DFF, nullptr, shm);
    transpose_convert(P.in[32] + (size_t)l * DFF * 1024, DFF, 1024, W + WO_D, DFF, 1024, nullptr, shm);
    transpose_convert(P.in[35] + (size_t)l * 256 * 1024, 256, 1024, W + WO_PP, 256, 1024, nullptr, shm);
    transpose_convert(P.in[36] + (size_t)l * 1024 * 1024, 1024, 1024, W + WO_PG, 1024, 1024, nullptr, shm);
  }
  __syncthreads();
  {
    float2* rope = (float2*)(ws + WS_ROPE);
    float2* tw = (float2*)(ws + WS_TW);
    for (int e = blockIdx.x * NTHREADS + tidx(); e < 2048 * 16 + 2048; e += gridDim.x * NTHREADS) {
      if (e < 2048 * 16) {
        const int t = e >> 4, j = e & 15;
        const float invf = exp2f(-(float)j * (13.287712379549449f / 16.0f));
        const float ang = (float)t * invf;
        float sn, cs; sincosf(ang, &sn, &cs);
        rope[e] = make_float2(cs, sn);
      } else {
        const int k = e - 2048 * 16;
        float sn, cs; sincospif((float)k * (1.0f / 2048.0f), &sn, &cs);
        tw[k] = make_float2(cs, -sn);
      }
    }
  }
  {
    float* sm = (float*)shm;
    float* kbuf = (float*)(ws + WS_KBUF);
    const int tid = tidx();
#pragma unroll 1
    for (int it = blockIdx.x; it < NL * (S / 4); it += gridDim.x) {
      const int l = it / (S / 4), tb = (it % (S / 4)) * 4;
      const float* w1 = P.in[11] + l * 33 * 64; const float* b1 = P.in[12] + l * 64; const float* fq = P.in[13] + l * 64;
      const float* w2 = P.in[14] + l * 64 * 64; const float* b2 = P.in[15] + l * 64; const float* w3 = P.in[16] + (size_t)l * 64 * 1024;
      __syncthreads();
      if (tid < 4 * 33) {
        const int q = tid / 33, i = tid % 33, t = tb + q;
        float f;
        if (i == 0) f = (float)t / 2047.0f;
        else {
          const int bi = (i - 1) & 15;
          const float band = 1e-4f + (float)bi * ((15.0f - 1e-4f) / 15.0f);
          const float ang = 6.283185307179586f * (float)t / 2048.0f;
          const float a = band * ang;
          f = (i <= 16) ? cosf(a) : -sinf(a);
        }
        sm[q * 64 + i] = f;
      }
      __syncthreads();
      if (tid < 256) {
        const int q = tid >> 6, j = tid & 63; float a = b1[j];
        for (int i = 0; i < 33; ++i) a += sm[q * 64 + i] * w1[i * 64 + j];
        sm[256 + q * 64 + j] = sinf(fq[j] * a);
      }
      __syncthreads();
      if (tid < 256) {
        const int q = tid >> 6, j = tid & 63; float a = b2[j];
        for (int i = 0; i < 64; ++i) a += sm[256 + q * 64 + i] * w2[i * 64 + j];
        sm[512 + q * 64 + j] = sinf(fq[j] * a);
      }
      __syncthreads();
#pragma unroll 1
      for (int oc = tid; oc < 1024; oc += NTHREADS) {
        float a0 = 0.f, a1 = 0.f, a2 = 0.f, a3 = 0.f;
#pragma unroll 8
        for (int i = 0; i < 64; ++i) { const float w = w3[i * 1024 + oc]; a0 += sm[512 + i] * w; a1 += sm[576 + i] * w; a2 += sm[640 + i] * w; a3 += sm[704 + i] * w; }
        const int o = oc >> 9, dir = (oc >> 8) & 1, c = oc & 255;
        const float mind = -3.0701134573253945f, maxd = -15.350567286626973f;
        const float delta = fabsf(mind + (float)c * ((maxd - mind) / 255.0f));
        float* kb = kbuf + ((size_t)((l * 2 + o) * 256 + c)) * 4096;
        const float av[4] = {a0, a1, a2, a3};
#pragma unroll
        for (int q = 0; q < 4; ++q) {
          const int t = tb + q;
          const float a = av[q] * expf(-((float)t / 2047.0f) * delta);
          if (dir == 0) kb[t] = a;
          else { if (t == 0) kb[2048] = 0.f; else kb[4096 - t] = a; }
        }
      }
    }
  }
  ln_rows(P.in[0], nullptr, (bfr*)(ws + WS_HB), P.in[2], P.in[3]);
}

DI void phase_gemm_in(const PX& P, int l, char* shm, int skip = 0) {
  const bfr* A = (const bfr*)(P.ws + WS_HB);
  const bfr* Bt = (const bfr*)(P.ws + WS_W) + (size_t)l * EW_LAYER + WO_IN;
  EpiStoreBf16 epi{(bfr*)(P.ws + WS_U), INP};
  for (int u = blockIdx.x; u < 256 * 11; u += gridDim.x) {
    int pm, pn; unit_to_tile(u, 256, 11, pm, pn);
#if PROBE_GEMM
    if (skip) gemm_unit<1024, 1024, EpiStoreBf16, PROBE_GEMM>(A, Bt, 1024, pm * 256, pn * 256, shm, epi);
    else
#endif
    gemm_unit<1024, 1024>(A, Bt, 1024, pm * 256, pn * 256, shm, epi);
  }
}

template <int NCOL>
DI void row_rstd(const bfr* Ucol, int brow, float* rs) {
  const int r = tidx() >> 1, hf = tidx() & 1;
  const unsigned uoff = (unsigned)(brow + r) * (unsigned)INP + (unsigned)(hf * NCOL);
  const bfr* up = Ucol + uoff;
  float ss = 0.f;
  uint4 q[NCOL / 8];
#pragma unroll
  for (int c = 0; c < NCOL / 8; ++c) q[c] = *reinterpret_cast<const uint4*>(up + c * 8);
#pragma unroll
  for (int c = 0; c < NCOL / 8; ++c) {
    float f[8]; unpack8(q[c], f);
#pragma unroll
    for (int e = 0; e < 8; ++e) ss += f[e] * f[e];
  }
  ss += __shfl_xor(ss, 1);
  if (hf == 0) rs[r] = rsqrtf(ss / (float)(2 * NCOL) + 1e-6f);
  __syncthreads();
}

DI void phase_premix(const PX& P, int l, char* shm) {
  char* ws = P.ws;
  const bfr* U = (const bfr*)(ws + WS_U);
  const bfr* W = (const bfr*)(ws + WS_W) + (size_t)l * EW_LAYER;
  float* rs = (float*)(shm + 135168);
  const float2* rope = (const float2*)(ws + WS_ROPE);
#ifndef SKIP_Q
  {
    EpiQ epi{(bfr*)(ws + WS_Q), rs, rope};
#pragma unroll 1
    for (int it = blockIdx.x; it < 512; it += gridDim.x) {
      const int pn = it & 1, brow = (it >> 1) * 256;
      row_rstd<128>(U + OQ, brow, rs);
      gemm_unit<INP, 256>(U + OQ, W + WO_UQ, 256, brow, pn * 256, shm, epi);
    }
  }
#endif
#ifndef SKIP_KV
  {
    EpiKV epi{(bfr*)(ws + WS_K), (bfr*)(ws + WS_VT), rs};
#pragma unroll 1
    for (int it = blockIdx.x; it < 512; it += gridDim.x) {
      const int pn = it & 1, brow = (it >> 1) * 256;
      row_rstd<64>(U + OKV, brow, rs);
      gemm_unit<INP, 256>(U + OKV, W + WO_UKV, 256, brow, pn * 256, shm, epi);
    }
  }
#endif
  {
    bfr* Kf = (bfr*)(ws + WS_K);
    for (long e = (long)blockIdx.x * NTHREADS + tidx(); e < (long)NT * 16; e += (long)gridDim.x * NTHREADS) {
      const int jj = (int)(e & 15); const long row = e >> 4; const int b = (int)(row >> 11), t = (int)(row & (S - 1));
      const float x1 = bf2f(U[row * INP + OKR + jj]), x2 = bf2f(U[row * INP + OKR + 16 + jj]);
      const float2 cs = rope[t * 16 + jj];
      const bfr o1 = f2bf(x1 * cs.x - x2 * cs.y), o2 = f2bf(x2 * cs.x + x1 * cs.y);
#pragma unroll
      for (int hh = 0; hh < 4; ++hh) {
        bfr* kp = Kf + (((long)(b * 4 + hh)) * S + t) * 96 + 64 + jj;
        kp[0] = o1; kp[16] = o2;
      }
    }
  }
  {
    bfr* tile = (bfr*)shm;
    bfr* HYT = (bfr*)(ws + WS_HYT);
    const float* cw = P.in[9] + l * 3 * 768; const float* cbias = P.in[10] + l * 768;
    const int tid = tidx();
#pragma unroll 1
    for (int it = blockIdx.x; it < 1024; it += gridDim.x) {
      const int b = it >> 5, t0 = (it & 31) * 64;
      __syncthreads();
#pragma unroll 1
      for (int e0 = tid; e0 < 96 * 64; e0 += 4 * NTHREADS) {
        uint4 q0[4], qm[4], qp[4];
#pragma unroll
        for (int i = 0; i < 4; ++i) {
          const int e = e0 + i * NTHREADS, c8 = e % 96, tl = e / 96, t = t0 + tl;
          const bfr* ub = U + ((long)b * S + t) * INP + OHY + c8 * 8;
          q0[i] = *reinterpret_cast<const uint4*>(ub);
          qm[i] = make_uint4(0, 0, 0, 0); qp[i] = make_uint4(0, 0, 0, 0);
          if (t > 0) qm[i] = *reinterpret_cast<const uint4*>(ub - INP);
          if (t < S - 1) qp[i] = *reinterpret_cast<const uint4*>(ub + INP);
        }
#pragma unroll
        for (int i = 0; i < 4; ++i) {
          const int e = e0 + i * NTHREADS, c8 = e % 96, tl = e / 96, c = c8 * 8;
          float u0[8], um[8], up[8], w[8], a[8];
          unpack8(q0[i], u0); unpack8(qm[i], um); unpack8(qp[i], up);
          ld8f(cbias + c, a);
          ld8f(cw + c, w);
#pragma unroll
          for (int j = 0; j < 8; ++j) a[j] += w[j] * um[j];
          ld8f(cw + 768 + c, w);
#pragma unroll
          for (int j = 0; j < 8; ++j) a[j] += w[j] * u0[j];
          ld8f(cw + 1536 + c, w);
          const int tr = (tl + 2 * c8) & 63;
#pragma unroll
          for (int j = 0; j < 8; ++j) tile[(c + j) * 66 + tr] = f2bf(a[j] + w[j] * up[j]);
        }
      }
      __syncthreads();
#pragma unroll 1
      for (int e = tid; e < 768 * 8; e += NTHREADS) {
        const int c = e >> 3, ch = e & 7, rot = c >> 3;
        const unsigned* tp = reinterpret_cast<const unsigned*>(tile + c * 66);
        uint4 v; v.x = tp[(ch * 4 + rot) & 31]; v.y = tp[(ch * 4 + 1 + rot) & 31]; v.z = tp[(ch * 4 + 2 + rot) & 31]; v.w = tp[(ch * 4 + 3 + rot) & 31];
        *reinterpret_cast<uint4*>(HYT + ((long)(b * 768 + c)) * S + t0 + ch * 8) = v;
      }
    }
  }
  if (l == 0) {
    const int tid = tidx(), hw = tid >> 8, t = tid & 255;
    float2* X = (float2*)shm + hw * FFT_LDS; float2* TW = (float2*)(shm + 2 * FFT_LDS * 8);
    const float* kbuf = (const float*)(ws + WS_KBUF);
    float2* KF = (float2*)(ws + WS_KF);
    const float2* twg = (const float2*)(ws + WS_TW);
    for (int it0 = blockIdx.x * 2; it0 < 1024; it0 += gridDim.x * 2) {
      const int it = it0 + hw;
      __syncthreads();
      for (int e = tid; e < 2048; e += NTHREADS) TW[e] = twg[e];
      for (int e = t; e < 4096; e += 256) X[fpos(e)] = make_float2(kbuf[(size_t)it * 4096 + e], 0.f);
      __syncthreads();
      fft_fwd(X, TW, t);
      for (int e = t; e < 4096; e += 256) { const float2 v = X[fpos(e)]; KF[(size_t)it * 4096 + e] = make_float2(v.x * (1.f / 4096.f), v.y * (1.f / 4096.f)); }
    }
  }
}

DI void ssd_item(const PX& P, int l, int item, char* shm) {
  constexpr int ST = 136;
  const bfr* U = (const bfr*)(P.ws + WS_U);
  bfr* YS = (bfr*)(P.ws + WS_YSSD);
  const int b = item >> 3, dir = (item >> 2) & 1, hd = item & 3, g = hd >> 1;
  const int tid = tidx(), wid = tid >> 6, lane = tid & 63, r = lane & 31, h = lane >> 5;
  const float* cw = P.in[19] + l * 3 * 768; const float* cbias = P.in[20] + l * 768;
  const float dtb = P.in[21][l * 8 + dir * 4 + hd];
  const float Acoef = -__expf(P.in[22][l * 8 + dir * 4 + hd]);
  bfr* Cs = (bfr*)shm;
  bfr* Bs = Cs + 128 * ST;
  bfr* BTd = Bs + 128 * ST;
  bfr* XT = BTd + 128 * ST;
  bfr* Rb = XT + 64 * ST;
  float* acs = (float*)(Rb + 64 * ST);
  float* dts = acs + 128;
  f32x16 racc;
#pragma unroll
  for (int i = 0; i < 16; ++i) racc[i] = 0.f;
  for (int e = tid; e < 64 * ST / 2; e += NTHREADS) reinterpret_cast<unsigned*>(Rb)[e] = 0u;
  float xr_next[2] = {0.f, 0.f};
  if (wid == 0) {
#pragma unroll
    for (int q = 0; q < 2; ++q) {
      const int k = lane * 2 + q, t = dir == 0 ? k : S - 1 - k;
      xr_next[q] = bf2f(U[((long)b * S + t) * INP + ODT + dir * 4 + hd]);
    }
  }
#pragma unroll 1
  for (int ci = 0; ci < 16; ++ci) {
    __syncthreads();
    if (wid == 0) {
      float a2[2], d2[2];
#pragma unroll
      for (int q = 0; q < 2; ++q) {
        const float xr = xr_next[q] + dtb;
        d2[q] = xr > 20.f ? xr : log1pf(__expf(xr));
        a2[q] = d2[q] * Acoef;
      }
      if (ci + 1 < 16) {
#pragma unroll
        for (int q = 0; q < 2; ++q) {
          const int k = lane * 2 + q, step = (ci + 1) * 128 + k, t = dir == 0 ? step : S - 1 - step;
          xr_next[q] = bf2f(U[((long)b * S + t) * INP + ODT + dir * 4 + hd]);
        }
      }
      const float pairsum = a2[0] + a2[1];
      float sc = pairsum;
      int lane_o = lane; asm volatile("" : "+v"(lane_o));
#pragma unroll
      for (int o = 1; o < 64; o <<= 1) { const float v = __shfl_up(sc, o); sc += (lane_o >= o) ? v : 0.f; }
      acs[lane * 2] = sc - a2[1]; acs[lane * 2 + 1] = sc;
      dts[lane * 2] = d2[0]; dts[lane * 2 + 1] = d2[1];
    }
    __syncthreads();
    const float atot = acs[127];
#pragma unroll 1
    for (int i0 = 0; i0 < 10; i0 += 5) {
      uint4 q0[5], qm[5], qp[5];
#pragma unroll
      for (int i = 0; i < 5; ++i) {
        const int it = tid + (i0 + i) * NTHREADS, k = it / 40, cc8 = it % 40;
        const int step = ci * 128 + k, t = dir == 0 ? step : S - 1 - step;
        const int col = cc8 < 8 ? hd * 64 + cc8 * 8 : (cc8 < 24 ? 256 + g * 128 + (cc8 - 8) * 8 : 512 + g * 128 + (cc8 - 24) * 8);
        const bfr* ub = U + ((long)b * S + t) * INP + OXBC + col;
        q0[i] = *reinterpret_cast<const uint4*>(ub);
        qm[i] = make_uint4(0, 0, 0, 0); qp[i] = make_uint4(0, 0, 0, 0);
        if (t > 0) qm[i] = *reinterpret_cast<const uint4*>(ub - INP);
        if (t < S - 1) qp[i] = *reinterpret_cast<const uint4*>(ub + INP);
      }
#pragma unroll
      for (int i = 0; i < 5; ++i) {
        const int it = tid + (i0 + i) * NTHREADS, k = it / 40, cc8 = it % 40;
        const int col = cc8 < 8 ? hd * 64 + cc8 * 8 : (cc8 < 24 ? 256 + g * 128 + (cc8 - 8) * 8 : 512 + g * 128 + (cc8 - 24) * 8);
        float u0[8], um[8], up[8], w[8], a[8];
        unpack8(q0[i], u0); unpack8(qm[i], um); unpack8(qp[i], up);
        ld8f(cbias + col, a);
        ld8f(cw + col, w);
#pragma unroll
        for (int j = 0; j < 8; ++j) a[j] += w[j] * um[j];
        ld8f(cw + 768 + col, w);
#pragma unroll
        for (int j = 0; j < 8; ++j) a[j] += w[j] * u0[j];
        ld8f(cw + 1536 + col, w);
#pragma unroll
        for (int j = 0; j < 8; ++j) a[j] = silu(a[j] + w[j] * up[j]);
        if (cc8 < 8) {
          const float dtk = dts[k];
#pragma unroll
          for (int j = 0; j < 8; ++j) XT[(cc8 * 8 + j) * ST + ((((k >> 3) ^ cc8) << 3) | (k & 7))] = f2bf(a[j] * dtk);
        } else if (cc8 < 24) {
          const int n0 = (cc8 - 8) * 8;
          *reinterpret_cast<uint4*>(Bs + k * ST + n0) = pack8(a);
          const float dec = __expf(atot - acs[k]);
#pragma unroll
          for (int j = 0; j < 8; ++j) BTd[(n0 + j) * ST + ((((k >> 3) ^ (cc8 - 8)) << 3) | (k & 7))] = f2bf(a[j] * dec);
        } else {
          *reinterpret_cast<uint4*>(Cs + k * ST + (cc8 - 24) * 8) = pack8(a);
        }
      }
    }
    __syncthreads();
    const int ti = wid >> 1;
    f32x16 cb[2];
#pragma unroll
    for (int q = 0; q < 2; ++q) {
      const int si = (wid & 1) * 2 + q;
#pragma unroll
      for (int i = 0; i < 16; ++i) cb[q][i] = 0.f;
      if (si <= ti) {
#pragma unroll
        for (int kk = 0; kk < 8; ++kk) {
          const bf16x8 av = *reinterpret_cast<const bf16x8*>(Cs + (32 * ti + r) * ST + kk * 16 + h * 8);
          const bf16x8 bv = *reinterpret_cast<const bf16x8*>(Bs + (32 * si + r) * ST + kk * 16 + h * 8);
          cb[q] = MFMA32(av, bv, cb[q]);
        }
      }
    }
    __syncthreads();
#pragma unroll
    for (int q = 0; q < 2; ++q) {
      const int si = (wid & 1) * 2 + q; int s = 32 * si + r; asm volatile("" : "+v"(s));
      const float as = acs[s];
#pragma unroll
      for (int i = 0; i < 16; ++i) {
        const int t = 32 * ti + (i & 3) + 8 * (i >> 2) + 4 * h;
        const float v = (s <= t) ? cb[q][i] * __expf(acs[t] - as) : 0.f;
        Bs[t * ST + s] = f2bf(v);
      }
    }
    __syncthreads();
    {
      const int pi = wid & 1;
      f32x16 y1, y2;
#pragma unroll
      for (int i = 0; i < 16; ++i) { y1[i] = 0.f; y2[i] = 0.f; }
#pragma unroll
      for (int kk = 0; kk < 8; ++kk) {
        const bf16x8 xv = *reinterpret_cast<const bf16x8*>(XT + (32 * pi + r) * ST + (((kk * 2 + h) ^ (((32 * pi + r) >> 3) & 7)) << 3));
        if (kk * 16 < 32 * ti + 32) {
          const bf16x8 mv = *reinterpret_cast<const bf16x8*>(Bs + (32 * ti + r) * ST + kk * 16 + h * 8);
          y1 = MFMA32(mv, xv, y1);
        }
        const bf16x8 cv = *reinterpret_cast<const bf16x8*>(Cs + (32 * ti + r) * ST + kk * 16 + h * 8);
        const bf16x8 rv = *reinterpret_cast<const bf16x8*>(Rb + (32 * pi + r) * ST + kk * 16 + h * 8);
        y2 = MFMA32(cv, rv, y2);
      }
#pragma unroll
      for (int i = 0; i < 16; ++i) {
        const int k = 32 * ti + (i & 3) + 8 * (i >> 2) + 4 * h;
        const int step = ci * 128 + k, t = dir == 0 ? step : S - 1 - step;
        const float y = y1[i] + __expf(acs[k]) * y2[i];
        YS[((size_t)dir * NT + (size_t)b * S + t) * 256 + hd * 64 + 32 * pi + r] = f2bf(y);
      }
    }
    {
      const int pi = wid >> 2, ni = wid & 3;
      const float ed = __expf(atot);
#pragma unroll
      for (int i = 0; i < 16; ++i) racc[i] *= ed;
#pragma unroll
      for (int kk = 0; kk < 8; ++kk) {
        const bf16x8 xv = *reinterpret_cast<const bf16x8*>(XT + (32 * pi + r) * ST + (((kk * 2 + h) ^ (((32 * pi + r) >> 3) & 7)) << 3));
        const bf16x8 bv = *reinterpret_cast<const bf16x8*>(BTd + (32 * ni + r) * ST + (((kk * 2 + h) ^ (((32 * ni + r) >> 3) & 15)) << 3));
        racc = MFMA32(xv, bv, racc);
      }
      __syncthreads();
#pragma unroll
      for (int i = 0; i < 16; ++i) Rb[(32 * pi + (i & 3) + 8 * (i >> 2) + 4 * h) * ST + 32 * ni + r] = f2bf(racc[i]);
    }
  }
}

DI void hyena_item(const PX& P, int l, int item0, char* shm) {
  const int tid = tidx(), hw = tid >> 8, t = tid & 255;
  const int item = item0 + hw;
  const int c = item >> 4, bp = item & 15, b0 = bp * 2, b1 = b0 + 1;
  float2* X = (float2*)shm + hw * FFT_LDS;
  float2* TW = (float2*)(shm + 2 * FFT_LDS * 8);
  float2* Z1 = TW + 2048 + hw * 2048;
  const bfr* HYT = (const bfr*)(P.ws + WS_HYT);
  const float2* twg = (const float2*)(P.ws + WS_TW);
  const float2* KF0 = (const float2*)(P.ws + WS_KF) + ((size_t)((l * 2 + 0) * 256 + c)) * 4096;
  const float2* KF1 = (const float2*)(P.ws + WS_KF) + ((size_t)((l * 2 + 1) * 256 + c)) * 4096;
  const float bias0 = P.in[17][(l * 2 + 0) * 256 + c], bias1 = P.in[17][(l * 2 + 1) * 256 + c];
  const bfr* v0 = HYT + ((size_t)(b0 * 768 + c)) * S; const bfr* v1 = HYT + ((size_t)(b1 * 768 + c)) * S;
  const bfr* x10 = v0 + 256 * S; const bfr* x11 = v1 + 256 * S;
  const bfr* x20 = v0 + 512 * S; const bfr* x21 = v1 + 512 * S;
  bfr* yo0 = (bfr*)(P.ws + WS_YH) + ((size_t)(b0 * 256 + c)) * S; bfr* yo1 = (bfr*)(P.ws + WS_YH) + ((size_t)(b1 * 256 + c)) * S;
  __syncthreads();
  for (int e = tid; e < 2048; e += NTHREADS) TW[e] = twg[e];
  {
    float a[8], b[8];
    unpack8(*reinterpret_cast<const uint4*>(v0 + t * 8), a); unpack8(*reinterpret_cast<const uint4*>(v1 + t * 8), b);
#pragma unroll
    for (int k = 0; k < 8; ++k) { X[fpos(t * 8 + k)] = make_float2(a[k], b[k]); X[fpos(2048 + t * 8 + k)] = make_float2(0.f, 0.f); }
  }
  __syncthreads();
  fft_fwd(X, TW, t);
  { float2 kf[16];
#pragma unroll
    for (int i = 0; i < 16; ++i) kf[i] = KF0[t + i * 256];
#pragma unroll
    for (int i = 0; i < 16; ++i) { const int p = fpos(t + i * 256); X[p] = cmul(X[p], kf[i]); } }
  __syncthreads();
  fft_inv(X, TW, t);
  {
    float a[8], b[8], g0[8], g1[8];
    unpack8(*reinterpret_cast<const uint4*>(v0 + t * 8), a); unpack8(*reinterpret_cast<const uint4*>(v1 + t * 8), b);
    unpack8(*reinterpret_cast<const uint4*>(x10 + t * 8), g0); unpack8(*reinterpret_cast<const uint4*>(x11 + t * 8), g1);
    float2 z[8];
#pragma unroll
    for (int k = 0; k < 8; ++k) { const float2 y = X[fpos(t * 8 + k)]; z[k] = make_float2(g0[k] * (y.x + bias0 * a[k]), g1[k] * (y.y + bias0 * b[k])); }
    __syncthreads();
#pragma unroll
    for (int k = 0; k < 8; ++k) { Z1[t * 8 + k] = z[k]; X[fpos(t * 8 + k)] = z[k]; X[fpos(2048 + t * 8 + k)] = make_float2(0.f, 0.f); }
  }
  __syncthreads();
  fft_fwd(X, TW, t);
  { float2 kf[16];
#pragma unroll
    for (int i = 0; i < 16; ++i) kf[i] = KF1[t + i * 256];
#pragma unroll
    for (int i = 0; i < 16; ++i) { const int p = fpos(t + i * 256); X[p] = cmul(X[p], kf[i]); } }
  __syncthreads();
  fft_inv(X, TW, t);
  {
    float g0[8], g1[8], o0[8], o1[8];
    unpack8(*reinterpret_cast<const uint4*>(x20 + t * 8), g0); unpack8(*reinterpret_cast<const uint4*>(x21 + t * 8), g1);
#pragma unroll
    for (int k = 0; k < 8; ++k) { const float2 y = X[fpos(t * 8 + k)], z1 = Z1[t * 8 + k]; o0[k] = g0[k] * (y.x + bias1 * z1.x); o1[k] = g1[k] * (y.y + bias1 * z1.y); }
    *reinterpret_cast<uint4*>(yo0 + t * 8) = pack8(o0); *reinterpret_cast<uint4*>(yo1 + t * 8) = pack8(o1);
  }
}

DI void phase_mix(const PX& P, int l, char* shm) {
  char* ws = P.ws;
  for (int rep = 0; rep < ((PROBE_MIX & 1) ? 2 : 1); ++rep)
  for (int it = blockIdx.x; it < 256; it += gridDim.x) ssd_item(P, l, it, shm);
  {
    const float sc = 0.10206207261596575f * LOG2E;
    for (int it = blockIdx.x; it < 1024; it += gridDim.x) {
      const int qblk = it & 7, bh = it >> 3, b = bh >> 2, hh = bh & 3;
      const bfr* q = (const bfr*)(ws + WS_Q) + (size_t)bh * S * 96;
      const bfr* k = (const bfr*)(ws + WS_K) + (size_t)bh * S * 96;
      const bfr* vt = (const bfr*)(ws + WS_VT) + (size_t)bh * 64 * S;
      bfr* o = (bfr*)(ws + WS_Y) + (size_t)b * S * 512 + hh * 64;
      attn_item<96, false>(q, 96, k, 96, vt, S, qblk * 256, 0, S, sc, 0.f, 0.f, o, 512, shm);
    }
  }
  {
    const bfr* U = (const bfr*)(ws + WS_U);
    for (int it = blockIdx.x; it < 1024; it += gridDim.x) {
      const int qblk = it & 7, bh = it >> 3, b = bh >> 2, hh = bh & 3, kvh = hh >> 1;
      const bfr* q = U + (size_t)b * S * INP + OSQ + hh * 64;
      const bfr* k = U + (size_t)b * S * INP + OSK + kvh * 64;
      const bfr* v = U + (size_t)b * S * INP + OSV + kvh * 64;
      bfr* o = (bfr*)(ws + WS_Y) + (size_t)b * S * 512 + 256 + hh * 64;
      const int q0 = qblk * 256, klo = max(q0 - 128, 0), khi = min(q0 + 256 + 128, S);
      const float slope = exp2f(-2.f * (float)(hh + 1));
      attn_item<64, true>(q, INP, k, INP, v, INP, q0, klo, khi, 0.125f * LOG2E, slope * LOG2E, P.in[18][l * 4 + hh] * LOG2E, o, 512, shm);
    }
  }
  for (int rep = 0; rep < ((PROBE_MIX & 8) ? 2 : 1); ++rep)
  for (int it = blockIdx.x * 2; it < 4096; it += gridDim.x * 2) hyena_item(P, l, it, shm);
}

DI void norm_store(float* vals, bfr* op) {
  float ss = 0.f;
#pragma unroll
  for (int k = 0; k < 16; ++k) ss += vals[k] * vals[k];
  ss += swz_xor<1>(ss); ss += swz_xor<2>(ss); ss += swz_xor<4>(ss); ss += swz_xor<8>(ss);
  const float rstd = rsqrtf(ss * (1.f / 256.f) + 1e-6f);
#pragma unroll
  for (int k = 0; k < 16; ++k) vals[k] *= rstd;
  *reinterpret_cast<uint4*>(op) = pack8(vals); *reinterpret_cast<uint4*>(op + 8) = pack8(vals + 8);
}

DI void phase_norm(const PX& P, int l, char* shm) {
  char* ws = P.ws;
  const bfr* U = (const bfr*)(ws + WS_U);
  const bfr* Y = (const bfr*)(ws + WS_Y);
  const bfr* YH = (const bfr*)(ws + WS_YH);
  const bfr* YS = (const bfr*)(ws + WS_YSSD);
  bfr* YN = (bfr*)(ws + WS_YN);
  bfr* hy = (bfr*)shm;
  const float* cw = P.in[19] + l * 3 * 768; const float* cbias = P.in[20] + l * 768;
  const int tid = tidx(), wid = tid >> 6, lane = tid & 63;
  const int grp = wid & 3, tsub = (wid >> 2) * 32, tk = lane >> 4, c16 = (lane & 15) * 16;
#pragma unroll 1
  for (int it = blockIdx.x; it < 1024; it += gridDim.x) {
    const int b = it >> 5, t0 = (it & 31) * 64;
    __syncthreads();
    for (int e = tid; e < 2048; e += NTHREADS) {
      const int c = e >> 3, ch = e & 7, rot = c >> 4;
      const uint4 v = *reinterpret_cast<const uint4*>(YH + ((size_t)(b * 256 + c)) * S + t0 + ch * 8);
      unsigned* tp = reinterpret_cast<unsigned*>(hy + c * 66);
      tp[(ch * 4 + rot) & 31] = v.x; tp[(ch * 4 + 1 + rot) & 31] = v.y; tp[(ch * 4 + 2 + rot) & 31] = v.z; tp[(ch * 4 + 3 + rot) & 31] = v.w;
    }
    __syncthreads();
    if (grp == 0 || grp == 2) {
      uint4 qa[8], qb[8];
#pragma unroll
      for (int i = 0; i < 8; ++i) {
        const long row = (long)b * S + t0 + tsub + i * 4 + tk;
        const bfr* yp = Y + row * 512 + (grp == 0 ? 0 : 256) + c16;
        qa[i] = *reinterpret_cast<const uint4*>(yp); qb[i] = *reinterpret_cast<const uint4*>(yp + 8);
      }
#pragma unroll
      for (int i = 0; i < 8; ++i) {
        const long row = (long)b * S + t0 + tsub + i * 4 + tk;
        float vals[16];
        unpack8(qa[i], vals); unpack8(qb[i], vals + 8);
        norm_store(vals, YN + row * 1024 + grp * 256 + c16);
      }
    } else if (grp == 1) {
#pragma unroll 2
      for (int i = 0; i < 8; ++i) {
        const int tl = tsub + i * 4 + tk; const long row = (long)b * S + t0 + tl;
        const int tr = (tl + 2 * (lane & 15)) & 63;
        float vals[16];
#pragma unroll
        for (int k = 0; k < 16; ++k) vals[k] = bf2f(hy[(c16 + k) * 66 + tr]);
        norm_store(vals, YN + row * 1024 + 256 + c16);
      }
    } else {
      const int hd = c16 >> 6;
      const float dsum = P.in[23][l * 8 + hd] + P.in[23][l * 8 + 4 + hd];
#pragma unroll 1
      for (int i = 0; i < 8; ++i) {
        const int tl = tsub + i * 4 + tk, t = t0 + tl; const long row = (long)b * S + t;
        const bfr* ub = U + row * INP + OXBC + c16;
        uint4 q0[2], qm[2], qp[2], qf[2], qbk[2], qz[2];
#pragma unroll
        for (int hf = 0; hf < 2; ++hf) {
          q0[hf] = *reinterpret_cast<const uint4*>(ub + hf * 8);
          qm[hf] = make_uint4(0, 0, 0, 0); qp[hf] = make_uint4(0, 0, 0, 0);
          if (t > 0) qm[hf] = *reinterpret_cast<const uint4*>(ub - INP + hf * 8);
          if (t < S - 1) qp[hf] = *reinterpret_cast<const uint4*>(ub + INP + hf * 8);
          qf[hf] = *reinterpret_cast<const uint4*>(YS + (size_t)row * 256 + c16 + hf * 8);
          qbk[hf] = *reinterpret_cast<const uint4*>(YS + ((size_t)NT + row) * 256 + c16 + hf * 8);
          qz[hf] = *reinterpret_cast<const uint4*>(U + row * INP + OZ + c16 + hf * 8);
        }
        float vals[16];
#pragma unroll
        for (int hf = 0; hf < 2; ++hf) {
          float u0[8], um[8], up[8], w[8], a[8];
          unpack8(q0[hf], u0); unpack8(qm[hf], um); unpack8(qp[hf], up);
          ld8f(cbias + c16 + hf * 8, a);
          ld8f(cw + c16 + hf * 8, w);
#pragma unroll
          for (int k = 0; k < 8; ++k) a[k] += w[k] * um[k];
          ld8f(cw + 768 + c16 + hf * 8, w);
#pragma unroll
          for (int k = 0; k < 8; ++k) a[k] += w[k] * u0[k];
          ld8f(cw + 1536 + c16 + hf * 8, w);
#pragma unroll
          for (int k = 0; k < 8; ++k) a[k] += w[k] * up[k];
          unpack8(qf[hf], u0); unpack8(qbk[hf], um); unpack8(qz[hf], up);
#pragma unroll
          for (int k = 0; k < 8; ++k) vals[hf * 8 + k] = (u0[k] + um[k] + dsum * silu(a[k])) * silu(up[k]);
        }
        norm_store(vals, YN + row * 1024 + 768 + c16);
      }
    }
  }
}

DI void ln_panel(const bfr* pre, float* out, bfr* hb, const float* stats, int brow, const float* g, const float* bta, bool write_f32) {
  const int tid = tidx(), wid = tid >> 6, lane = tid & 63;
#pragma unroll 1
  for (int r4 = wid * 4; r4 < 256; r4 += 32) {
    uint4 q[4][2];
#pragma unroll
    for (int qq = 0; qq < 4; ++qq)
#pragma unroll
      for (int i = 0; i < 2; ++i) q[qq][i] = write_f32 ? make_uint4(0, 0, 0, 0) : *reinterpret_cast<const uint4*>(pre + (long)(brow + r4 + qq) * D + i * 512 + lane * 8);
#pragma unroll
    for (int qq = 0; qq < 4; ++qq) {
      const int row = brow + r4 + qq;
      const float2 st = reinterpret_cast<const float2*>(stats)[r4 + qq];
      const float mu = st.x * (1.f / D);
      const float rstd = rsqrtf(fmaxf(st.y * (1.f / D) - mu * mu, 0.f) + 1e-5f);
#pragma unroll
      for (int i = 0; i < 2; ++i) {
        const int c0 = i * 512 + lane * 8;
        float v[8], gg[8], bb[8];
        if (write_f32) ld8f(out + (long)row * D + c0, v); else unpack8(q[qq][i], v);
        ld8f(g + c0, gg); ld8f(bta + c0, bb);
#pragma unroll
        for (int k = 0; k < 8; ++k) v[k] = (v[k] - mu) * rstd * gg[k] + bb[k];
        if (write_f32) { float* op = out + (long)row * D + c0; *reinterpret_cast<float4*>(op) = make_float4(v[0], v[1], v[2], v[3]); *reinterpret_cast<float4*>(op + 4) = make_float4(v[4], v[5], v[6], v[7]); }
        *reinterpret_cast<uint4*>(hb + (long)row * D + c0) = pack8(v);
      }
    }
  }
}

template <int LDA, int LDB>
DI void phase_gemm_ln(const PX& P, const bfr* A, const bfr* Bt, int K, const float* g, const float* bta, char* shm) {
  float* stats = (float*)(shm + 136192);
  EpiResid epi{(bfr*)(P.ws + WS_PRE), (const bfr*)(P.ws + WS_HB), stats};
#pragma unroll 1
  for (int pm = blockIdx.x; pm < 256; pm += gridDim.x) {
    { const int t = tidx(); if (t < 512) stats[t] = 0.f; }
    __syncthreads();
#pragma unroll 1
    for (int pn = 0; pn < 4; ++pn) gemm_unit<LDA, LDB>(A, Bt, K, pm * 256, pn * 256, shm, epi);
    ln_panel((const bfr*)(P.ws + WS_PRE), P.out, (bfr*)(P.ws + WS_HB), stats, pm * 256, g, bta, false);
    __syncthreads();
  }
}

template <int LDA, int LDB, int K, class Epi>
DI void phase_gemm(const bfr* A, const bfr* Bt, int nN, char* shm, const Epi& epi) {
  for (int u = blockIdx.x; u < 256 * nN; u += gridDim.x) {
    int pm, pn; unit_to_tile(u, 256, nN, pm, pn);
    gemm_unit<LDA, LDB>(A, Bt, K, pm * 256, pn * 256, shm, epi);
  }
}

DI void phase_ple(const PX& P, int l, char* shm) {
  char* ws = P.ws;
  const bfr* W = (const bfr*)(ws + WS_W) + (size_t)l * EW_LAYER;
  bfr* E = (bfr*)(ws + WS_YN);
  float* stats = (float*)(shm + 136192);
  EpiStoreBf16 e1{E, 1024};
  EpiPle e2{(bfr*)(ws + WS_PRE), (l == NL - 1) ? P.out : nullptr, (const bfr*)(ws + WS_HB), E, P.in[37] + l * 1024, stats};
#pragma unroll 1
  for (int pm = blockIdx.x; pm < 256; pm += gridDim.x) {
    { const int t = tidx(); if (t < 512) stats[t] = 0.f; }
    __syncthreads();
#pragma unroll 1
    for (int pn = 0; pn < 4; ++pn) gemm_unit<256, 256>((const bfr*)(ws + WS_PB), W + WO_PP, 256, pm * 256, pn * 256, shm, e1);
#pragma unroll 1
    for (int pn = 0; pn < 4; ++pn) gemm_unit<1024, 1024>((const bfr*)(ws + WS_HB), W + WO_PG, 1024, pm * 256, pn * 256, shm, e2);
    ln_panel((const bfr*)(ws + WS_PRE), P.out, (bfr*)(ws + WS_HB), stats, pm * 256, P.in[38] + l * D, P.in[39] + l * D, l == NL - 1);
    __syncthreads();
  }
}

DI void convert_p(const PX& P, int l) {
  const float4* src = reinterpret_cast<const float4*>(P.in[1] + (size_t)l * NT * PLE);
  uint2* dst = reinterpret_cast<uint2*>(P.ws + WS_PB);
  for (size_t e = (size_t)blockIdx.x * NTHREADS + tidx(); e < (size_t)NT * PLE / 4; e += (size_t)gridDim.x * NTHREADS) {
    const float4 v = src[e]; uint2 pk; pk.x = pack2(v.x, v.y); pk.y = pack2(v.z, v.w); dst[e] = pk;
  }
}

constexpr int NPH_LAYER = 9;
constexpr int NPHASES = 1 + NL * NPH_LAYER;

DI void run_phase(const Params& P0, int ph, char* shm, int skip = 0) {
  PX P;
  int z = 0; asm volatile("" : "+v"(z)); z = __builtin_amdgcn_readfirstlane(z);
  P.in = (in_tab_t)(&P0.in[0]) + z; P.out = P0.out + z; P.ws = P0.ws + z;
  char* ws = P.ws;
  if (ph == 0) { phase_prep(P, shm); return; }
  const int l = (ph - 1) / NPH_LAYER, k = (ph - 1) % NPH_LAYER;
  const bfr* W = (const bfr*)(ws + WS_W) + (size_t)l * EW_LAYER;
  const bfr* HB = (const bfr*)(ws + WS_HB);
  switch (k) {
    case 0: phase_gemm_in(P, l, shm, skip); break;
    case 1: phase_premix(P, l, shm); break;
    case 2: phase_mix(P, l, shm); break;
    case 3: phase_norm(P, l, shm); break;
    case 4: phase_gemm_ln<1024, 1024>(P, (const bfr*)(ws + WS_YN), W + WO_OUT, 1024, P.in[26] + l * D, P.in[27] + l * D, shm); convert_p(P, l); break;
    case 5: { EpiGate e{(bfr*)(ws + WS_U), (bfr*)(ws + WS_HALO)}; phase_gemm<1024, 1024, 1024>(HB, W + WO_G, 11, shm, e); } break;
    case 6: { EpiUp e{(bfr*)(ws + WS_U), (const bfr*)(ws + WS_HALO), P.in[30] + (size_t)l * 3 * DFF, P.in[31] + (size_t)l * DFF};
              phase_gemm<1024, 1024, 1024>(HB, W + WO_U, 11, shm, e); } break;
    case 7: phase_gemm_ln<DFF, DFF>(P, (const bfr*)(ws + WS_U), W + WO_D, DFF, P.in[33] + l * D, P.in[34] + l * D, shm); break;
    case 8: phase_ple(P, l, shm); break;
  }
}

DI void grid_barrier(unsigned* bar, unsigned target) {
  __syncthreads();
  if (tidx() == 0) {
    __builtin_amdgcn_fence(__ATOMIC_RELEASE, "agent");
    __hip_atomic_fetch_add(bar, 1u, __ATOMIC_RELAXED, __HIP_MEMORY_SCOPE_AGENT);
    while (__hip_atomic_load(bar, __ATOMIC_RELAXED, __HIP_MEMORY_SCOPE_AGENT) < target) __builtin_amdgcn_s_sleep(1);
    __builtin_amdgcn_fence(__ATOMIC_ACQUIRE, "agent");
  }
  __syncthreads();
}

template <int PH>
DI void do_phase(const Params& P, int lo, int hi, char* shm) {
  if (PH >= lo && PH < hi) {
#if PROBE_DUP
    if (PH > 0 && ((PROBE_DUP >> ((PH - 1) % NPH_LAYER)) & 1)) { run_phase(P, PH, shm, 1); __syncthreads(); }
    if (PH == 0 && (PROBE_DUP & 0x8000)) { run_phase(P, PH, shm, 1); __syncthreads(); }
#endif
    run_phase(P, PH, shm);
    if (PH + 1 < hi) grid_barrier((unsigned*)(P.ws + WS_BAR), (unsigned)(PH + 1 - lo) * gridDim.x);
  }
}

__global__ __launch_bounds__(NTHREADS, 2) void mega(Params P, int ph_lo, int ph_hi) {
  extern __shared__ __attribute__((aligned(16))) char shm[];
  tid_init();
  if (ph_hi - ph_lo > 1) cg::this_grid().sync();
#ifdef DIAGPH
  run_phase(P, DIAGPH, shm);
#else
  do_phase<0>(P, ph_lo, ph_hi, shm);
  do_phase<1>(P, ph_lo, ph_hi, shm);
  do_phase<2>(P, ph_lo, ph_hi, shm);
  do_phase<3>(P, ph_lo, ph_hi, shm);
  do_phase<4>(P, ph_lo, ph_hi, shm);
  do_phase<5>(P, ph_lo, ph_hi, shm);
  do_phase<6>(P, ph_lo, ph_hi, shm);
  do_phase<7>(P, ph_lo, ph_hi, shm);
  do_phase<8>(P, ph_lo, ph_hi, shm);
  do_phase<9>(P, ph_lo, ph_hi, shm);
  do_phase<10>(P, ph_lo, ph_hi, shm);
  do_phase<11>(P, ph_lo, ph_hi, shm);
  do_phase<12>(P, ph_lo, ph_hi, shm);
  do_phase<13>(P, ph_lo, ph_hi, shm);
  do_phase<14>(P, ph_lo, ph_hi, shm);
  do_phase<15>(P, ph_lo, ph_hi, shm);
  do_phase<16>(P, ph_lo, ph_hi, shm);
  do_phase<17>(P, ph_lo, ph_hi, shm);
  do_phase<18>(P, ph_lo, ph_hi, shm);
#endif
}

extern "C" void kernel_launch(void* const* d_in, const int* in_sizes, int n_in, void* d_out, int out_size, void* d_ws,
                              size_t ws_size, hipStream_t stream) {
  static int grid = 0;
  if (grid == 0) {
    int dev = 0, cus = 0, per_cu = 0;
    hipGetDevice(&dev);
    hipDeviceGetAttribute(&cus, hipDeviceAttributeMultiprocessorCount, dev);
    hipFuncSetAttribute((const void*)mega, hipFuncAttributeMaxDynamicSharedMemorySize, LDS_BYTES);
    hipOccupancyMaxActiveBlocksPerMultiprocessor(&per_cu, (const void*)mega, NTHREADS, LDS_BYTES);
    if (per_cu < 1) per_cu = 1;
    grid = cus * per_cu;
    if (ws_size < WS_END) fprintf(stderr, "workspace too small: %zu < %zu\n", ws_size, (size_t)WS_END);
  }
  Params p{};
  for (int i = 0; i < 40; ++i) p.in[i] = (const float*)d_in[i];
  p.out = (float*)d_out; p.ws = (char*)d_ws;
#if COOP
  hipMemsetAsync((char*)d_ws + WS_BAR, 0, 256, stream);
  int lo = 0, hi = NPHASES;
  void* args[] = {&p, &lo, &hi};
  hipError_t e = hipLaunchCooperativeKernel((const void*)mega, dim3(grid), dim3(NTHREADS), args, LDS_BYTES, stream);
  if (e != hipSuccess) fprintf(stderr, "cooperative launch failed: %s (grid %d)\n", hipGetErrorString(e), grid);
#else
  for (int ph = 0; ph < NPHASES; ++ph) hipLaunchKernelGGL(mega, dim3(grid), dim3(NTHREADS), LDS_BYTES, stream, p, ph, ph + 1);
#endif
}
```
